# Optimizing an MI355X kernel written in HIP

```python
import math, functools
import jax, jax.numpy as jnp
from jax import lax
import numpy as np

D_MODEL = 1024
BATCH = 8
SEQ = 2048
DEPTH = 1
DEC_BATCH = 128
DEC_SEQ = 1
PAST_LEN = 8192
PAGE_SIZE = 128

N_META = 16
MLA_HEADS = 8
QK_NOPE = 64
QK_ROPE = 32
V_DIM = 64
Q_LORA = 384
KV_LORA = 256
KV_WIDTH = KV_LORA + QK_ROPE
ROPE_BASE = 10000.0
Q_BLOCK = 128
SM_SCALE = (QK_NOPE + QK_ROPE) ** -0.5
RWKV_HEADS = 8
HEAD_SIZE = 64
RWKV_WIDTH = RWKV_HEADS * HEAD_SIZE
W_LORA = 64
A_LORA = 64
G_LORA = 128
RWKV_COLS = 3 * RWKV_WIDTH + W_LORA + A_LORA + G_LORA
RWKV_SPLITS = [RWKV_WIDTH, 2 * RWKV_WIDTH, 3 * RWKV_WIDTH, 3 * RWKV_WIDTH + W_LORA, 3 * RWKV_WIDTH + W_LORA + A_LORA]
GN_EPS = 64e-5
MLA_COLS = Q_LORA + KV_LORA + QK_ROPE
IN_COLS = MLA_COLS + RWKV_COLS + 2 * D_MODEL
IN_SPLITS = [Q_LORA, Q_LORA + KV_LORA, MLA_COLS, MLA_COLS + RWKV_COLS]
D_FF = 4 * D_MODEL
NORM_EPS = 1e-6
NEG_INF = -1e30

kernel_name = 'mla_rwkv7_gated_hybrid_step'


def rms_norm(x, g):
    xf = x.astype(jnp.float32)
    y = xf * lax.rsqrt(jnp.mean(xf * xf, axis=-1, keepdims=True) + NORM_EPS)
    return (y * g.astype(jnp.float32)).astype(x.dtype)


def rope_angles(pos):
    inv = ROPE_BASE ** (-jnp.arange(0, QK_ROPE, 2, dtype=jnp.float32) / QK_ROPE)
    ang = pos.astype(jnp.float32)[:, None] * inv[None, :]
    return jnp.cos(ang), jnp.sin(ang)


def apply_rope(x, cos, sin):
    xf = x.astype(jnp.float32)
    x1, x2 = xf[..., :QK_ROPE // 2], xf[..., QK_ROPE // 2:]
    return jnp.concatenate([x1 * cos - x2 * sin, x1 * sin + x2 * cos], axis=-1).astype(x.dtype)


def project_inputs(h, lw, pos):
    B, T = h.shape[:2]
    z = h @ lw['w_in']
    q_in, kv_in, kr_in, rw_cols, gate_in = jnp.split(z, IN_SPLITS, axis=-1)
    cos, sin = rope_angles(pos)
    q = (rms_norm(q_in, lw['g_q']) @ lw['w_uq']).reshape(B, T, MLA_HEADS, QK_NOPE + QK_ROPE)
    q_nope = q[..., :QK_NOPE]
    q_rope = apply_rope(q[..., QK_NOPE:], cos[:, None, :], sin[:, None, :])
    kv_rows = jnp.concatenate([rms_norm(kv_in, lw['g_kv']), apply_rope(kr_in, cos, sin)], axis=-1)
    return q_nope, q_rope, kv_rows, rw_cols, gate_in


def mla_attend_prompt(q_nope, q_rope, kv_rows, lw):
    f32 = jnp.float32
    B, T = kv_rows.shape[:2]
    c_kv = kv_rows[..., :KV_LORA].astype(f32)
    k_rope = kv_rows[..., KV_LORA:].astype(f32)
    k_nope = jnp.einsum('btc,chn->bthn', c_kv, lw['w_uk'].astype(f32).reshape(KV_LORA, MLA_HEADS, QK_NOPE))
    v = jnp.einsum('btc,chv->bthv', c_kv, lw['w_uv'].astype(f32).reshape(KV_LORA, MLA_HEADS, V_DIM))
    nb = -(-T // Q_BLOCK)
    tp = nb * Q_BLOCK

    def to_blocks(t):
        t = jnp.pad(t.astype(f32), [(0, 0), (0, tp - T)] + [(0, 0)] * (t.ndim - 2))
        return jnp.moveaxis(t.reshape((B, nb, Q_BLOCK) + t.shape[2:]), 1, 0)

    k_pos = jnp.arange(T)

    def one_block(args):
        qn, qr, i = args
        q_pos = i * Q_BLOCK + jnp.arange(Q_BLOCK)
        s = (jnp.einsum('bqhn,bkhn->bhqk', qn, k_nope) + jnp.einsum('bqhr,bkr->bhqk', qr, k_rope)) * SM_SCALE
        s = jnp.where(k_pos[None, :] <= q_pos[:, None], s, NEG_INF)
        return jnp.einsum('bhqk,bkhv->bqhv', jax.nn.softmax(s, axis=-1), v)

    o = lax.map(one_block, (to_blocks(q_nope), to_blocks(q_rope), jnp.arange(nb)))
    return jnp.moveaxis(o, 0, 1).reshape(B, tp, MLA_HEADS, V_DIM)[:, :T]


def softmax_merge(carry, s, vals):
    m, l, acc = carry
    m_new = jnp.maximum(m, s.max(axis=-1))
    alpha = jnp.exp(m - m_new)
    p = jnp.exp(s - m_new[..., None])
    l = l * alpha + p.sum(axis=-1)
    acc = acc * alpha[..., None] + jnp.einsum('bhqk,bkc->bhqc', p, vals)
    return (m_new, l, acc)


def mla_attend_sample(q_nope, q_rope, kv_rows, lw, cache_kv, page_table):
    f32 = jnp.float32
    Bd, S = kv_rows.shape[:2]
    w_uk = lw['w_uk'].astype(f32).reshape(KV_LORA, MLA_HEADS, QK_NOPE)
    w_uv = lw['w_uv'].astype(f32).reshape(KV_LORA, MLA_HEADS, V_DIM)
    q_lat = jnp.einsum('bqhn,chn->bqhc', q_nope.astype(f32), w_uk)
    qf = jnp.concatenate([q_lat, q_rope.astype(f32)], axis=-1) * SM_SCALE

    def page_step(carry, pages):
        rows = cache_kv[pages].astype(f32)
        s = jnp.einsum('bqhc,bkc->bhqk', qf, rows)
        return softmax_merge(carry, s, rows[..., :KV_LORA]), None

    init = (jnp.full((Bd, MLA_HEADS, S), NEG_INF, f32),
            jnp.zeros((Bd, MLA_HEADS, S), f32),
            jnp.zeros((Bd, MLA_HEADS, S, KV_LORA), f32))
    carry, _ = lax.scan(page_step, init, page_table.T)
    kvn = kv_rows.astype(f32)
    s = jnp.einsum('bqhc,bkc->bhqk', qf, kvn)
    s = jnp.where(jnp.tril(jnp.ones((S, S), bool)), s, NEG_INF)
    m, l, acc = softmax_merge(carry, s, kvn[..., :KV_LORA])
    o_lat = acc / l[..., None]
    return jnp.einsum('bhqc,chv->bqhv', o_lat, w_uv)


def wkv_scan(S0, r, w, k, v, a, b):
    def step(S, inp):
        r_t, w_t, k_t, v_t, a_t, b_t = inp
        sa = jnp.einsum('bhvk,bhk->bhv', S, a_t)
        S = S * w_t[:, :, None, :] + sa[..., None] * b_t[:, :, None, :] + v_t[..., None] * k_t[:, :, None, :]
        return S, jnp.einsum('bhvk,bhk->bhv', S, r_t)
    xs = (jnp.swapaxes(r, 0, 1), jnp.swapaxes(w, 0, 1), jnp.swapaxes(k, 0, 1),
          jnp.swapaxes(v, 0, 1), jnp.swapaxes(a, 0, 1), jnp.swapaxes(b, 0, 1))
    S, y = lax.scan(step, S0, xs)
    return S, jnp.swapaxes(y, 0, 1)


def rwkv_branch(cols, shift0, wkv0, lw):
    f32 = jnp.float32
    B, T = cols.shape[:2]
    c = cols.astype(f32)
    prev = jnp.concatenate([shift0[:, None].astype(f32), c[:, :-1]], axis=1)
    z = c + (prev - c) * lw['mu_shift'].astype(f32)
    r, k, v, w_in, a_in, g_in = jnp.split(z, RWKV_SPLITS, axis=-1)
    w_log = lw['w0'].astype(f32) + jnp.tanh(w_in) @ lw['w2'].astype(f32)
    decay = jnp.exp(-jnp.exp(-jax.nn.softplus(-w_log) - 0.5))
    a = jax.nn.sigmoid(lw['a0'].astype(f32) + a_in @ lw['a2'].astype(f32))
    g = jax.nn.sigmoid(g_in) @ lw['g2'].astype(f32)
    hs = (RWKV_HEADS, HEAD_SIZE)
    r, k, v, decay, a = [t.reshape(B, T, RWKV_HEADS, HEAD_SIZE) for t in (r, k, v, decay, a)]
    kk = k * lw['k_k'].astype(f32).reshape(hs)
    kk = kk / jnp.maximum(jnp.sqrt(jnp.sum(kk * kk, axis=-1, keepdims=True)), 1e-12)
    k = k * (1.0 + (a - 1.0) * lw['k_a'].astype(f32).reshape(hs))
    S, y = wkv_scan(wkv0.astype(f32), r, decay, k, v, -kk, kk * a)
    mu = jnp.mean(y, axis=-1, keepdims=True)
    var = jnp.mean(jnp.square(y - mu), axis=-1, keepdims=True)
    y = (y - mu) * lax.rsqrt(var + GN_EPS) * lw['ln_w'].astype(f32).reshape(hs) + lw['ln_b'].astype(f32).reshape(hs)
    y = y + jnp.sum(r * k * lw['r_k'].astype(f32), axis=-1, keepdims=True) * v
    return y.reshape(B, T, RWKV_WIDTH) * g, S


def hybrid_layer(x, pos, attend, wkv0, shift0, lw):
    B, T = x.shape[:2]
    h = rms_norm(x, lw['g_mix'])
    q_nope, q_rope, kv_rows, rw_cols, gate_in = project_inputs(h, lw, pos)
    o_mla = attend(q_nope, q_rope, kv_rows, lw).reshape(B, T, MLA_HEADS * V_DIM).astype(x.dtype) @ lw['w_o_mla']
    o_rwkv, wkv_new = rwkv_branch(rw_cols, shift0, wkv0, lw)
    o_rwkv = o_rwkv.astype(x.dtype) @ lw['w_o_rwkv']
    g_mla, g_rwkv = jnp.split(jax.nn.sigmoid(gate_in), 2, axis=-1)
    x = x + (g_mla * o_mla + g_rwkv * o_rwkv) @ lw['w_out']
    h2 = rms_norm(x, lw['g_ffn'])
    x = x + jnp.square(jax.nn.relu(h2 @ lw['w_up'])) @ lw['w_down']
    return x, kv_rows, wkv_new, rw_cols[:, -1]


def setup_inputs(seed: int = 0) -> dict:
    key = jax.random.key(seed)
    keys = iter(jax.random.split(key, 48))

    def nrm(shape, scale):
        return scale * jax.random.normal(next(keys), shape, jnp.float32)

    def gain(shape):
        return 1.0 + nrm(shape, 0.02)

    L = DEPTH
    n_pages = PAST_LEN // PAGE_SIZE
    n_used = DEC_BATCH * n_pages
    n_pool = (n_used * 5) // 4
    x_prompt = nrm((BATCH, SEQ, D_MODEL), 1.0)
    x_sample = nrm((DEC_BATCH, DEC_SEQ, D_MODEL), 1.0)
    cache_kv = nrm((L, n_pool, PAGE_SIZE, KV_WIDTH), 1.0)
    page_table = jax.random.permutation(next(keys), n_pool)[:n_used].reshape(DEC_BATCH, n_pages).astype(jnp.int32)
    state_wkv = nrm((L, DEC_BATCH, RWKV_HEADS, HEAD_SIZE, HEAD_SIZE), 0.5)
    state_shift = nrm((L, DEC_BATCH, RWKV_COLS), 1.0)
    return {
        'x_prompt': x_prompt,
        'x_sample': x_sample,
        'cache_kv': cache_kv,
        'page_table': page_table,
        'state_wkv': state_wkv,
        'state_shift': state_shift,
        'meta_tokens': nrm((N_META, D_MODEL), 1.0),
        'g_final': gain((D_MODEL,)),
        'g_mix': gain((L, D_MODEL)),
        'w_in': nrm((L, D_MODEL, IN_COLS), D_MODEL ** -0.5),
        'g_q': gain((L, Q_LORA)),
        'w_uq': nrm((L, Q_LORA, MLA_HEADS * (QK_NOPE + QK_ROPE)), Q_LORA ** -0.5),
        'g_kv': gain((L, KV_LORA)),
        'w_uk': nrm((L, KV_LORA, MLA_HEADS * QK_NOPE), KV_LORA ** -0.5),
        'w_uv': nrm((L, KV_LORA, MLA_HEADS * V_DIM), KV_LORA ** -0.5),
        'w_o_mla': nrm((L, MLA_HEADS * V_DIM, D_MODEL), (MLA_HEADS * V_DIM) ** -0.5),
        'mu_shift': jax.random.uniform(next(keys), (L, RWKV_COLS), jnp.float32),
        'w0': -3.0 + nrm((L, RWKV_WIDTH), 1.0),
        'w2': nrm((L, W_LORA, RWKV_WIDTH), 0.5 * W_LORA ** -0.5),
        'a0': nrm((L, RWKV_WIDTH), 0.3),
        'a2': nrm((L, A_LORA, RWKV_WIDTH), 0.5 * A_LORA ** -0.5),
        'g2': nrm((L, G_LORA, RWKV_WIDTH), G_LORA ** -0.5),
        'k_k': 0.85 + nrm((L, RWKV_WIDTH), 0.02),
        'k_a': 1.0 + nrm((L, RWKV_WIDTH), 0.02),
        'r_k': nrm((L, RWKV_HEADS, HEAD_SIZE), 0.1),
        'ln_w': gain((L, RWKV_WIDTH)),
        'ln_b': nrm((L, RWKV_WIDTH), 0.02),
        'w_o_rwkv': nrm((L, RWKV_WIDTH, D_MODEL), RWKV_WIDTH ** -0.5),
        'w_out': nrm((L, D_MODEL, D_MODEL), D_MODEL ** -0.5),
        'g_ffn': gain((L, D_MODEL)),
        'w_up': nrm((L, D_MODEL, D_FF), D_MODEL ** -0.5),
        'w_down': nrm((L, D_FF, D_MODEL), D_FF ** -0.5),
    }


def reference(x_prompt, x_sample, cache_kv, page_table, state_wkv, state_shift, meta_tokens, g_final,
              g_mix, w_in, g_q, w_uq, g_kv, w_uk, w_uv, w_o_mla, mu_shift, w0, w2, a0, a2, g2,
              k_k, k_a, r_k, ln_w, ln_b, w_o_rwkv, w_out, g_ffn, w_up, w_down):
    b_p = x_prompt.shape[0]
    s_s = x_sample.shape[1]
    meta = jnp.broadcast_to(meta_tokens[None].astype(x_prompt.dtype), (b_p, N_META, D_MODEL))
    xp = jnp.concatenate([meta, x_prompt], axis=1)
    xs = x_sample
    pos_p = jnp.arange(xp.shape[1])
    pos_s = PAST_LEN + jnp.arange(s_s)
    wkv_zero = jnp.zeros((b_p, RWKV_HEADS, HEAD_SIZE, HEAD_SIZE), jnp.float32)
    shift_zero = jnp.zeros((b_p, RWKV_COLS), jnp.float32)
    kv_p, wkv_p, sh_p, kv_s, wkv_s, sh_s = [], [], [], [], [], []
    for layer in range(DEPTH):
        lw = dict(g_mix=g_mix[layer], w_in=w_in[layer], g_q=g_q[layer], w_uq=w_uq[layer], g_kv=g_kv[layer],
                  w_uk=w_uk[layer], w_uv=w_uv[layer], w_o_mla=w_o_mla[layer], mu_shift=mu_shift[layer],
                  w0=w0[layer], w2=w2[layer], a0=a0[layer], a2=a2[layer], g2=g2[layer], k_k=k_k[layer],
                  k_a=k_a[layer], r_k=r_k[layer], ln_w=ln_w[layer], ln_b=ln_b[layer],
                  w_o_rwkv=w_o_rwkv[layer], w_out=w_out[layer], g_ffn=g_ffn[layer], w_up=w_up[layer],
                  w_down=w_down[layer])
        xp, kv, wkv, sh = hybrid_layer(xp, pos_p, mla_attend_prompt, wkv_zero, shift_zero, lw)
        kv_p.append(kv)
        wkv_p.append(wkv)
        sh_p.append(sh)
        attend_s = functools.partial(mla_attend_sample, cache_kv=cache_kv[layer], page_table=page_table)
        xs, kv, wkv, sh = hybrid_layer(xs, pos_s, attend_s, state_wkv[layer], state_shift[layer], lw)
        kv_s.append(kv)
        wkv_s.append(wkv)
        sh_s.append(sh)
    y_prompt = rms_norm(xp, g_final)[:, N_META:]
    y_sample = rms_norm(xs, g_final)
    return (y_prompt, y_sample,
            jnp.stack(kv_p).astype(cache_kv.dtype),
            jnp.stack(wkv_p).astype(state_wkv.dtype),
            jnp.stack(sh_p).astype(state_shift.dtype),
            jnp.stack(kv_s).astype(cache_kv.dtype),
            jnp.stack(wkv_s).astype(state_wkv.dtype),
            jnp.stack(sh_s).astype(state_shift.dtype))
```

```cpp
#include <hip/hip_runtime.h>
#include <cstdio>
#include <cstdint>
#define LAS __attribute__((address_space(3)))
#define MK_LAUNCHES 1
namespace pg8 {
#define PG8_LAS __attribute__((address_space(3)))
typedef unsigned short bf16_t;
typedef short bf16x8 __attribute__((ext_vector_type(8)));
typedef float f32x4 __attribute__((ext_vector_type(4)));
typedef unsigned u32x4 __attribute__((ext_vector_type(4)));
constexpr int BM = 256, BK = 64, HALF = 128, HTB = HALF * BK * 2  , STAGE_BYTES = 8 * HTB, NXCD = 8, WGM = 8;

__host__ __device__ __forceinline__ int lds_byte(int r, int c) { const int st = (r >> 4) * 2 + (c >> 5), rr = r & 15, cc = c & 31, ob = rr * 64 + cc * 2; return st * 1024 + (ob ^ (((ob >> 9) & 1) << 5)); }
__host__ __device__ __forceinline__ void stage_rc(int b, int& R, int& C) { const int st = b / 1024, sb = b % 1024, swz = sb ^ (((sb >> 9) & 1) << 5); R = (st >> 1) * 16 + swz / 64; C = (st & 1) * 32 + (swz % 64) / 2; }
__host__ __device__ __forceinline__ int perm32(int rho) { const int n = rho >> 4, i = rho & 15; return 8 * (i >> 2) + 4 * n + (i & 3); }

struct Unit { int pm, pn; };
struct Gemm { const bf16_t* A; const bf16_t* Bt; int M, N, K; };

struct StaticOrder {
    int nM, nN, nwg, G, c;
    __host__ __device__ void init(int M, int N, int G_, int c_) { nM = M / BM; nN = N / BM; nwg = nM * nN; G = G_; c = c_; }
    __host__ __device__ bool next(int i, Unit& u) const {
        const long L = (long)i * G + c; if (L >= nwg) return false;
        int wgid = (int)L; { const int q = nwg / NXCD, r = nwg % NXCD, xcd = wgid % NXCD, off = wgid / NXCD; wgid = (xcd < r ? xcd * (q + 1) : r * (q + 1) + (xcd - r) * q) + off; }
        const int nig = WGM * nN, gid = wgid / nig, fm = gid * WGM, gsz = (nM - fm) < WGM ? (nM - fm) : WGM;
        u.pm = fm + ((wgid % nig) % gsz); u.pn = (wgid % nig) / gsz; return true;
    }
    __device__ __forceinline__ void a_ready(const Unit&) const {}
    __device__ __forceinline__ void done(const Unit&) const {}
};


template <class Epi, class Sched, bool ALIGN_EPI = false, bool SP2 = false>
__device__ __forceinline__ void gemm_phase(PG8_LAS unsigned char* lds, const Gemm g, const Sched& S, const Epi& E) {
    const int tid = threadIdx.x, wid = __builtin_amdgcn_readfirstlane(tid >> 6), lane = tid & 63, wr = wid >> 2, wc = wid & 3, fr = lane & 15, fq = lane >> 4;
    const int K = g.K, nt = K / BK;
    unsigned voffA[2], voffB[2];
#pragma unroll
    for (int i = 0; i < 2; ++i) { int R, C; stage_rc(tid * 16 + i * 8192, R, C); const int Rb = Epi::PERM ? ((R & ~31) + perm32(R & 31)) : R;
        voffA[i] = (unsigned)(R * K + C) * 2u; voffB[i] = (unsigned)(Rb * K + C) * 2u; }
    const size_t kstep = (size_t)(BK * 2);
    const size_t hstep = (size_t)HALF * K * 2;
    const size_t tstep = 2 * hstep;
    const unsigned ldsw = (unsigned)wid * 1024u;
    const int aoff = lds_byte(wr * 64 + fr, fq * 8), boff = lds_byte(wc * 32 + fr, fq * 8);
#define PG8_SA(b, h) (((b) * 2 + (h)) * HTB)
#define PG8_SB(b, h) ((4 + (b) * 2 + (h)) * HTB)
#define PG8_STAGE(bufoff, gbase, voff) do { _Pragma("unroll") for (int _i = 0; _i < 2; ++_i) \
        __builtin_amdgcn_global_load_lds((const unsigned*)((const char*)(gbase) + (voff)[_i]), (PG8_LAS unsigned*)(lds + (bufoff) + ldsw + _i * 8192), 16, 0, 0); } while (0)
#define PG8_LDA(dst, b, h) do { _Pragma("unroll") for (int m = 0; m < 4; ++m) _Pragma("unroll") for (int k = 0; k < 2; ++k) dst[m][k] = *(const PG8_LAS bf16x8*)(lds + PG8_SA(b, h) + aoff + m * 2048 + k * 1024); } while (0)
#define PG8_LDB(dst, b, h) do { _Pragma("unroll") for (int n = 0; n < 2; ++n) _Pragma("unroll") for (int k = 0; k < 2; ++k) dst[n][k] = *(const PG8_LAS bf16x8*)(lds + PG8_SB(b, h) + boff + n * 2048 + k * 1024); } while (0)
#define PG8_MMA(ai, bj, At, Bt) do { __builtin_amdgcn_s_setprio(1); _Pragma("unroll") for (int m = 0; m < 4; ++m) _Pragma("unroll") for (int n = 0; n < 2; ++n) _Pragma("unroll") for (int k = 0; k < 2; ++k) \
        acc[ai][bj][m][n] = __builtin_amdgcn_mfma_f32_16x16x32_bf16(Bt[n][k], At[m][k], acc[ai][bj][m][n], 0, 0, 0); __builtin_amdgcn_s_setprio(0); } while (0)
#define PG8_WAIT_V(n) asm volatile("s_waitcnt vmcnt(" #n ")" ::: "memory")
#define PG8_WAIT_L(n) asm volatile("s_waitcnt lgkmcnt(" #n ")" ::: "memory")
#define PG8_BAR __builtin_amdgcn_s_barrier()
#define PG8_SCHED __builtin_amdgcn_sched_barrier(0)
    Unit cur, nxt; int ui = 0;
    if (!S.next(0, cur)) return;
    f32x4 acc[2][2][4][2];
#pragma unroll
    for (int a = 0; a < 2; ++a)
#pragma unroll
        for (int b = 0; b < 2; ++b)
#pragma unroll
            for (int m = 0; m < 4; ++m)
#pragma unroll
                for (int n = 0; n < 2; ++n) acc[a][b][m][n] = (f32x4){0.f, 0.f, 0.f, 0.f};
    bf16x8 At[4][2], B0[2][2], B1[2][2];
    const char* cA = (const char*)g.A + (size_t)cur.pm * tstep; const char* cB = (const char*)g.Bt + (size_t)cur.pn * tstep;
    S.a_ready(cur);
    if constexpr (SP2) {
        PG8_STAGE(PG8_SB(0, 0), cB, voffB); PG8_STAGE(PG8_SB(0, 1), cB + hstep, voffB); PG8_STAGE(PG8_SA(0, 0), cA, voffA); PG8_STAGE(PG8_SA(0, 1), cA + hstep, voffA);
        if (wr == 1) PG8_BAR;
        PG8_WAIT_V(2); PG8_BAR;
        PG8_STAGE(PG8_SB(1, 0), cB + kstep, voffB); PG8_STAGE(PG8_SA(1, 0), cA + kstep, voffA); PG8_STAGE(PG8_SB(1, 1), cB + hstep + kstep, voffB);
        PG8_WAIT_V(6); PG8_BAR;
    } else {
        PG8_STAGE(PG8_SB(0, 0), cB, voffB); PG8_STAGE(PG8_SA(0, 0), cA, voffA); PG8_STAGE(PG8_SB(0, 1), cB + hstep, voffB); PG8_STAGE(PG8_SA(0, 1), cA + hstep, voffA);
        if (wr == 1) PG8_BAR;
        PG8_WAIT_V(4); PG8_BAR;
        PG8_STAGE(PG8_SB(1, 0), cB + kstep, voffB); PG8_STAGE(PG8_SA(1, 0), cA + kstep, voffA); PG8_STAGE(PG8_SB(1, 1), cB + hstep + kstep, voffB);
        PG8_WAIT_V(6); PG8_BAR;
    }
    for (;;) {
        const bool has_next = S.next(ui + 1, nxt);
        const char* nA = has_next ? (const char*)g.A + (size_t)nxt.pm * tstep : cA; const char* nB = has_next ? (const char*)g.Bt + (size_t)nxt.pn * tstep : cB;
_Pragma("nounroll")
        for (int t = 0; t < nt; t += 2) {
            const bool last = (t == nt - 2);
            const char* a1 = cA + (size_t)(t + 1) * kstep;
            const char* a2 = last ? nA : cA + (size_t)(t + 2) * kstep; const char* b2 = last ? nB : cB + (size_t)(t + 2) * kstep;
            const char* a3 = a2 + kstep; const char* b3 = b2 + kstep;
            if (last && has_next) S.a_ready(nxt);
            if constexpr (SP2) {
            PG8_LDB(B0, 0, 0); PG8_LDB(B1, 0, 1); PG8_SCHED; PG8_LDA(At, 0, 0); PG8_STAGE(PG8_SA(1, 1), a1 + hstep, voffA);
            PG8_WAIT_V(8); PG8_WAIT_L(0); PG8_BAR; PG8_MMA(0, 0, At, B0); PG8_MMA(0, 1, At, B1); PG8_BAR; PG8_SCHED;
            PG8_LDA(At, 0, 1); PG8_STAGE(PG8_SB(0, 0), b2, voffB); PG8_STAGE(PG8_SB(0, 1), b2 + hstep, voffB); PG8_STAGE(PG8_SA(0, 0), a2, voffA);
            PG8_WAIT_V(8); PG8_WAIT_L(0); PG8_BAR; PG8_MMA(1, 0, At, B0); PG8_MMA(1, 1, At, B1); PG8_BAR; PG8_SCHED;
            PG8_LDB(B0, 1, 0); PG8_LDB(B1, 1, 1); PG8_SCHED; PG8_LDA(At, 1, 0); PG8_STAGE(PG8_SA(0, 1), a2 + hstep, voffA);
            PG8_WAIT_V(8); PG8_WAIT_L(0); PG8_BAR; PG8_MMA(0, 0, At, B0); PG8_MMA(0, 1, At, B1); PG8_BAR; PG8_SCHED;
            PG8_LDA(At, 1, 1); PG8_STAGE(PG8_SB(1, 0), b3, voffB); PG8_STAGE(PG8_SB(1, 1), b3 + hstep, voffB); PG8_STAGE(PG8_SA(1, 0), a3, voffA);
            PG8_WAIT_V(8); PG8_WAIT_L(0); PG8_BAR; PG8_MMA(1, 0, At, B0); PG8_MMA(1, 1, At, B1); PG8_BAR; PG8_SCHED;
            } else {
            PG8_LDB(B0, 0, 0); PG8_SCHED; PG8_LDA(At, 0, 0); PG8_STAGE(PG8_SA(1, 1), a1 + hstep, voffA);
            PG8_WAIT_L(8); PG8_BAR; PG8_WAIT_L(0); PG8_MMA(0, 0, At, B0); PG8_BAR; PG8_SCHED;
            PG8_LDB(B1, 0, 1); PG8_STAGE(PG8_SB(0, 0), b2, voffB);
            PG8_BAR; PG8_WAIT_L(0); PG8_MMA(0, 1, At, B1); PG8_BAR;
            PG8_LDA(At, 0, 1); PG8_STAGE(PG8_SA(0, 0), a2, voffA);
            PG8_BAR; PG8_WAIT_L(0); PG8_MMA(1, 0, At, B0); PG8_BAR; PG8_SCHED;
            PG8_STAGE(PG8_SB(0, 1), b2 + hstep, voffB);
            PG8_WAIT_V(6); PG8_BAR; PG8_MMA(1, 1, At, B1); PG8_BAR;
            PG8_LDB(B0, 1, 0); PG8_SCHED; PG8_LDA(At, 1, 0); PG8_STAGE(PG8_SA(0, 1), a2 + hstep, voffA);
            PG8_WAIT_L(8); PG8_BAR; PG8_WAIT_L(0); PG8_MMA(0, 0, At, B0); PG8_BAR; PG8_SCHED;
            PG8_LDB(B1, 1, 1); PG8_STAGE(PG8_SB(1, 0), b3, voffB);
            PG8_BAR; PG8_WAIT_L(0); PG8_MMA(0, 1, At, B1); PG8_BAR;
            PG8_LDA(At, 1, 1); PG8_STAGE(PG8_SA(1, 0), a3, voffA);
            PG8_BAR; PG8_WAIT_L(0); PG8_MMA(1, 0, At, B0); PG8_BAR; PG8_SCHED;
            PG8_STAGE(PG8_SB(1, 1), b3 + hstep, voffB);
            PG8_WAIT_V(6); PG8_BAR; PG8_MMA(1, 1, At, B1); PG8_BAR;
            }
        }
        if constexpr (ALIGN_EPI) { if (wr == 0) PG8_BAR; }
        if constexpr (!Epi::AFTER_DRAIN) { E(acc, cur, wr, wc, fr, fq); S.done(cur); }
        if (!has_next) break;
#pragma unroll
        for (int a = 0; a < 2; ++a)
#pragma unroll
            for (int b = 0; b < 2; ++b)
#pragma unroll
                for (int m = 0; m < 4; ++m)
#pragma unroll
                    for (int n = 0; n < 2; ++n) acc[a][b][m][n] = (f32x4){0.f, 0.f, 0.f, 0.f};
        cur = nxt; cA = nA; cB = nB; ++ui;
        if constexpr (ALIGN_EPI) { if (wr == 1) PG8_BAR; }
    }
    PG8_WAIT_V(0);
    if constexpr (!ALIGN_EPI) { if (wr == 0) PG8_BAR; }
    PG8_BAR;
    if constexpr (Epi::AFTER_DRAIN) { E.fused(acc, cur, wr, wc, fr, fq, lds, wid, lane); S.done(cur); }
#undef PG8_SA
#undef PG8_SB
#undef PG8_STAGE
#undef PG8_LDA
#undef PG8_LDB
#undef PG8_MMA
#undef PG8_WAIT_V
#undef PG8_WAIT_L
#undef PG8_BAR
#undef PG8_SCHED
}
}
#define GAS __attribute__((address_space(1)))
#define XB_TMO      128
#define XB_XCNT(j)  (256  + 64 * (j))
#define XB_XSUB(j)  (1280 + 64 * (j))
#define XB_XGEN(j)  (2304 + 64 * (j))
#define XB_TOP      3328
#define XB_TOPGEN   3392
#define XCD_BAR_WORDS 3456
#define XB_SPIN_CAP (1u << 18)

__device__ __forceinline__ unsigned xb_ld(unsigned* p)              { return __hip_atomic_load(p, __ATOMIC_RELAXED, __HIP_MEMORY_SCOPE_AGENT); }
__device__ __forceinline__ unsigned xb_add(unsigned* p, unsigned v) { return __hip_atomic_fetch_add(p, v, __ATOMIC_RELAXED, __HIP_MEMORY_SCOPE_AGENT); }
__device__ __forceinline__ unsigned xb_xcc_id() { return (unsigned)__builtin_amdgcn_s_getreg((3 << 11) | 20) & 0xFu; }
#define XB_SPIN(cond, bar) do { unsigned _sp = 0; while (cond) { __builtin_amdgcn_s_sleep(1); \
    if ((++_sp & 255u) == 0u) { if (xb_ld(&(bar)[XB_TMO])) break; if (_sp > XB_SPIN_CAP) { atomicAdd(&(bar)[XB_TMO], 1u); break; } } } } while (0)

struct XcdBarrier {
    unsigned* bar; unsigned x;
    volatile LAS unsigned* st;
};

__device__ __forceinline__ XcdBarrier xcd_barrier_post(unsigned* bar, volatile LAS unsigned* st) {
    XcdBarrier b; b.bar = bar; b.x = xb_xcc_id(); b.st = st;
    if (threadIdx.x == 0) (void)xb_add(&bar[XB_XCNT(b.x)], 1u);
    return b;
}
__device__ __forceinline__ void xcd_barrier_complete(unsigned* bar, unsigned x, unsigned& nloc, unsigned& nx) {
    const unsigned G = gridDim.x * gridDim.y * gridDim.z;
    unsigned sum, cnt, mine, sp = 0u;
    for (;;) {
        sum = 0u; cnt = 0u; mine = 0u;
#pragma unroll
        for (unsigned j = 0; j < 16; ++j) { const unsigned c = xb_ld(&bar[XB_XCNT(j)]); sum += c; cnt += (c > 0u) ? 1u : 0u; mine = (j == x) ? c : mine; }
        if (sum == G) break;
        __builtin_amdgcn_s_sleep(1);
        if ((++sp & 255u) == 0u) { if (xb_ld(&bar[XB_TMO])) break; if (sp > XB_SPIN_CAP) { atomicAdd(&bar[XB_TMO], 1u); break; } }
    }
    nloc = mine > 0u ? mine : 1u; nx = cnt > 0u ? cnt : 1u;
}

__device__ __forceinline__ void xcd_barrier(const XcdBarrier& b) {
    asm volatile("s_waitcnt vmcnt(0)" ::: "memory");
    __syncthreads();
    if (threadIdx.x == 0) {
        unsigned* bar = b.bar;
        __builtin_amdgcn_s_waitcnt(0);
        unsigned nloc = b.st[0], nx = b.st[1];
        if (nloc == 0u) { xcd_barrier_complete(bar, b.x, nloc, nx); b.st[0] = nloc; b.st[1] = nx; }
        const unsigned old = xb_add(&bar[XB_XSUB(b.x)], 1u);
        const unsigned gen = old / nloc;
        if (old + 1u == (gen + 1u) * nloc) {
            __builtin_amdgcn_fence(__ATOMIC_RELEASE, "agent");
            asm volatile("s_waitcnt vmcnt(0)" ::: "memory");
            const unsigned og = xb_add(&bar[XB_TOP], 1u);
            const unsigned tg = og / nx;
            if (og + 1u == (tg + 1u) * nx) xb_add(&bar[XB_TOPGEN], 1u);
            else XB_SPIN(xb_ld(&bar[XB_TOPGEN]) == tg, bar);
            __builtin_amdgcn_fence(__ATOMIC_ACQUIRE, "agent");
            xb_add(&bar[XB_XGEN(b.x)], 1u);
            asm volatile("s_waitcnt vmcnt(0)" ::: "memory");
        } else {
            XB_SPIN(xb_ld(&bar[XB_XGEN(b.x)]) == gen, bar);
            __builtin_amdgcn_fence(__ATOMIC_ACQUIRE, "agent");
            asm volatile("s_waitcnt vmcnt(0)" ::: "memory");
        }
    }
    __syncthreads();
}

using pg8::bf16_t; using pg8::bf16x8; using pg8::f32x4; using pg8::Unit;
typedef float f32x16 __attribute__((ext_vector_type(16)));
typedef float f32x2_t __attribute__((ext_vector_type(2)));
typedef __bf16 bf16x2_t __attribute__((ext_vector_type(2)));
typedef unsigned u32x2 __attribute__((ext_vector_type(2)));
typedef unsigned u32x4 __attribute__((ext_vector_type(4)));

constexpr int DM = 1024, NBATCH = 8, SEQ = 2048, NMETA = 16, TPOS = 2064, DECB = 128, PASTLEN = 8192, PAGESZ = 128, NPAGES = 64;
constexpr int NHEAD = 8, QLORA = 384, KVLORA = 256, KVW = 288;
constexpr int RWW = 512, RWCOLS = 1792, INCOLS = 4512, INPAD = 4608, DFF = 4096;
constexpr int MMAIN = 16384, ROW_META = 16384, ROW_SAMP = 16400, ROW_PAD = 16528, MROWS = 16640;
constexpr int KPITCH = 2112;
constexpr int ROPE_SAMP = 2064;
constexpr float NORM_EPS = 1e-6f, GN_EPS = 64e-5f;
constexpr float QSCALE = 0.10206207261596577f * 1.4426950408889634f;
constexpr int NTHREADS = 512, NWAVES = 8;
constexpr int LDS_RING = 131072, LDS_MISC = LDS_RING, LDS_BYTES = LDS_RING + 1024;

constexpr size_t al256(size_t x) { return (x + 255) & ~(size_t)255; }
constexpr size_t WS_CTL   = 0;
constexpr size_t WS_SSQ1  = 65536;
constexpr size_t WS_SSQ2  = WS_SSQ1 + al256((size_t)MROWS * 4);
constexpr size_t WS_ZERO_END = WS_SSQ2 + al256((size_t)MROWS * 4);
constexpr size_t WS_WIN   = al256(WS_ZERO_END);
constexpr size_t WS_WUQ   = WS_WIN   + (size_t)INPAD * DM * 2;
constexpr size_t WS_WQABS = WS_WUQ   + (size_t)768 * 384 * 2;
constexpr size_t WS_WKV   = WS_WQABS + (size_t)2048 * 384 * 2;
constexpr size_t WS_WLORA = WS_WKV   + (size_t)1024 * 256 * 2;
constexpr size_t WS_WOM   = WS_WLORA + (size_t)1536 * 256 * 2;
constexpr size_t WS_WOR   = WS_WOM   + (size_t)1024 * 512 * 2;
constexpr size_t WS_WOUT  = WS_WOR   + (size_t)1024 * 512 * 2;
constexpr size_t WS_WUP   = WS_WOUT  + (size_t)1024 * 1024 * 2;
constexpr size_t WS_WDN   = WS_WUP   + (size_t)4096 * 1024 * 2;
constexpr size_t WS_ROPE  = WS_WDN   + (size_t)1024 * 4096 * 2;
constexpr size_t WS_XB    = al256(WS_ROPE + (size_t)2065 * 32 * 4);
constexpr size_t WS_ZS    = WS_XB    + (size_t)MROWS * 1024 * 2;
constexpr size_t WS_RW    = WS_ZS    + (size_t)MROWS * 768 * 4;
constexpr size_t WS_GATE  = WS_RW    + (size_t)MROWS * 1792 * 4;
constexpr size_t WS_QN    = WS_GATE  + (size_t)MROWS * 2048 * 2;
constexpr size_t WS_CKV   = WS_QN    + (size_t)MROWS * 384 * 2;
constexpr size_t WS_LIN   = WS_CKV   + (size_t)MROWS * 256 * 2;
constexpr size_t WS_ZR    = WS_LIN   + (size_t)MROWS * 256 * 2;
constexpr size_t WS_ZK    = WS_ZR    + (size_t)MROWS * 512 * 4;
constexpr size_t WS_ZV    = WS_ZK    + (size_t)MROWS * 512 * 4;
constexpr size_t WS_KKN   = WS_ZV    + (size_t)MROWS * 512 * 4;
constexpr size_t WS_DEC   = WS_KKN   + (size_t)MROWS * 512 * 4;
constexpr size_t WS_K2    = WS_DEC   + (size_t)MROWS * 512 * 4;
constexpr size_t WS_B2    = WS_K2    + (size_t)MROWS * 512 * 4;
constexpr size_t WS_Y     = WS_B2    + (size_t)MROWS * 512 * 4;
constexpr size_t WS_GB    = WS_Y     + (size_t)MROWS * 512 * 4;
constexpr size_t WS_KN    = WS_GB    + (size_t)MROWS * 512 * 2;
constexpr size_t WS_KR    = WS_KN    + (size_t)NBATCH * KPITCH * 512 * 2;
constexpr size_t WS_VT    = WS_KR    + (size_t)NBATCH * KPITCH * 32 * 2;
constexpr size_t WS_Q     = WS_VT    + (size_t)NBATCH * 512 * KPITCH * 2;
constexpr size_t WS_QF    = WS_Q     + (size_t)MROWS * 768 * 2;
constexpr size_t WS_PART  = al256(WS_QF + (size_t)DECB * 8 * 288 * 2);
constexpr size_t WS_O     = al256(WS_PART + (size_t)1024 * 8 * 260 * 4);
constexpr size_t WS_ORW   = WS_O     + (size_t)MROWS * 512 * 2;
constexpr size_t WS_MRG   = WS_ORW   + (size_t)MROWS * 512 * 2;
constexpr size_t WS_X1    = WS_MRG   + (size_t)MROWS * 1024 * 2;
constexpr size_t WS_X1B   = WS_X1    + (size_t)MROWS * 1024 * 4;
constexpr size_t WS_ACT   = WS_X1B   + (size_t)MROWS * 1024 * 2;
constexpr size_t WS_X2    = WS_ACT   + (size_t)MROWS * 4096 * 2;
constexpr size_t WS_END   = WS_X2    + (size_t)MROWS * 1024 * 4;

constexpr size_t OUT_YP  = 0;
constexpr size_t OUT_YS  = OUT_YP  + (size_t)NBATCH * SEQ * DM;
constexpr size_t OUT_KVP = OUT_YS  + (size_t)DECB * DM;
constexpr size_t OUT_WKVP= OUT_KVP + (size_t)NBATCH * TPOS * KVW;
constexpr size_t OUT_SHP = OUT_WKVP+ (size_t)NBATCH * 8 * 64 * 64;
constexpr size_t OUT_KVS = OUT_SHP + (size_t)NBATCH * RWCOLS;
constexpr size_t OUT_WKVS= OUT_KVS + (size_t)DECB * KVW;
constexpr size_t OUT_SHS = OUT_WKVS+ (size_t)DECB * 8 * 64 * 64;
constexpr size_t OUT_END = OUT_SHS + (size_t)DECB * RWCOLS;

enum { I_XP = 0, I_XS, I_CACHE, I_PT, I_SWKV, I_SSHIFT, I_META, I_GFINAL, I_GMIX, I_WIN, I_GQ, I_WUQ, I_GKV, I_WUK, I_WUV, I_WOM, I_MU, I_W0, I_W2, I_A0, I_A2, I_G2,
       I_KK, I_KA, I_RK, I_LNW, I_LNB, I_WOR, I_WOUT, I_GFFN, I_WUP, I_WDN, N_IN };

struct Args { const void* in[N_IN]; float* out; unsigned char* ws; int ph_lo, ph_hi; };
#define INF(i) ((const float*)A.in[i])
#define WSP(T, off) ((T*)(A.ws + (off)))

__device__ __forceinline__ unsigned pk_bf16(float lo, float hi) { f32x2_t v = {lo, hi}; bf16x2_t b = __builtin_convertvector(v, bf16x2_t); return __builtin_bit_cast(unsigned, b); }
__device__ __forceinline__ bf16_t f2bf(float f) { return (bf16_t)(pk_bf16(f, 0.f) & 0xffffu); }
__device__ __forceinline__ float bf2f(bf16_t b) { return __uint_as_float((unsigned)b << 16); }
__device__ __forceinline__ u32x2 pk4(f32x4 v) { u32x2 r; r.x = pk_bf16(v[0], v[1]); r.y = pk_bf16(v[2], v[3]); return r; }
__device__ __forceinline__ float sigmoidf_(float x) { return __builtin_amdgcn_rcpf(1.0f + __expf(-x)); }
__device__ __forceinline__ float wave_sum(float v) {
#pragma unroll
    for (int o = 1; o < 64; o <<= 1) v += __shfl_xor(v, o);
    return v;
}
__device__ __forceinline__ float dpp_f(float x, const int ctrl_sel) {
    int xi = __builtin_bit_cast(int, x), r;
    if (ctrl_sel == 0) r = __builtin_amdgcn_update_dpp(0, xi, 0xB1, 0xF, 0xF, true);
    else if (ctrl_sel == 1) r = __builtin_amdgcn_update_dpp(0, xi, 0x4E, 0xF, 0xF, true);
    else if (ctrl_sel == 2) r = __builtin_amdgcn_update_dpp(0, xi, 0x141, 0xF, 0xF, true);
    else r = __builtin_amdgcn_update_dpp(0, xi, 0x140, 0xF, 0xF, true);
    return __builtin_bit_cast(float, r);
}
__device__ __forceinline__ float row16_sum(float x) { x += dpp_f(x, 0); x += dpp_f(x, 1); x += dpp_f(x, 2); x += dpp_f(x, 3); return x; }

struct XSrc { const float* xp; const float* meta; const float* xs; };
__device__ __forceinline__ const float* xrow_ptr(const XSrc& X, int row) {
    if (row < MMAIN) return X.xp + (size_t)row * DM;
    if (row < ROW_SAMP) return X.meta + (size_t)(row - ROW_META) * DM;
    if (row < ROW_PAD) return X.xs + (size_t)(row - ROW_SAMP) * DM;
    return nullptr;
}
__device__ __forceinline__ int rope_idx(int row) {
    if (row < MMAIN) return NMETA + (row & (SEQ - 1));
    if (row < ROW_SAMP) return row - ROW_META;
    if (row < ROW_PAD) return ROPE_SAMP;
    return 0;
}

__device__ __forceinline__ int win_cmap(int n) {
    if (n < 256) return 384 + n;
    if (n < 640) return n - 256;
    if (n < 672) return n;
    if (n < 768) return -1;
    return n - 96;
}
struct TJob { const float* src; int ldsrc; const float* kscale; bf16_t* dst; int ldd; int N, K; int mode; };
__device__ __forceinline__ void transpose_tile(const TJob& J, int tile, LAS float* scr) {
    const int ntk = J.K >> 6, tn = tile / ntk, tk = tile - tn * ntk, tid = threadIdx.x;
    {
        const int n_l = tid & 63, k0 = tid >> 6, n = tn * 64 + n_l, c = J.mode ? win_cmap(n) : n;
#pragma unroll
        for (int i = 0; i < 8; ++i) {
            const int k_l = k0 + 8 * i, k = tk * 64 + k_l;
            float v = 0.f;
            if (c >= 0) { v = J.src[(size_t)k * J.ldsrc + c]; if (J.kscale) v *= J.kscale[k]; }
            scr[k_l * 65 + n_l] = v;
        }
    }
    __syncthreads();
    {
        const int k_l = tid & 63, n0 = tid >> 6;
#pragma unroll
        for (int i = 0; i < 8; ++i) {
            const int n_l = n0 + 8 * i;
            J.dst[(size_t)(tn * 64 + n_l) * J.ldd + tk * 64 + k_l] = f2bf(scr[k_l * 65 + n_l]);
        }
    }
    __syncthreads();
}
constexpr int NJOBS = 12;
__device__ __forceinline__ TJob get_job(const Args& A, int j) {
    TJob J; J.kscale = nullptr; J.mode = 0;
    switch (j) {
    case 0:  J.src = INF(I_WIN);  J.ldsrc = INCOLS; J.kscale = INF(I_GMIX); J.dst = WSP(bf16_t, WS_WIN); J.ldd = 1024; J.N = INPAD; J.K = 1024; J.mode = 1; break;
    case 1:  J.src = INF(I_WUQ);  J.ldsrc = 768;  J.kscale = INF(I_GQ); J.dst = WSP(bf16_t, WS_WUQ); J.ldd = 384; J.N = 768; J.K = 384; break;
    case 2:  J.src = INF(I_WUK);  J.ldsrc = 512;  J.dst = WSP(bf16_t, WS_WKV); J.ldd = 256; J.N = 512; J.K = 256; break;
    case 3:  J.src = INF(I_WUV);  J.ldsrc = 512;  J.dst = WSP(bf16_t, WS_WKV) + (size_t)512 * 256; J.ldd = 256; J.N = 512; J.K = 256; break;
    case 4:  J.src = INF(I_W2);   J.ldsrc = 512;  J.dst = WSP(bf16_t, WS_WLORA); J.ldd = 256; J.N = 512; J.K = 64; break;
    case 5:  J.src = INF(I_A2);   J.ldsrc = 512;  J.dst = WSP(bf16_t, WS_WLORA) + (size_t)512 * 256 + 64; J.ldd = 256; J.N = 512; J.K = 64; break;
    case 6:  J.src = INF(I_G2);   J.ldsrc = 512;  J.dst = WSP(bf16_t, WS_WLORA) + (size_t)1024 * 256 + 128; J.ldd = 256; J.N = 512; J.K = 128; break;
    case 7:  J.src = INF(I_WOM);  J.ldsrc = 1024; J.dst = WSP(bf16_t, WS_WOM); J.ldd = 512; J.N = 1024; J.K = 512; break;
    case 8:  J.src = INF(I_WOR);  J.ldsrc = 1024; J.dst = WSP(bf16_t, WS_WOR); J.ldd = 512; J.N = 1024; J.K = 512; break;
    case 9:  J.src = INF(I_WOUT); J.ldsrc = 1024; J.dst = WSP(bf16_t, WS_WOUT); J.ldd = 1024; J.N = 1024; J.K = 1024; break;
    case 10: J.src = INF(I_WUP);  J.ldsrc = 4096; J.kscale = INF(I_GFFN); J.dst = WSP(bf16_t, WS_WUP); J.ldd = 1024; J.N = 4096; J.K = 1024; break;
    default: J.src = INF(I_WDN);  J.ldsrc = 1024; J.dst = WSP(bf16_t, WS_WDN); J.ldd = 4096; J.N = 1024; J.K = 4096; break;
    }
    return J;
}
__device__ __forceinline__ void p0_prologue(const Args& A, LAS unsigned char* lds) {
    const int tid = threadIdx.x, lane = tid & 63, wid = tid >> 6, G = gridDim.x;
    {
        int base = 0;
        for (int j = 0; j < NJOBS; ++j) {
            const TJob J = get_job(A, j);
            const int nt = (J.N >> 6) * (J.K >> 6);
            int t = ((int)blockIdx.x - base % G + G) % G;
            for (; t < nt; t += G) transpose_tile(J, t, (LAS float*)lds);
            base += nt;
        }
    }
    const int gtid = blockIdx.x * NTHREADS + tid, gthreads = G * NTHREADS;
    for (int i = gtid; i < 1536 * 256; i += gthreads) {
        const int n = i >> 8, k = i & 255, blk = n >> 9;
        const bool nz = (blk == 0) ? (k < 64) : (blk == 1) ? (k >= 64 && k < 128) : (k >= 128);
        if (!nz) WSP(bf16_t, WS_WLORA)[i] = 0;
    }
    for (int i = gtid; i < 2048 * 384; i += gthreads) {
        const int k = i % 384, n = i / 384, h = n >> 8, c = n & 255;
        const float* a = INF(I_WUQ) + (size_t)k * 768 + h * 96;
        const float* b = INF(I_WUK) + (size_t)c * 512 + h * 64;
        float s = 0.f;
#pragma unroll
        for (int q = 0; q < 16; ++q) { const f32x4 av = *(const f32x4*)(a + 4 * q), bv = *(const f32x4*)(b + 4 * q); s += av[0] * bv[0] + av[1] * bv[1] + av[2] * bv[2] + av[3] * bv[3]; }
        WSP(bf16_t, WS_WQABS)[i] = f2bf(s * INF(I_GQ)[k]);
    }
    for (int i = gtid; i < 2065 * 16; i += gthreads) {
        const int idx = i >> 4, f = i & 15;
        const double pos = (idx == ROPE_SAMP) ? (double)PASTLEN : (double)idx;
        const double ang = pos * pow(10000.0, -(double)f / 16.0);
        WSP(float, WS_ROPE)[idx * 32 + f] = (float)cos(ang);
        WSP(float, WS_ROPE)[idx * 32 + 16 + f] = (float)sin(ang);
    }
    for (int row = blockIdx.x * NWAVES + wid; row < MROWS; row += G * NWAVES) {
        const XSrc XS{INF(I_XP), INF(I_META), INF(I_XS)};
        const float* xr = xrow_ptr(XS, row);
        bf16_t* o = WSP(bf16_t, WS_XB) + (size_t)row * DM;
        f32x4 v[4]; float ss = 0.f;
#pragma unroll
        for (int i = 0; i < 4; ++i) { v[i] = xr ? *(const f32x4*)(xr + i * 256 + lane * 4) : (f32x4){0.f, 0.f, 0.f, 0.f}; ss += v[i][0] * v[i][0] + v[i][1] * v[i][1] + v[i][2] * v[i][2] + v[i][3] * v[i][3]; }
        ss = wave_sum(ss);
        const float rs = rsqrtf(ss * (1.0f / DM) + NORM_EPS);
#pragma unroll
        for (int i = 0; i < 4; ++i) *(u32x2*)(o + i * 256 + lane * 4) = pk4(v[i] * rs);
    }
}

#define EPI_ROWS_BEGIN _Pragma("unroll") for (int ai = 0; ai < 2; ++ai) _Pragma("unroll") for (int m = 0; m < 4; ++m) { const int row = u.pm * 256 + ai * 128 + wr * 64 + m * 16 + fr;
#define EPI_COLS_BEGIN _Pragma("unroll") for (int bj = 0; bj < 2; ++bj) _Pragma("unroll") for (int n = 0; n < 2; ++n) { const int col = u.pn * 256 + bj * 128 + wc * 32 + n * 16 + fq * 4; const f32x4 v = acc[ai][bj][m][n];
#define EPI_END }

struct EpiG1 {
    static constexpr bool PERM = false, AFTER_DRAIN = false;
    float* zs; float* rw; bf16_t* gate;
    __device__ __forceinline__ void operator()(const f32x4 (&acc)[2][2][4][2], const Unit& u, int wr, int wc, int fr, int fq) const {
        EPI_ROWS_BEGIN
            EPI_COLS_BEGIN
                if (u.pn < 3) *(f32x4*)(zs + (size_t)row * 768 + col) = v;
                else if (u.pn < 10) *(f32x4*)(rw + (size_t)row * RWCOLS + (col - 768)) = v;
                else { f32x4 s; s[0] = sigmoidf_(v[0]); s[1] = sigmoidf_(v[1]); s[2] = sigmoidf_(v[2]); s[3] = sigmoidf_(v[3]); *(u32x2*)(gate + (size_t)row * 2048 + (col - 2560)) = pk4(s); }
            EPI_END
        EPI_END
    }
};
struct EpiKV {
    static constexpr bool PERM = false, AFTER_DRAIN = false;
    bf16_t* kn; bf16_t* vt;
    __device__ __forceinline__ void operator()(const f32x4 (&acc)[2][2][4][2], const Unit& u, int wr, int wc, int fr, int fq) const {
        EPI_ROWS_BEGIN
            int b0, b1, pos;
            if (row < MMAIN) { b0 = row >> 11; b1 = b0 + 1; pos = NMETA + (row & (SEQ - 1)); }
            else if (row < ROW_SAMP) { b0 = 0; b1 = NBATCH; pos = row - ROW_META; }
            else { b0 = 0; b1 = 0; pos = 0; }
            EPI_COLS_BEGIN
                if (u.pn < 2) { const u32x2 w = pk4(v); for (int b = b0; b < b1; ++b) *(u32x2*)(kn + ((size_t)b * KPITCH + pos) * 512 + col) = w; }
                else { const int hv = col - 512;
                    for (int b = b0; b < b1; ++b) { bf16_t* p = vt + ((size_t)b * 512 + hv) * KPITCH + pos;
                        p[0] = f2bf(v[0]); p[KPITCH] = f2bf(v[1]); p[2 * KPITCH] = f2bf(v[2]); p[3 * KPITCH] = f2bf(v[3]); } }
            EPI_END
        EPI_END
    }
};
struct EpiLora {
    static constexpr bool PERM = false, AFTER_DRAIN = false;
    const float* w0; const float* a0; const float* k_a; const float* zk; const float* kkn; float* dec; float* k2; float* b2; bf16_t* gb;
    __device__ __forceinline__ void operator()(const f32x4 (&acc)[2][2][4][2], const Unit& u, int wr, int wc, int fr, int fq) const {
        EPI_ROWS_BEGIN
            EPI_COLS_BEGIN
                if (u.pn < 2) {
                    const f32x4 w = *(const f32x4*)(w0 + col); f32x4 d;
#pragma unroll
                    for (int e = 0; e < 4; ++e) d[e] = __expf(-0.6065306597126334f * sigmoidf_(w[e] + v[e]));
                    *(f32x4*)(dec + (size_t)row * 512 + col) = d;
                } else if (u.pn < 4) {
                    const int c = col - 512;
                    const f32x4 a0v = *(const f32x4*)(a0 + c), kav = *(const f32x4*)(k_a + c), zkv = *(const f32x4*)(zk + (size_t)row * 512 + c), nk = *(const f32x4*)(kkn + (size_t)row * 512 + c);
                    f32x4 ko, bo;
#pragma unroll
                    for (int e = 0; e < 4; ++e) { const float a = sigmoidf_(a0v[e] + v[e]); ko[e] = zkv[e] * (1.0f + (a - 1.0f) * kav[e]); bo[e] = -nk[e] * a; }
                    *(f32x4*)(k2 + (size_t)row * 512 + c) = ko; *(f32x4*)(b2 + (size_t)row * 512 + c) = bo;
                } else {
                    *(u32x2*)(gb + (size_t)row * 512 + (col - 1024)) = pk4(v);
                }
            EPI_END
        EPI_END
    }
};
struct EpiQ {
    static constexpr bool PERM = false, AFTER_DRAIN = false;
    bf16_t* q; bf16_t* qf; const float* rope;
    __device__ __forceinline__ void operator()(const f32x4 (&acc)[2][2][4][2], const Unit& u, int wr, int wc, int fr, int fq) const {
        EPI_ROWS_BEGIN
            const int ri = rope_idx(row);
#pragma unroll
            for (int bj = 0; bj < 2; ++bj) {
                const int cb = u.pn * 256 + bj * 128 + wc * 32;
                const int g32 = cb >> 5, h = g32 / 3, part = g32 - 3 * h;
                f32x4 v0 = acc[ai][bj][m][0] * QSCALE, v1 = acc[ai][bj][m][1] * QSCALE;
                if (part == 2) {
                    const f32x4 cs = *(const f32x4*)(rope + ri * 32 + fq * 4), sn = *(const f32x4*)(rope + ri * 32 + 16 + fq * 4);
                    const f32x4 o0 = v0 * cs - v1 * sn, o1 = v0 * sn + v1 * cs; v0 = o0; v1 = o1;
                    if (row >= ROW_SAMP && row < ROW_PAD) { bf16_t* p = qf + ((size_t)(row - ROW_SAMP) * 8 + h) * 288 + 256 + fq * 4; *(u32x2*)p = pk4(v0); *(u32x2*)(p + 16) = pk4(v1); }
                }
                bf16_t* p = q + (size_t)row * 768 + cb + fq * 4;
                *(u32x2*)p = pk4(v0); *(u32x2*)(p + 16) = pk4(v1);
            }
        EPI_END
    }
};
struct EpiQabs {
    static constexpr bool PERM = false, AFTER_DRAIN = false;
    bf16_t* qf;
    __device__ __forceinline__ void operator()(const f32x4 (&acc)[2][2][4][2], const Unit& u, int wr, int wc, int fr, int fq) const {
        EPI_ROWS_BEGIN
            const int sb = row - (ROW_SAMP - ROW_META);
            EPI_COLS_BEGIN
                if (sb >= 0 && sb < DECB) { const int h = col >> 8, c = col & 255; *(u32x2*)(qf + ((size_t)sb * 8 + h) * 288 + c) = pk4(v * QSCALE); }
            EPI_END
        EPI_END
    }
};
struct EpiG4 {
    static constexpr bool PERM = false, AFTER_DRAIN = false;
    const bf16_t* gate; bf16_t* mrg;
    __device__ __forceinline__ void operator()(const f32x4 (&acc)[2][2][4][2], const Unit& u, int wr, int wc, int fr, int fq) const {
        EPI_ROWS_BEGIN
            EPI_COLS_BEGIN
                const u32x2 g = *(const u32x2*)(gate + (size_t)row * 2048 + col);
                f32x4 o; o[0] = v[0] * __uint_as_float(g.x << 16); o[1] = v[1] * __uint_as_float(g.x & 0xffff0000u); o[2] = v[2] * __uint_as_float(g.y << 16); o[3] = v[3] * __uint_as_float(g.y & 0xffff0000u);
                *(u32x2*)(mrg + (size_t)row * 1024 + col) = pk4(o);
            EPI_END
        EPI_END
    }
};
struct EpiG5 {
    static constexpr bool PERM = false, AFTER_DRAIN = false;
    const bf16_t* gate; bf16_t* mrg;
    __device__ __forceinline__ void operator()(const f32x4 (&acc)[2][2][4][2], const Unit& u, int wr, int wc, int fr, int fq) const {
        EPI_ROWS_BEGIN
            EPI_COLS_BEGIN
                const u32x2 g = *(const u32x2*)(gate + (size_t)row * 2048 + 1024 + col);
                const u32x2 t = *(const u32x2*)(mrg + (size_t)row * 1024 + col);
                f32x4 o; o[0] = __uint_as_float(t.x << 16) + v[0] * __uint_as_float(g.x << 16); o[1] = __uint_as_float(t.x & 0xffff0000u) + v[1] * __uint_as_float(g.x & 0xffff0000u);
                o[2] = __uint_as_float(t.y << 16) + v[2] * __uint_as_float(g.y << 16); o[3] = __uint_as_float(t.y & 0xffff0000u) + v[3] * __uint_as_float(g.y & 0xffff0000u);
                *(u32x2*)(mrg + (size_t)row * 1024 + col) = pk4(o);
            EPI_END
        EPI_END
    }
};
struct EpiG6 {
    static constexpr bool PERM = false, AFTER_DRAIN = false;
    XSrc X; float* x1; bf16_t* x1b; float* ssq;
    __device__ __forceinline__ void operator()(const f32x4 (&acc)[2][2][4][2], const Unit& u, int wr, int wc, int fr, int fq) const {
        EPI_ROWS_BEGIN
            const float* xr = xrow_ptr(X, row); float ss = 0.f;
            EPI_COLS_BEGIN
                const f32x4 xv = xr ? *(const f32x4*)(xr + col) : (f32x4){0.f, 0.f, 0.f, 0.f};
                const f32x4 o = xv + v;
                ss += o[0] * o[0] + o[1] * o[1] + o[2] * o[2] + o[3] * o[3];
                *(f32x4*)(x1 + (size_t)row * 1024 + col) = o; *(u32x2*)(x1b + (size_t)row * 1024 + col) = pk4(o);
            EPI_END
            ss += __shfl_xor(ss, 16); ss += __shfl_xor(ss, 32);
            if (fq == 0) atomicAdd(ssq + row, ss);
        EPI_END
    }
};
struct EpiG7 {
    static constexpr bool PERM = false, AFTER_DRAIN = false;
    const float* ssq; bf16_t* act;
    __device__ __forceinline__ void operator()(const f32x4 (&acc)[2][2][4][2], const Unit& u, int wr, int wc, int fr, int fq) const {
        EPI_ROWS_BEGIN
            const float rs = rsqrtf(ssq[row] * (1.0f / DM) + NORM_EPS);
            EPI_COLS_BEGIN
                f32x4 o;
#pragma unroll
                for (int e = 0; e < 4; ++e) { const float t = fmaxf(v[e] * rs, 0.f); o[e] = t * t; }
                *(u32x2*)(act + (size_t)row * DFF + col) = pk4(o);
            EPI_END
        EPI_END
    }
};
struct EpiG8 {
    static constexpr bool PERM = false, AFTER_DRAIN = false;
    const float* x1; float* x2; float* ssq;
    __device__ __forceinline__ void operator()(const f32x4 (&acc)[2][2][4][2], const Unit& u, int wr, int wc, int fr, int fq) const {
        EPI_ROWS_BEGIN
            float ss = 0.f;
            EPI_COLS_BEGIN
                const f32x4 o = *(const f32x4*)(x1 + (size_t)row * 1024 + col) + v;
                ss += o[0] * o[0] + o[1] * o[1] + o[2] * o[2] + o[3] * o[3];
                *(f32x4*)(x2 + (size_t)row * 1024 + col) = o;
            EPI_END
            ss += __shfl_xor(ss, 16); ss += __shfl_xor(ss, 32);
            if (fq == 0) atomicAdd(ssq + row, ss);
        EPI_END
    }
};

__device__ __forceinline__ void p2a_rows(const Args& A) {
    const int tid = threadIdx.x, lane = tid & 63, wid = tid >> 6, G = gridDim.x;
    const float* zs = WSP(float, WS_ZS); const float* rw = WSP(float, WS_RW); const float* rope = WSP(float, WS_ROPE);
    for (int row = blockIdx.x * NWAVES + wid; row < MROWS; row += G * NWAVES) {
        bf16_t* qn = WSP(bf16_t, WS_QN) + (size_t)row * 384; bf16_t* ckv = WSP(bf16_t, WS_CKV) + (size_t)row * 256; bf16_t* lin = WSP(bf16_t, WS_LIN) + (size_t)row * 256;
        if (row >= ROW_PAD) {
            *(u32x2*)(qn + lane * 4) = (u32x2){0u, 0u}; *(unsigned*)(qn + 256 + lane * 2) = 0u; *(u32x2*)(ckv + lane * 4) = (u32x2){0u, 0u}; *(u32x2*)(lin + lane * 4) = (u32x2){0u, 0u};
            continue;
        }
        int kind, b = 0, pos, ri; const float* prev;
        if (row < MMAIN) { kind = 0; b = row >> 11; const int t = row & (SEQ - 1); pos = NMETA + t; ri = pos; prev = rw + (size_t)(t == 0 ? ROW_META + NMETA - 1 : row - 1) * RWCOLS; }
        else if (row < ROW_SAMP) { kind = 1; pos = row - ROW_META; ri = pos; prev = (pos == 0) ? nullptr : rw + (size_t)(row - 1) * RWCOLS; }
        else { kind = 2; b = row - ROW_SAMP; pos = 0; ri = ROPE_SAMP; prev = INF(I_SSHIFT) + (size_t)b * RWCOLS; }
        const float* z = zs + (size_t)row * 768;
        {
            const f32x4 kv = *(const f32x4*)(z + lane * 4);
            const float ss = wave_sum(kv[0] * kv[0] + kv[1] * kv[1] + kv[2] * kv[2] + kv[3] * kv[3]);
            const float rs = rsqrtf(ss * (1.0f / KVLORA) + NORM_EPS);
            const f32x4 c = kv * rs * *(const f32x4*)(INF(I_GKV) + lane * 4);
            *(u32x2*)(ckv + lane * 4) = pk4(c);
            if (kind == 0) *(f32x4*)(A.out + OUT_KVP + ((size_t)b * TPOS + pos) * KVW + lane * 4) = c;
            else if (kind == 1) { for (int bb = 0; bb < NBATCH; ++bb) *(f32x4*)(A.out + OUT_KVP + ((size_t)bb * TPOS + pos) * KVW + lane * 4) = c; }
            else *(f32x4*)(A.out + OUT_KVS + (size_t)b * KVW + lane * 4) = c;
        }
        {
            const f32x4 q0 = *(const f32x4*)(z + 256 + lane * 4); const f32x2_t q1 = *(const f32x2_t*)(z + 512 + lane * 2);
            const float ss = wave_sum(q0[0] * q0[0] + q0[1] * q0[1] + q0[2] * q0[2] + q0[3] * q0[3] + q1[0] * q1[0] + q1[1] * q1[1]);
            const float rs = rsqrtf(ss * (1.0f / QLORA) + NORM_EPS);
            *(u32x2*)(qn + lane * 4) = pk4(q0 * rs); *(unsigned*)(qn + 256 + lane * 2) = pk_bf16(q1[0] * rs, q1[1] * rs);
        }
        if (lane < 16) {
            const float x1 = z[640 + lane], x2 = z[656 + lane], cs = rope[ri * 32 + lane], sn = rope[ri * 32 + 16 + lane];
            const float o1 = x1 * cs - x2 * sn, o2 = x1 * sn + x2 * cs;
            if (kind == 2) { float* o = A.out + OUT_KVS + (size_t)b * KVW + 256; o[lane] = o1; o[16 + lane] = o2; }
            else {
                const int b0 = (kind == 0) ? b : 0, b1 = (kind == 0) ? b + 1 : NBATCH;
                for (int bb = b0; bb < b1; ++bb) {
                    float* o = A.out + OUT_KVP + ((size_t)bb * TPOS + pos) * KVW + 256; o[lane] = o1; o[16 + lane] = o2;
                    bf16_t* kr = WSP(bf16_t, WS_KR) + ((size_t)bb * KPITCH + pos) * 32; kr[lane] = f2bf(o1); kr[16 + lane] = f2bf(o2);
                }
            }
        }
        {
            const float* c = rw + (size_t)row * RWCOLS; const float* mu = INF(I_MU);
            float* shout = (kind == 0 && (row & (SEQ - 1)) == SEQ - 1) ? A.out + OUT_SHP + (size_t)b * RWCOLS : (kind == 2) ? A.out + OUT_SHS + (size_t)b * RWCOLS : nullptr;
#pragma unroll
            for (int j = 0; j < 7; ++j) {
                const int col = 4 * (lane + 64 * j);
                const f32x4 cc = *(const f32x4*)(c + col), pp = prev ? *(const f32x4*)(prev + col) : (f32x4){0.f, 0.f, 0.f, 0.f}, mm = *(const f32x4*)(mu + col);
                const f32x4 zz = cc + (pp - cc) * mm;
                if (shout) *(f32x4*)(shout + col) = cc;
                if (j < 2) *(f32x4*)(WSP(float, WS_ZR) + (size_t)row * 512 + col) = zz;
                else if (j < 4) {
                    const int c2 = col - 512;
                    *(f32x4*)(WSP(float, WS_ZK) + (size_t)row * 512 + c2) = zz;
                    const f32x4 kk = zz * *(const f32x4*)(INF(I_KK) + c2);
                    const float ss = row16_sum(kk[0] * kk[0] + kk[1] * kk[1] + kk[2] * kk[2] + kk[3] * kk[3]);
                    const float inv = -1.0f / fmaxf(sqrtf(ss), 1e-12f);
                    *(f32x4*)(WSP(float, WS_KKN) + (size_t)row * 512 + c2) = kk * inv;
                } else if (j < 6) *(f32x4*)(WSP(float, WS_ZV) + (size_t)row * 512 + (col - 1024)) = zz;
                else {
                    f32x4 o;
                    if (lane < 16) { for (int e = 0; e < 4; ++e) o[e] = tanhf(zz[e]); }
                    else if (lane < 32) o = zz;
                    else { for (int e = 0; e < 4; ++e) o[e] = sigmoidf_(zz[e]); }
                    *(u32x2*)(lin + lane * 4) = pk4(o);
                }
            }
        }
    }
}

__device__ __forceinline__ void attn_unit(const Args& A, int b, int h, int qblk, int wid, int lane) {
    const int c = lane & 31, hh = lane >> 5;
    const int qrow = b * SEQ + qblk * 256 + wid * 32 + c, qpos = NMETA + qblk * 256 + wid * 32 + c;
    const bf16_t* qp = WSP(bf16_t, WS_Q) + (size_t)qrow * 768 + h * 96 + 8 * hh;
    bf16x8 qf[6];
#pragma unroll
    for (int s = 0; s < 6; ++s) qf[s] = *(const bf16x8*)(qp + 16 * s);
    f32x16 o0, o1;
#pragma unroll
    for (int i = 0; i < 16; ++i) { o0[i] = 0.f; o1[i] = 0.f; }
    float mrun = -1e30f, lrun = 0.f;
    const int nkt = 8 * qblk + wid + 2;
    const bf16_t* kn = WSP(bf16_t, WS_KN) + (size_t)b * KPITCH * 512 + h * 64 + 8 * hh;
    const bf16_t* kr = WSP(bf16_t, WS_KR) + (size_t)b * KPITCH * 32 + 8 * hh;
    const bf16_t* vt = WSP(bf16_t, WS_VT) + ((size_t)(b * 8 + h) * 64 + c) * KPITCH + 4 * hh;
    const int qmin = NMETA + qblk * 256 + wid * 32;
    for (int kt = 0; kt < nkt; ++kt) {
        const int kpos = 32 * kt + c;
        bf16x8 kf[6];
#pragma unroll
        for (int s = 0; s < 4; ++s) kf[s] = *(const bf16x8*)(kn + (size_t)kpos * 512 + 16 * s);
#pragma unroll
        for (int s = 0; s < 2; ++s) kf[4 + s] = *(const bf16x8*)(kr + (size_t)kpos * 32 + 16 * s);
        u32x2 vlo[2][2], vhi[2][2];
#pragma unroll
        for (int mt = 0; mt < 2; ++mt)
#pragma unroll
            for (int s = 0; s < 2; ++s) { const bf16_t* p = vt + (size_t)(32 * mt) * KPITCH + 32 * kt + 16 * s; vlo[mt][s] = *(const u32x2*)p; vhi[mt][s] = *(const u32x2*)(p + 8); }
        f32x16 sa;
#pragma unroll
        for (int i = 0; i < 16; ++i) sa[i] = 0.f;
#pragma unroll
        for (int s = 0; s < 6; ++s) sa = __builtin_amdgcn_mfma_f32_32x32x16_bf16(kf[s], qf[s], sa, 0, 0, 0);
        if (32 * kt + 31 > qmin) {
#pragma unroll
            for (int i = 0; i < 16; ++i) { const int key = 32 * kt + (i & 3) + 8 * (i >> 2) + 4 * hh; if (key > qpos) sa[i] = -1e30f; }
        }
        float mx = sa[0];
#pragma unroll
        for (int i = 1; i < 16; ++i) mx = fmaxf(mx, sa[i]);
        mx = fmaxf(mx, __shfl_xor(mx, 32));
        const float mnew = fmaxf(mrun, mx), alpha = exp2f(mrun - mnew);
        float ps = 0.f;
#pragma unroll
        for (int i = 0; i < 16; ++i) { sa[i] = exp2f(sa[i] - mnew); ps += sa[i]; }
        ps += __shfl_xor(ps, 32);
        lrun = lrun * alpha + ps; mrun = mnew;
        o0 *= alpha; o1 *= alpha;
#pragma unroll
        for (int s = 0; s < 2; ++s) {
            u32x4 pw; pw[0] = pk_bf16(sa[8 * s], sa[8 * s + 1]); pw[1] = pk_bf16(sa[8 * s + 2], sa[8 * s + 3]); pw[2] = pk_bf16(sa[8 * s + 4], sa[8 * s + 5]); pw[3] = pk_bf16(sa[8 * s + 6], sa[8 * s + 7]);
            const bf16x8 pf = __builtin_bit_cast(bf16x8, pw);
            u32x4 v0w; v0w[0] = vlo[0][s].x; v0w[1] = vlo[0][s].y; v0w[2] = vhi[0][s].x; v0w[3] = vhi[0][s].y;
            u32x4 v1w; v1w[0] = vlo[1][s].x; v1w[1] = vlo[1][s].y; v1w[2] = vhi[1][s].x; v1w[3] = vhi[1][s].y;
            o0 = __builtin_amdgcn_mfma_f32_32x32x16_bf16(__builtin_bit_cast(bf16x8, v0w), pf, o0, 0, 0, 0);
            o1 = __builtin_amdgcn_mfma_f32_32x32x16_bf16(__builtin_bit_cast(bf16x8, v1w), pf, o1, 0, 0, 0);
        }
    }
    const float inv = 1.0f / lrun;
    bf16_t* op = WSP(bf16_t, WS_O) + (size_t)qrow * 512 + h * 64 + 4 * hh;
#pragma unroll
    for (int g = 0; g < 4; ++g) {
        *(u32x2*)(op + 8 * g) = pk4((f32x4){o0[4 * g] * inv, o0[4 * g + 1] * inv, o0[4 * g + 2] * inv, o0[4 * g + 3] * inv});
        *(u32x2*)(op + 32 + 8 * g) = pk4((f32x4){o1[4 * g] * inv, o1[4 * g + 1] * inv, o1[4 * g + 2] * inv, o1[4 * g + 3] * inv});
    }
}
__device__ __forceinline__ void p3_attention(const Args& A) {
    const int tid = threadIdx.x, lane = tid & 63, wid = tid >> 6;
    for (int p = blockIdx.x; p < 256; p += gridDim.x) {
        const int b = p >> 5, h = (p >> 2) & 7, qq = p & 3;
        attn_unit(A, b, h, 7 - qq, wid, lane);
        attn_unit(A, b, h, qq, wid, lane);
    }
}

__device__ __forceinline__ void scan_sample_step(const Args& A, int slot, int lane) {
    const int sb = slot >> 3, h = slot & 7, rho = lane >> 4, kq = lane & 15, row = ROW_SAMP + sb;
    const size_t vo = (size_t)row * 512 + h * 64;
    const f32x4 rr = *(const f32x4*)(WSP(float, WS_ZR) + vo + 4 * kq), ww = *(const f32x4*)(WSP(float, WS_DEC) + vo + 4 * kq), kk = *(const f32x4*)(WSP(float, WS_K2) + vo + 4 * kq),
                aa = *(const f32x4*)(WSP(float, WS_KKN) + vo + 4 * kq), bb = *(const f32x4*)(WSP(float, WS_B2) + vo + 4 * kq);
    const float* s0 = INF(I_SWKV) + (size_t)slot * 4096; float* s1 = A.out + OUT_WKVS + (size_t)slot * 4096;
#pragma unroll 4
    for (int i = 0; i < 16; ++i) {
        const int v = 4 * i + rho;
        f32x4 S = *(const f32x4*)(s0 + v * 64 + 4 * kq);
        const float vv = WSP(float, WS_ZV)[vo + v];
        const float sa = row16_sum(S[0] * aa[0] + S[1] * aa[1] + S[2] * aa[2] + S[3] * aa[3]);
        S = S * ww + sa * bb + vv * kk;
        const float y = row16_sum(S[0] * rr[0] + S[1] * rr[1] + S[2] * rr[2] + S[3] * rr[3]);
        *(f32x4*)(s1 + v * 64 + 4 * kq) = S;
        if (kq == 0) WSP(float, WS_Y)[vo + v] = y;
    }
}
__device__ __forceinline__ void scan_prompt(const Args& A, int slot, int lane) {
    const int bh = slot >> 4, rg = slot & 15, b = bh >> 3, h = bh & 7, rho = lane >> 4, kq = lane & 15, v = 4 * rg + rho;
    const float* pr = WSP(float, WS_ZR) + h * 64 + 4 * kq; const float* pw = WSP(float, WS_DEC) + h * 64 + 4 * kq; const float* pk = WSP(float, WS_K2) + h * 64 + 4 * kq;
    const float* pa = WSP(float, WS_KKN) + h * 64 + 4 * kq; const float* pb = WSP(float, WS_B2) + h * 64 + 4 * kq; const float* pv = WSP(float, WS_ZV) + h * 64 + v;
    float* py = WSP(float, WS_Y) + h * 64 + v;
    f32x4 S = {0.f, 0.f, 0.f, 0.f};
    f32x4 R[4], W[4], K[4], Aa[4], Bb[4]; float V[4];
    auto rowof = [&](int t) -> size_t { return (size_t)(t < NMETA ? ROW_META + t : b * SEQ + (t - NMETA)) * 512; };
#pragma unroll
    for (int i = 0; i < 4; ++i) { const size_t ro = rowof(i); R[i] = *(const f32x4*)(pr + ro); W[i] = *(const f32x4*)(pw + ro); K[i] = *(const f32x4*)(pk + ro); Aa[i] = *(const f32x4*)(pa + ro); Bb[i] = *(const f32x4*)(pb + ro); V[i] = pv[ro]; }
    for (int t0 = 0; t0 < TPOS; t0 += 4) {
        f32x4 Rn[4], Wn[4], Kn[4], An[4], Bn[4]; float Vn[4];
        const int tn = (t0 + 4 < TPOS) ? t0 + 4 : t0;
#pragma unroll
        for (int i = 0; i < 4; ++i) { const size_t ro = rowof(tn + i); Rn[i] = *(const f32x4*)(pr + ro); Wn[i] = *(const f32x4*)(pw + ro); Kn[i] = *(const f32x4*)(pk + ro); An[i] = *(const f32x4*)(pa + ro); Bn[i] = *(const f32x4*)(pb + ro); Vn[i] = pv[ro]; }
#pragma unroll
        for (int i = 0; i < 4; ++i) {
            const float sa = row16_sum(S[0] * Aa[i][0] + S[1] * Aa[i][1] + S[2] * Aa[i][2] + S[3] * Aa[i][3]);
            S = S * W[i] + sa * Bb[i] + V[i] * K[i];
            const float y = row16_sum(S[0] * R[i][0] + S[1] * R[i][1] + S[2] * R[i][2] + S[3] * R[i][3]);
            if (kq == 0) py[rowof(t0 + i)] = y;
        }
#pragma unroll
        for (int i = 0; i < 4; ++i) { R[i] = Rn[i]; W[i] = Wn[i]; K[i] = Kn[i]; Aa[i] = An[i]; Bb[i] = Bn[i]; V[i] = Vn[i]; }
    }
    *(f32x4*)(A.out + OUT_WKVP + ((size_t)bh * 64 + v) * 64 + 4 * kq) = S;
}

__device__ __forceinline__ void decode_item(const Args& A, int item, int lane) {
    const int sb = item >> 3, chunk = item & 7, c = lane & 15, q = lane >> 4;
    bf16x8 qb[9];
    {
        const bf16_t* qp = WSP(bf16_t, WS_QF) + ((size_t)sb * 8 + (c & 7)) * 288 + 8 * q;
#pragma unroll
        for (int s = 0; s < 9; ++s) { bf16x8 t = *(const bf16x8*)(qp + 32 * s); if (c >= 8) { for (int e = 0; e < 8; ++e) t[e] = 0; } qb[s] = t; }
    }
    f32x4 acc[4][4];
#pragma unroll
    for (int i = 0; i < 4; ++i)
#pragma unroll
        for (int e = 0; e < 4; ++e) acc[i][e] = (f32x4){0.f, 0.f, 0.f, 0.f};
    float mrun = -1e30f, lpart = 0.f;
    const int* pt = (const int*)A.in[I_PT] + sb * NPAGES + chunk * 8;
    for (int pg = 0; pg < 8; ++pg) {
        const float* page = INF(I_CACHE) + (size_t)pt[pg] * (PAGESZ * KVW);
        for (int kc = 0; kc < 4; ++kc) {
            const float* kb = page + (size_t)(32 * kc) * KVW;
            f32x4 st[2];
#pragma unroll
            for (int t = 0; t < 2; ++t) {
                const float* rp = kb + (size_t)(16 * t + c) * KVW + 8 * q;
                f32x4 s4 = {0.f, 0.f, 0.f, 0.f};
#pragma unroll
                for (int s = 0; s < 9; ++s) {
                    const f32x4 x0 = *(const f32x4*)(rp + 32 * s), x1 = *(const f32x4*)(rp + 32 * s + 4);
                    u32x4 w; w[0] = pk_bf16(x0[0], x0[1]); w[1] = pk_bf16(x0[2], x0[3]); w[2] = pk_bf16(x1[0], x1[1]); w[3] = pk_bf16(x1[2], x1[3]);
                    s4 = __builtin_amdgcn_mfma_f32_16x16x32_bf16(__builtin_bit_cast(bf16x8, w), qb[s], s4, 0, 0, 0);
                }
                st[t] = s4;
            }
            float mx = fmaxf(fmaxf(fmaxf(st[0][0], st[0][1]), fmaxf(st[0][2], st[0][3])), fmaxf(fmaxf(st[1][0], st[1][1]), fmaxf(st[1][2], st[1][3])));
            mx = fmaxf(mx, __shfl_xor(mx, 16)); mx = fmaxf(mx, __shfl_xor(mx, 32));
            const float mnew = fmaxf(mrun, mx), alpha = exp2f(mrun - mnew);
            mrun = mnew;
            f32x4 p0, p1; float ps = 0.f;
#pragma unroll
            for (int r = 0; r < 4; ++r) { p0[r] = exp2f(st[0][r] - mnew); p1[r] = exp2f(st[1][r] - mnew); ps += p0[r] + p1[r]; }
            lpart = lpart * alpha + ps;
            u32x4 pw; pw[0] = pk_bf16(p0[0], p0[1]); pw[1] = pk_bf16(p0[2], p0[3]); pw[2] = pk_bf16(p1[0], p1[1]); pw[3] = pk_bf16(p1[2], p1[3]);
            const bf16x8 pa = __builtin_bit_cast(bf16x8, pw);
            f32x4 al;
#pragma unroll
            for (int r = 0; r < 4; ++r) al[r] = __shfl(alpha, (4 * q + r) & 7);
#pragma unroll
            for (int blk = 0; blk < 4; ++blk) {
                f32x4 x[8];
#pragma unroll
                for (int t = 0; t < 2; ++t)
#pragma unroll
                    for (int r = 0; r < 4; ++r) x[4 * t + r] = *(const f32x4*)(kb + (size_t)(16 * t + 4 * q + r) * KVW + 64 * blk + 4 * c);
#pragma unroll
                for (int e = 0; e < 4; ++e) {
                    u32x4 w; w[0] = pk_bf16(x[0][e], x[1][e]); w[1] = pk_bf16(x[2][e], x[3][e]); w[2] = pk_bf16(x[4][e], x[5][e]); w[3] = pk_bf16(x[6][e], x[7][e]);
                    acc[blk][e] = __builtin_amdgcn_mfma_f32_16x16x32_bf16(pa, __builtin_bit_cast(bf16x8, w), acc[blk][e] * al, 0, 0, 0);
                }
            }
        }
    }
    float lsum = lpart; lsum += __shfl_xor(lsum, 16); lsum += __shfl_xor(lsum, 32);
    float* part = WSP(float, WS_PART) + (size_t)item * (8 * 260);
    if (q < 2) {
#pragma unroll
        for (int blk = 0; blk < 4; ++blk)
#pragma unroll
            for (int e = 0; e < 4; ++e)
#pragma unroll
                for (int r = 0; r < 4; ++r) part[(4 * q + r) * 260 + 64 * blk + 4 * c + e] = acc[blk][e][r];
    }
    if (q == 0 && c < 8) { part[c * 260 + 256] = mrun; part[c * 260 + 257] = lsum; }
}
__device__ __forceinline__ void p4_scan_decode(const Args& A) {
    const int tid = threadIdx.x, lane = tid & 63, wid = __builtin_amdgcn_readfirstlane(tid >> 6), G = gridDim.x;
    if (wid < 4) {
        for (int s = blockIdx.x * 4 + wid; s < 1024; s += G * 4) scan_sample_step(A, s, lane);
        for (int s = blockIdx.x * 4 + wid; s < 1024; s += G * 4) scan_prompt(A, s, lane);
    } else {
        for (int it = blockIdx.x * 4 + (wid - 4); it < 1024; it += G * 4) decode_item(A, it, lane);
    }
}

__device__ __forceinline__ void p5a_post(const Args& A, LAS unsigned char* lds) {
    const int tid = threadIdx.x, lane = tid & 63, wid = tid >> 6, G = gridDim.x;
    for (int row = blockIdx.x * NWAVES + wid; row < MROWS; row += G * NWAVES) {
        bf16_t* o = WSP(bf16_t, WS_ORW) + (size_t)row * 512 + lane * 8;
        if (row >= ROW_PAD || (row >= ROW_META && row < ROW_SAMP)) { *(u32x4*)o = (u32x4){0u, 0u, 0u, 0u}; continue; }
        const size_t ro = (size_t)row * 512 + lane * 8;
        f32x4 y[2], r[2], k[2], v[2];
#pragma unroll
        for (int i = 0; i < 2; ++i) { y[i] = *(const f32x4*)(WSP(float, WS_Y) + ro + 4 * i); r[i] = *(const f32x4*)(WSP(float, WS_ZR) + ro + 4 * i); k[i] = *(const f32x4*)(WSP(float, WS_K2) + ro + 4 * i); v[i] = *(const f32x4*)(WSP(float, WS_ZV) + ro + 4 * i); }
        float s1 = 0.f, rk = 0.f;
#pragma unroll
        for (int i = 0; i < 2; ++i) { const f32x4 rkw = *(const f32x4*)(INF(I_RK) + lane * 8 + 4 * i);
            for (int e = 0; e < 4; ++e) { s1 += y[i][e]; rk += r[i][e] * k[i][e] * rkw[e]; } }
        s1 += __shfl_xor(s1, 1); s1 += __shfl_xor(s1, 2); s1 += __shfl_xor(s1, 4);
        rk += __shfl_xor(rk, 1); rk += __shfl_xor(rk, 2); rk += __shfl_xor(rk, 4);
        const float mean = s1 * (1.0f / 64.0f);
        float s2 = 0.f;
#pragma unroll
        for (int i = 0; i < 2; ++i) for (int e = 0; e < 4; ++e) { const float d = y[i][e] - mean; s2 += d * d; }
        s2 += __shfl_xor(s2, 1); s2 += __shfl_xor(s2, 2); s2 += __shfl_xor(s2, 4);
        const float rstd = rsqrtf(s2 * (1.0f / 64.0f) + GN_EPS);
        const u32x4 gw = *(const u32x4*)(WSP(bf16_t, WS_GB) + ro);
        f32x4 out[2];
#pragma unroll
        for (int i = 0; i < 2; ++i) { const f32x4 lw = *(const f32x4*)(INF(I_LNW) + lane * 8 + 4 * i), lb = *(const f32x4*)(INF(I_LNB) + lane * 8 + 4 * i);
            for (int e = 0; e < 4; ++e) { const unsigned g2 = gw[2 * i + (e >> 1)]; const float g = __uint_as_float((e & 1) ? (g2 & 0xffff0000u) : (g2 << 16));
                out[i][e] = ((y[i][e] - mean) * rstd * lw[e] + lb[e] + rk * v[i][e]) * g; } }
        const u32x2 a = pk4(out[0]), b2 = pk4(out[1]);
        *(u32x4*)o = (u32x4){a.x, a.y, b2.x, b2.y};
    }
    LAS float* ol = (LAS float*)lds;
    for (int sb = blockIdx.x; sb < DECB; sb += G) {
        const int h = tid >> 6, c4 = (tid & 63) * 4;
        const float* kvs = A.out + OUT_KVS + (size_t)sb * KVW;
        const bf16_t* qf = WSP(bf16_t, WS_QF) + ((size_t)sb * 8 + h) * 288;
        float sp = 0.f;
        { const u32x2 qw = *(const u32x2*)(qf + c4); const f32x4 kv = *(const f32x4*)(kvs + c4);
          sp = __uint_as_float(qw.x << 16) * kv[0] + __uint_as_float(qw.x & 0xffff0000u) * kv[1] + __uint_as_float(qw.y << 16) * kv[2] + __uint_as_float(qw.y & 0xffff0000u) * kv[3];
          if (lane < 32) sp += bf2f(qf[256 + lane]) * kvs[256 + lane]; }
        const float sself = wave_sum(sp);
        const float* part = WSP(float, WS_PART) + (size_t)(sb * 8) * (8 * 260) + h * 260;
        float M = sself;
#pragma unroll
        for (int i = 0; i < 8; ++i) M = fmaxf(M, part[(size_t)i * (8 * 260) + 256]);
        const float wself = exp2f(sself - M);
        float L = wself; f32x4 o = *(const f32x4*)(kvs + c4) * wself;
#pragma unroll
        for (int i = 0; i < 8; ++i) { const float* pi = part + (size_t)i * (8 * 260); const float w = exp2f(pi[256] - M); L += pi[257] * w; o += *(const f32x4*)(pi + c4) * w; }
        const float invL = 1.0f / L;
        __syncthreads();
        ol[h * 256 + c4] = o[0] * invL; ol[h * 256 + c4 + 1] = o[1] * invL; ol[h * 256 + c4 + 2] = o[2] * invL; ol[h * 256 + c4 + 3] = o[3] * invL;
        __syncthreads();
        { const int hv = tid, hh = hv >> 6; const float* wv = INF(I_WUV) + hv; float s = 0.f;
#pragma unroll 8
          for (int cc = 0; cc < 256; ++cc) s += ol[hh * 256 + cc] * wv[(size_t)cc * 512];
          WSP(bf16_t, WS_O)[(size_t)(ROW_SAMP + sb) * 512 + hv] = f2bf(s); }
    }
    for (int i = blockIdx.x * NTHREADS + tid; i < (MROWS - MMAIN) * 512; i += G * NTHREADS) {
        const int row = MMAIN + i / 512; if (row < ROW_SAMP || row >= ROW_PAD) WSP(bf16_t, WS_O)[(size_t)MMAIN * 512 + i] = 0;
    }
}

__device__ __forceinline__ void p9_final(const Args& A) {
    const int tid = threadIdx.x, lane = tid & 63, wid = tid >> 6, G = gridDim.x;
    for (int row = blockIdx.x * NWAVES + wid; row < ROW_PAD; row += G * NWAVES) {
        float* o;
        if (row < MMAIN) o = A.out + OUT_YP + (size_t)row * DM;
        else if (row >= ROW_SAMP) o = A.out + OUT_YS + (size_t)(row - ROW_SAMP) * DM;
        else continue;
        const float rs = rsqrtf(WSP(float, WS_SSQ2)[row] * (1.0f / DM) + NORM_EPS);
        const float* x = WSP(float, WS_X2) + (size_t)row * DM;
#pragma unroll
        for (int i = 0; i < 4; ++i) *(f32x4*)(o + i * 256 + lane * 4) = *(const f32x4*)(x + i * 256 + lane * 4) * rs * *(const f32x4*)(INF(I_GFINAL) + i * 256 + lane * 4);
    }
}

#ifndef MK_LAUNCHES
#define MK_LAUNCHES 1
#endif
constexpr int NPHASES = 11;
constexpr int CW_BAR = 0;

__global__ void __launch_bounds__(NTHREADS, 2) mk_fwd(Args A) {
    extern __shared__ __attribute__((aligned(16))) unsigned char lds_raw[];
    LAS unsigned char* lds = (LAS unsigned char*)lds_raw;
    volatile LAS unsigned* misc = (volatile LAS unsigned*)(lds + LDS_MISC);
    const int tid = threadIdx.x;
    if (tid < 64) misc[tid] = 0u;
    __syncthreads();
    const int lo = A.ph_lo, hi = A.ph_hi;
    XcdBarrier bar; bar.bar = WSP(unsigned, WS_CTL) + CW_BAR; bar.x = 0; bar.st = nullptr;
    if (hi - lo > 1) bar = xcd_barrier_post(WSP(unsigned, WS_CTL) + CW_BAR, misc + 8);
#ifndef PH_MASK
#define PH_MASK 0x7ff
#endif
#define IN(k) (((PH_MASK >> (k)) & 1) && lo <= (k) && (k) < hi)
#define SEAM(k) do { if (IN(k) && IN((k) + 1)) xcd_barrier(bar); } while (0)
    const int G = gridDim.x, cid = blockIdx.x;

    if (IN(0)) { p0_prologue(A, lds); }
    SEAM(0);
    if (IN(1)) {
        pg8::Gemm g{WSP(bf16_t, WS_XB), WSP(bf16_t, WS_WIN), MROWS, INPAD, DM}; pg8::StaticOrder S; S.init(MROWS, INPAD, G, cid);
        EpiG1 E{WSP(float, WS_ZS), WSP(float, WS_RW), WSP(bf16_t, WS_GATE)};
        pg8::gemm_phase<EpiG1, pg8::StaticOrder, false, false>(lds, g, S, E);
    }
    SEAM(1);
    if (IN(2)) { p2a_rows(A); }
    SEAM(2);
    if (IN(3)) {
#ifndef P3SEL
#define P3SEL 15
#endif
        if (P3SEL & 1) {
            pg8::Gemm g{WSP(bf16_t, WS_CKV), WSP(bf16_t, WS_WKV), MROWS, 1024, 256}; pg8::StaticOrder S; S.init(MROWS, 1024, G, cid);
            EpiKV E{WSP(bf16_t, WS_KN), WSP(bf16_t, WS_VT)};
            pg8::gemm_phase<EpiKV, pg8::StaticOrder, false, false>(lds, g, S, E);
        }
        if (P3SEL & 2) {
            pg8::Gemm g{WSP(bf16_t, WS_LIN), WSP(bf16_t, WS_WLORA), MROWS, 1536, 256}; pg8::StaticOrder S; S.init(MROWS, 1536, G, cid);
            EpiLora E{INF(I_W0), INF(I_A0), INF(I_KA), WSP(float, WS_ZK), WSP(float, WS_KKN), WSP(float, WS_DEC), WSP(float, WS_K2), WSP(float, WS_B2), WSP(bf16_t, WS_GB)};
            pg8::gemm_phase<EpiLora, pg8::StaticOrder, false, false>(lds, g, S, E);
        }
        if (P3SEL & 4) {
            pg8::Gemm g{WSP(bf16_t, WS_QN), WSP(bf16_t, WS_WUQ), MROWS, 768, 384}; pg8::StaticOrder S; S.init(MROWS, 768, G, cid);
            EpiQ E{WSP(bf16_t, WS_Q), WSP(bf16_t, WS_QF), WSP(float, WS_ROPE)};
            pg8::gemm_phase<EpiQ, pg8::StaticOrder, false, false>(lds, g, S, E);
        }
        if (P3SEL & 8) {
            pg8::Gemm g{WSP(bf16_t, WS_QN) + (size_t)ROW_META * 384, WSP(bf16_t, WS_WQABS), 256, 2048, 384}; pg8::StaticOrder S; S.init(256, 2048, G, cid);
            EpiQabs E{WSP(bf16_t, WS_QF)};
            pg8::gemm_phase<EpiQabs, pg8::StaticOrder, false, false>(lds, g, S, E);
        }
    }
    SEAM(3);
    if (IN(4)) { p3_attention(A); p4_scan_decode(A); }
    SEAM(4);
    if (IN(5)) { p5a_post(A, lds); }
    SEAM(5);
    if (IN(6)) {
        {   pg8::Gemm g{WSP(bf16_t, WS_O), WSP(bf16_t, WS_WOM), MROWS, 1024, 512}; pg8::StaticOrder S; S.init(MROWS, 1024, G, cid);
            EpiG4 E{WSP(bf16_t, WS_GATE), WSP(bf16_t, WS_MRG)};
            pg8::gemm_phase<EpiG4, pg8::StaticOrder, false, false>(lds, g, S, E); }
        {   pg8::Gemm g{WSP(bf16_t, WS_ORW), WSP(bf16_t, WS_WOR), MROWS, 1024, 512}; pg8::StaticOrder S; S.init(MROWS, 1024, G, cid);
            EpiG5 E{WSP(bf16_t, WS_GATE), WSP(bf16_t, WS_MRG)};
            pg8::gemm_phase<EpiG5, pg8::StaticOrder, false, false>(lds, g, S, E); }
    }
    SEAM(6);
    if (IN(7)) {
        pg8::Gemm g{WSP(bf16_t, WS_MRG), WSP(bf16_t, WS_WOUT), MROWS, 1024, 1024}; pg8::StaticOrder S; S.init(MROWS, 1024, G, cid);
        EpiG6 E{XSrc{INF(I_XP), INF(I_META), INF(I_XS)}, WSP(float, WS_X1), WSP(bf16_t, WS_X1B), WSP(float, WS_SSQ1)};
        pg8::gemm_phase<EpiG6, pg8::StaticOrder, false, false>(lds, g, S, E);
    }
    SEAM(7);
    if (IN(8)) {
        pg8::Gemm g{WSP(bf16_t, WS_X1B), WSP(bf16_t, WS_WUP), MROWS, DFF, 1024}; pg8::StaticOrder S; S.init(MROWS, DFF, G, cid);
        EpiG7 E{WSP(float, WS_SSQ1), WSP(bf16_t, WS_ACT)};
        pg8::gemm_phase<EpiG7, pg8::StaticOrder, false, false>(lds, g, S, E);
    }
    SEAM(8);
    if (IN(9)) {
        pg8::Gemm g{WSP(bf16_t, WS_ACT), WSP(bf16_t, WS_WDN), MROWS, 1024, DFF}; pg8::StaticOrder S; S.init(MROWS, 1024, G, cid);
        EpiG8 E{WSP(float, WS_X1), WSP(float, WS_X2), WSP(float, WS_SSQ2)};
        pg8::gemm_phase<EpiG8, pg8::StaticOrder, false, false>(lds, g, S, E);
    }
    SEAM(9);
    if (IN(10)) { p9_final(A); }
#undef IN
#undef SEAM
}

extern "C" void kernel_launch(void* const* d_in, const int* in_sizes, int n_in, void* d_out, int out_size, void* d_ws, size_t ws_size, hipStream_t stream) {
    static int grid = 0;
    if (grid == 0) {
        if (n_in != N_IN || (size_t)out_size != OUT_END || ws_size < WS_END) { fprintf(stderr, "kernel_launch: unexpected sizes: n_in %d out %d (want %zu) ws %zu (want %zu)\n", n_in, out_size, (size_t)OUT_END, ws_size, (size_t)WS_END); grid = -1; return; }
        int dev = 0, cus = 0, per_cu = 0;
        if (hipGetDevice(&dev) != hipSuccess || hipDeviceGetAttribute(&cus, hipDeviceAttributeMultiprocessorCount, dev) != hipSuccess) { grid = -1; return; }
        if (hipFuncSetAttribute((const void*)mk_fwd, hipFuncAttributeMaxDynamicSharedMemorySize, LDS_BYTES) != hipSuccess) { fprintf(stderr, "kernel_launch: hipFuncSetAttribute failed\n"); grid = -1; return; }
        if (hipOccupancyMaxActiveBlocksPerMultiprocessor(&per_cu, (const void*)mk_fwd, NTHREADS, LDS_BYTES) != hipSuccess || per_cu < 1) { fprintf(stderr, "kernel_launch: occupancy query says %d\n", per_cu); }
        (void)hipGetLastError();
        grid = cus;
    }
    if (grid < 0) return;
    (void)hipMemsetAsync(d_ws, 0, WS_ZERO_END, stream);
    Args a{};
    for (int i = 0; i < N_IN; ++i) a.in[i] = d_in[i];
    a.out = (float*)d_out; a.ws = (unsigned char*)d_ws;
#if MK_LAUNCHES == 1
    a.ph_lo = 0; a.ph_hi = NPHASES;
    hipLaunchKernelGGL(mk_fwd, dim3(grid), dim3(NTHREADS), LDS_BYTES, stream, a);
#else
    for (int ph = 0; ph < NPHASES; ++ph) { a.ph_lo = ph; a.ph_hi = ph + 1; hipLaunchKernelGGL(mk_fwd, dim3(grid), dim3(NTHREADS), LDS_BYTES, stream, a); }
#endif
}
```

```cpp
#include <hip/hip_runtime.h>
#include <cstdio>
#include <cstdint>
#define LAS __attribute__((address_space(3)))
#define MK_LAUNCHES 1
namespace pg8 {
#define PG8_LAS __attribute__((address_space(3)))
typedef unsigned short bf16_t;
typedef short bf16x8 __attribute__((ext_vector_type(8)));
typedef float f32x4 __attribute__((ext_vector_type(4)));
typedef unsigned u32x4 __attribute__((ext_vector_type(4)));
constexpr int BM = 256, BK = 64, HALF = 128, HTB = HALF * BK * 2  , STAGE_BYTES = 8 * HTB, NXCD = 8, WGM = 8;

__host__ __device__ __forceinline__ int lds_byte(int r, int c) { const int st = (r >> 4) * 2 + (c >> 5), rr = r & 15, cc = c & 31, ob = rr * 64 + cc * 2; return st * 1024 + (ob ^ (((ob >> 9) & 1) << 5)); }
__host__ __device__ __forceinline__ void stage_rc(int b, int& R, int& C) { const int st = b / 1024, sb = b % 1024, swz = sb ^ (((sb >> 9) & 1) << 5); R = (st >> 1) * 16 + swz / 64; C = (st & 1) * 32 + (swz % 64) / 2; }
__host__ __device__ __forceinline__ int perm32(int rho) { const int n = rho >> 4, i = rho & 15; return 8 * (i >> 2) + 4 * n + (i & 3); }

struct Unit { int pm, pn; };
struct Gemm { const bf16_t* A; const bf16_t* Bt; int M, N, K; };

struct StaticOrder {
    int nM, nN, nwg, G, c;
    __host__ __device__ void init(int M, int N, int G_, int c_) { nM = M / BM; nN = N / BM; nwg = nM * nN; G = G_; c = c_; }
    __host__ __device__ bool next(int i, Unit& u) const {
        const long L = (long)i * G + c; if (L >= nwg) return false;
        int wgid = (int)L; { const int q = nwg / NXCD, r = nwg % NXCD, xcd = wgid % NXCD, off = wgid / NXCD; wgid = (xcd < r ? xcd * (q + 1) : r * (q + 1) + (xcd - r) * q) + off; }
        const int nig = WGM * nN, gid = wgid / nig, fm = gid * WGM, gsz = (nM - fm) < WGM ? (nM - fm) : WGM;
        u.pm = fm + ((wgid % nig) % gsz); u.pn = (wgid % nig) / gsz; return true;
    }
    __device__ __forceinline__ void a_ready(const Unit&) const {}
    __device__ __forceinline__ void done(const Unit&) const {}
};


template <class Epi, class Sched, bool ALIGN_EPI = false, bool SP2 = false>
__device__ __forceinline__ void gemm_phase(PG8_LAS unsigned char* lds, const Gemm g, const Sched& S, const Epi& E) {
    const int tid = threadIdx.x, wid = __builtin_amdgcn_readfirstlane(tid >> 6), lane = tid & 63, wr = wid >> 2, wc = wid & 3, fr = lane & 15, fq = lane >> 4;
    const int K = g.K, nt = K / BK;
    unsigned voffA[2], voffB[2];
#pragma unroll
    for (int i = 0; i < 2; ++i) { int R, C; stage_rc(tid * 16 + i * 8192, R, C); const int Rb = Epi::PERM ? ((R & ~31) + perm32(R & 31)) : R;
        voffA[i] = (unsigned)(R * K + C) * 2u; voffB[i] = (unsigned)(Rb * K + C) * 2u; }
    const size_t kstep = (size_t)(BK * 2);
    const size_t hstep = (size_t)HALF * K * 2;
    const size_t tstep = 2 * hstep;
    const unsigned ldsw = (unsigned)wid * 1024u;
    const int aoff = lds_byte(wr * 64 + fr, fq * 8), boff = lds_byte(wc * 32 + fr, fq * 8);
#define PG8_SA(b, h) (((b) * 2 + (h)) * HTB)
#define PG8_SB(b, h) ((4 + (b) * 2 + (h)) * HTB)
#define PG8_STAGE(bufoff, gbase, voff) do { _Pragma("unroll") for (int _i = 0; _i < 2; ++_i) \
        __builtin_amdgcn_global_load_lds((const unsigned*)((const char*)(gbase) + (voff)[_i]), (PG8_LAS unsigned*)(lds + (bufoff) + ldsw + _i * 8192), 16, 0, 0); } while (0)
#define PG8_LDA(dst, b, h) do { _Pragma("unroll") for (int m = 0; m < 4; ++m) _Pragma("unroll") for (int k = 0; k < 2; ++k) dst[m][k] = *(const PG8_LAS bf16x8*)(lds + PG8_SA(b, h) + aoff + m * 2048 + k * 1024); } while (0)
#define PG8_LDB(dst, b, h) do { _Pragma("unroll") for (int n = 0; n < 2; ++n) _Pragma("unroll") for (int k = 0; k < 2; ++k) dst[n][k] = *(const PG8_LAS bf16x8*)(lds + PG8_SB(b, h) + boff + n * 2048 + k * 1024); } while (0)
#define PG8_MMA(ai, bj, At, Bt) do { __builtin_amdgcn_s_setprio(1); _Pragma("unroll") for (int m = 0; m < 4; ++m) _Pragma("unroll") for (int n = 0; n < 2; ++n) _Pragma("unroll") for (int k = 0; k < 2; ++k) \
        acc[ai][bj][m][n] = __builtin_amdgcn_mfma_f32_16x16x32_bf16(Bt[n][k], At[m][k], acc[ai][bj][m][n], 0, 0, 0); __builtin_amdgcn_s_setprio(0); } while (0)
#define PG8_WAIT_V(n) asm volatile("s_waitcnt vmcnt(" #n ")" ::: "memory")
#define PG8_WAIT_L(n) asm volatile("s_waitcnt lgkmcnt(" #n ")" ::: "memory")
#define PG8_BAR __builtin_amdgcn_s_barrier()
#define PG8_SCHED __builtin_amdgcn_sched_barrier(0)
    Unit cur, nxt; int ui = 0;
    if (!S.next(0, cur)) return;
    f32x4 acc[2][2][4][2];
#pragma unroll
    for (int a = 0; a < 2; ++a)
#pragma unroll
        for (int b = 0; b < 2; ++b)
#pragma unroll
            for (int m = 0; m < 4; ++m)
#pragma unroll
                for (int n = 0; n < 2; ++n) acc[a][b][m][n] = (f32x4){0.f, 0.f, 0.f, 0.f};
    bf16x8 At[4][2], B0[2][2], B1[2][2];
    const char* cA = (const char*)g.A + (size_t)cur.pm * tstep; const char* cB = (const char*)g.Bt + (size_t)cur.pn * tstep;
    S.a_ready(cur);
    if constexpr (SP2) {
        PG8_STAGE(PG8_SB(0, 0), cB, voffB); PG8_STAGE(PG8_SB(0, 1), cB + hstep, voffB); PG8_STAGE(PG8_SA(0, 0), cA, voffA); PG8_STAGE(PG8_SA(0, 1), cA + hstep, voffA);
        if (wr == 1) PG8_BAR;
        PG8_WAIT_V(2); PG8_BAR;
        PG8_STAGE(PG8_SB(1, 0), cB + kstep, voffB); PG8_STAGE(PG8_SA(1, 0), cA + kstep, voffA); PG8_STAGE(PG8_SB(1, 1), cB + hstep + kstep, voffB);
        PG8_WAIT_V(6); PG8_BAR;
    } else {
        PG8_STAGE(PG8_SB(0, 0), cB, voffB); PG8_STAGE(PG8_SA(0, 0), cA, voffA); PG8_STAGE(PG8_SB(0, 1), cB + hstep, voffB); PG8_STAGE(PG8_SA(0, 1), cA + hstep, voffA);
        if (wr == 1) PG8_BAR;
        PG8_WAIT_V(4); PG8_BAR;
        PG8_STAGE(PG8_SB(1, 0), cB + kstep, voffB); PG8_STAGE(PG8_SA(1, 0), cA + kstep, voffA); PG8_STAGE(PG8_SB(1, 1), cB + hstep + kstep, voffB);
        PG8_WAIT_V(6); PG8_BAR;
    }
    for (;;) {
        const bool has_next = S.next(ui + 1, nxt);
        const char* nA = has_next ? (const char*)g.A + (size_t)nxt.pm * tstep : cA; const char* nB = has_next ? (const char*)g.Bt + (size_t)nxt.pn * tstep : cB;
_Pragma("nounroll")
        for (int t = 0; t < nt; t += 2) {
            const bool last = (t == nt - 2);
            const char* a1 = cA + (size_t)(t + 1) * kstep;
            const char* a2 = last ? nA : cA + (size_t)(t + 2) * kstep; const char* b2 = last ? nB : cB + (size_t)(t + 2) * kstep;
            const char* a3 = a2 + kstep; const char* b3 = b2 + kstep;
            if (last && has_next) S.a_ready(nxt);
            if constexpr (SP2) {
            PG8_LDB(B0, 0, 0); PG8_LDB(B1, 0, 1); PG8_SCHED; PG8_LDA(At, 0, 0); PG8_STAGE(PG8_SA(1, 1), a1 + hstep, voffA);
            PG8_WAIT_V(8); PG8_WAIT_L(0); PG8_BAR; PG8_MMA(0, 0, At, B0); PG8_MMA(0, 1, At, B1); PG8_BAR; PG8_SCHED;
            PG8_LDA(At, 0, 1); PG8_STAGE(PG8_SB(0, 0), b2, voffB); PG8_STAGE(PG8_SB(0, 1), b2 + hstep, voffB); PG8_STAGE(PG8_SA(0, 0), a2, voffA);
            PG8_WAIT_V(8); PG8_WAIT_L(0); PG8_BAR; PG8_MMA(1, 0, At, B0); PG8_MMA(1, 1, At, B1); PG8_BAR; PG8_SCHED;
            PG8_LDB(B0, 1, 0); PG8_LDB(B1, 1, 1); PG8_SCHED; PG8_LDA(At, 1, 0); PG8_STAGE(PG8_SA(0, 1), a2 + hstep, voffA);
            PG8_WAIT_V(8); PG8_WAIT_L(0); PG8_BAR; PG8_MMA(0, 0, At, B0); PG8_MMA(0, 1, At, B1); PG8_BAR; PG8_SCHED;
            PG8_LDA(At, 1, 1); PG8_STAGE(PG8_SB(1, 0), b3, voffB); PG8_STAGE(PG8_SB(1, 1), b3 + hstep, voffB); PG8_STAGE(PG8_SA(1, 0), a3, voffA);
            PG8_WAIT_V(8); PG8_WAIT_L(0); PG8_BAR; PG8_MMA(1, 0, At, B0); PG8_MMA(1, 1, At, B1); PG8_BAR; PG8_SCHED;
            } else {
            PG8_LDB(B0, 0, 0); PG8_SCHED; PG8_LDA(At, 0, 0); PG8_STAGE(PG8_SA(1, 1), a1 + hstep, voffA);
            PG8_WAIT_L(8); PG8_BAR; PG8_WAIT_L(0); PG8_MMA(0, 0, At, B0); PG8_BAR; PG8_SCHED;
            PG8_LDB(B1, 0, 1); PG8_STAGE(PG8_SB(0, 0), b2, voffB);
            PG8_BAR; PG8_WAIT_L(0); PG8_MMA(0, 1, At, B1); PG8_BAR;
            PG8_LDA(At, 0, 1); PG8_STAGE(PG8_SA(0, 0), a2, voffA);
            PG8_BAR; PG8_WAIT_L(0); PG8_MMA(1, 0, At, B0); PG8_BAR; PG8_SCHED;
            PG8_STAGE(PG8_SB(0, 1), b2 + hstep, voffB);
            PG8_WAIT_V(6); PG8_BAR; PG8_MMA(1, 1, At, B1); PG8_BAR;
            PG8_LDB(B0, 1, 0); PG8_SCHED; PG8_LDA(At, 1, 0); PG8_STAGE(PG8_SA(0, 1), a2 + hstep, voffA);
            PG8_WAIT_L(8); PG8_BAR; PG8_WAIT_L(0); PG8_MMA(0, 0, At, B0); PG8_BAR; PG8_SCHED;
            PG8_LDB(B1, 1, 1); PG8_STAGE(PG8_SB(1, 0), b3, voffB);
            PG8_BAR; PG8_WAIT_L(0); PG8_MMA(0, 1, At, B1); PG8_BAR;
            PG8_LDA(At, 1, 1); PG8_STAGE(PG8_SA(1, 0), a3, voffA);
            PG8_BAR; PG8_WAIT_L(0); PG8_MMA(1, 0, At, B0); PG8_BAR; PG8_SCHED;
            PG8_STAGE(PG8_SB(1, 1), b3 + hstep, voffB);
            PG8_WAIT_V(6); PG8_BAR; PG8_MMA(1, 1, At, B1); PG8_BAR;
            }
        }
        if constexpr (ALIGN_EPI) { if (wr == 0) PG8_BAR; }
        if constexpr (!Epi::AFTER_DRAIN) { E(acc, cur, wr, wc, fr, fq); S.done(cur); }
        if (!has_next) break;
#pragma unroll
        for (int a = 0; a < 2; ++a)
#pragma unroll
            for (int b = 0; b < 2; ++b)
#pragma unroll
                for (int m = 0; m < 4; ++m)
#pragma unroll
                    for (int n = 0; n < 2; ++n) acc[a][b][m][n] = (f32x4){0.f, 0.f, 0.f, 0.f};
        cur = nxt; cA = nA; cB = nB; ++ui;
        if constexpr (ALIGN_EPI) { if (wr == 1) PG8_BAR; }
    }
    PG8_WAIT_V(0);
    if constexpr (!ALIGN_EPI) { if (wr == 0) PG8_BAR; }
    PG8_BAR;
    if constexpr (Epi::AFTER_DRAIN) { E.fused(acc, cur, wr, wc, fr, fq, lds, wid, lane); S.done(cur); }
#undef PG8_SA
#undef PG8_SB
#undef PG8_STAGE
#undef PG8_LDA
#undef PG8_LDB
#undef PG8_MMA
#undef PG8_WAIT_V
#undef PG8_WAIT_L
#undef PG8_BAR
#undef PG8_SCHED
}
}
#define GAS __attribute__((address_space(1)))
#define XB_TMO      128
#define XB_XCNT(j)  (256  + 64 * (j))
#define XB_XSUB(j)  (1280 + 64 * (j))
#define XB_XGEN(j)  (2304 + 64 * (j))
#define XB_TOP      3328
#define XB_TOPGEN   3392
#define XCD_BAR_WORDS 3456
#define XB_SPIN_CAP (1u << 18)

__device__ __forceinline__ unsigned xb_ld(unsigned* p)              { return __hip_atomic_load(p, __ATOMIC_RELAXED, __HIP_MEMORY_SCOPE_AGENT); }
__device__ __forceinline__ unsigned xb_add(unsigned* p, unsigned v) { return __hip_atomic_fetch_add(p, v, __ATOMIC_RELAXED, __HIP_MEMORY_SCOPE_AGENT); }
__device__ __forceinline__ unsigned xb_xcc_id() { return (unsigned)__builtin_amdgcn_s_getreg((3 << 11) | 20) & 0xFu; }
#define XB_SPIN(cond, bar) do { unsigned _sp = 0; while (cond) { __builtin_amdgcn_s_sleep(1); \
    if ((++_sp & 255u) == 0u) { if (xb_ld(&(bar)[XB_TMO])) break; if (_sp > XB_SPIN_CAP) { atomicAdd(&(bar)[XB_TMO], 1u); break; } } } } while (0)

struct XcdBarrier {
    unsigned* bar; unsigned x;
    volatile LAS unsigned* st;
};

__device__ __forceinline__ XcdBarrier xcd_barrier_post(unsigned* bar, volatile LAS unsigned* st) {
    XcdBarrier b; b.bar = bar; b.x = xb_xcc_id(); b.st = st;
    if (threadIdx.x == 0) (void)xb_add(&bar[XB_XCNT(b.x)], 1u);
    return b;
}
__device__ __forceinline__ void xcd_barrier_complete(unsigned* bar, unsigned x, unsigned& nloc, unsigned& nx) {
    const unsigned G = gridDim.x * gridDim.y * gridDim.z;
    unsigned sum, cnt, mine, sp = 0u;
    for (;;) {
        sum = 0u; cnt = 0u; mine = 0u;
#pragma unroll
        for (unsigned j = 0; j < 16; ++j) { const unsigned c = xb_ld(&bar[XB_XCNT(j)]); sum += c; cnt += (c > 0u) ? 1u : 0u; mine = (j == x) ? c : mine; }
        if (sum == G) break;
        __builtin_amdgcn_s_sleep(1);
        if ((++sp & 255u) == 0u) { if (xb_ld(&bar[XB_TMO])) break; if (sp > XB_SPIN_CAP) { atomicAdd(&bar[XB_TMO], 1u); break; } }
    }
    nloc = mine > 0u ? mine : 1u; nx = cnt > 0u ? cnt : 1u;
}

__device__ __forceinline__ void xcd_barrier(const XcdBarrier& b) {
    asm volatile("s_waitcnt vmcnt(0)" ::: "memory");
    __syncthreads();
    if (threadIdx.x == 0) {
        unsigned* bar = b.bar;
        __builtin_amdgcn_s_waitcnt(0);
        unsigned nloc = b.st[0], nx = b.st[1];
        if (nloc == 0u) { xcd_barrier_complete(bar, b.x, nloc, nx); b.st[0] = nloc; b.st[1] = nx; }
        const unsigned old = xb_add(&bar[XB_XSUB(b.x)], 1u);
        const unsigned gen = old / nloc;
        if (old + 1u == (gen + 1u) * nloc) {
            __builtin_amdgcn_fence(__ATOMIC_RELEASE, "agent");
            asm volatile("s_waitcnt vmcnt(0)" ::: "memory");
            const unsigned og = xb_add(&bar[XB_TOP], 1u);
            const unsigned tg = og / nx;
            if (og + 1u == (tg + 1u) * nx) xb_add(&bar[XB_TOPGEN], 1u);
            else XB_SPIN(xb_ld(&bar[XB_TOPGEN]) == tg, bar);
            __builtin_amdgcn_fence(__ATOMIC_ACQUIRE, "agent");
            xb_add(&bar[XB_XGEN(b.x)], 1u);
            asm volatile("s_waitcnt vmcnt(0)" ::: "memory");
        } else {
            XB_SPIN(xb_ld(&bar[XB_XGEN(b.x)]) == gen, bar);
            __builtin_amdgcn_fence(__ATOMIC_ACQUIRE, "agent");
            asm volatile("s_waitcnt vmcnt(0)" ::: "memory");
        }
    }
    __syncthreads();
}

using pg8::bf16_t; using pg8::bf16x8; using pg8::f32x4; using pg8::Unit;
typedef float f32x16 __attribute__((ext_vector_type(16)));
typedef float f32x2_t __attribute__((ext_vector_type(2)));
typedef __bf16 bf16x2_t __attribute__((ext_vector_type(2)));
typedef unsigned u32x2 __attribute__((ext_vector_type(2)));
typedef unsigned u32x4 __attribute__((ext_vector_type(4)));

constexpr int DM = 1024, NBATCH = 8, SEQ = 2048, NMETA = 16, TPOS = 2064, DECB = 128, PASTLEN = 8192, PAGESZ = 128, NPAGES = 64;
constexpr int NHEAD = 8, QLORA = 384, KVLORA = 256, KVW = 288;
constexpr int RWW = 512, RWCOLS = 1792, INCOLS = 4512, INPAD = 4608, DFF = 4096;
constexpr int MMAIN = 16384, ROW_META = 16384, ROW_SAMP = 16400, ROW_PAD = 16528, MROWS = 16640;
constexpr int KPITCH = 2112;
constexpr int ROPE_SAMP = 2064;
constexpr float NORM_EPS = 1e-6f, GN_EPS = 64e-5f;
constexpr float QSCALE = 0.10206207261596577f * 1.4426950408889634f;
constexpr int NTHREADS = 512, NWAVES = 8;
constexpr int LDS_RING = 131072, LDS_DECQ = 122880  , LDS_MISC = 144384, LDS_BYTES = LDS_MISC + 1024;

constexpr size_t al256(size_t x) { return (x + 255) & ~(size_t)255; }
constexpr size_t WS_CTL   = 0;
constexpr size_t WS_SSQ1  = 65536;
constexpr size_t WS_SSQ2  = WS_SSQ1 + al256((size_t)MROWS * 4);
constexpr size_t WS_ZERO_END = WS_SSQ2 + al256((size_t)MROWS * 4);
constexpr size_t WS_WIN   = al256(WS_ZERO_END);
constexpr size_t WS_WUQ   = WS_WIN   + (size_t)INPAD * DM * 2;
constexpr size_t WS_WQABS = WS_WUQ   + (size_t)768 * 384 * 2;
constexpr size_t WS_WKV   = WS_WQABS + (size_t)2048 * 384 * 2;
constexpr size_t WS_WLORA = WS_WKV   + (size_t)1024 * 256 * 2;
constexpr size_t WS_WOM   = WS_WLORA + (size_t)1536 * 256 * 2;
constexpr size_t WS_WOR   = WS_WOM   + (size_t)1024 * 512 * 2;
constexpr size_t WS_WOUT  = WS_WOR   + (size_t)1024 * 512 * 2;
constexpr size_t WS_WUP   = WS_WOUT  + (size_t)1024 * 1024 * 2;
constexpr size_t WS_WDN   = WS_WUP   + (size_t)4096 * 1024 * 2;
constexpr size_t WS_ROPE  = WS_WDN   + (size_t)1024 * 4096 * 2;
constexpr size_t WS_XB    = al256(WS_ROPE + (size_t)2065 * 32 * 4);
constexpr size_t WS_ZS    = WS_XB    + (size_t)MROWS * 1024 * 2;
constexpr size_t WS_RW    = WS_ZS    + (size_t)MROWS * 768 * 4;
constexpr size_t WS_GATE  = WS_RW    + (size_t)MROWS * 1792 * 4;
constexpr size_t WS_QN    = WS_GATE  + (size_t)MROWS * 2048 * 2;
constexpr size_t WS_CKV   = WS_QN    + (size_t)MROWS * 384 * 2;
constexpr size_t WS_LIN   = WS_CKV   + (size_t)MROWS * 256 * 2;
constexpr size_t WS_ZK    = WS_LIN   + (size_t)MROWS * 256 * 2;
constexpr size_t SCN_TOTAL = (size_t)64 * TPOS * 384;
constexpr size_t SCN_BSTRIDE = (size_t)8 * TPOS * 384;
constexpr size_t WS_SCN   = WS_ZK    + (size_t)MROWS * 512 * 4;
constexpr size_t WS_B2    = WS_SCN   + (SCN_TOTAL + (size_t)1024 * 384) * 4;
constexpr size_t WS_Y     = WS_B2;
constexpr size_t WS_GB    = WS_Y     + (size_t)MROWS * 512 * 4;
constexpr size_t WS_KN    = WS_GB    + (size_t)MROWS * 512 * 2;
constexpr size_t WS_KR    = WS_KN    + (size_t)NBATCH * KPITCH * 512 * 2;
constexpr size_t WS_VT    = WS_KR    + (size_t)NBATCH * KPITCH * 32 * 2;
constexpr size_t WS_Q     = WS_VT    + (size_t)NBATCH * 512 * KPITCH * 2;
constexpr size_t WS_QF    = WS_Q     + (size_t)MROWS * 768 * 2;
constexpr size_t WS_PART  = al256(WS_QF + (size_t)DECB * 8 * 288 * 2);
constexpr size_t WS_O     = al256(WS_PART + (size_t)1024 * 8 * 260 * 4);
constexpr size_t WS_ORW   = WS_O     + (size_t)MROWS * 512 * 2;
constexpr size_t WS_MRG   = WS_ORW   + (size_t)MROWS * 512 * 2;
constexpr size_t WS_X1    = WS_MRG   + (size_t)MROWS * 1024 * 2;
constexpr size_t WS_X1B   = WS_X1    + (size_t)MROWS * 1024 * 4;
constexpr size_t WS_ACT   = WS_X1B   + (size_t)MROWS * 1024 * 2;
constexpr size_t WS_X2    = WS_ACT   + (size_t)MROWS * 4096 * 2;
constexpr size_t WS_END   = WS_X2    + (size_t)MROWS * 1024 * 4;

constexpr size_t OUT_YP  = 0;
constexpr size_t OUT_YS  = OUT_YP  + (size_t)NBATCH * SEQ * DM;
constexpr size_t OUT_KVP = OUT_YS  + (size_t)DECB * DM;
constexpr size_t OUT_WKVP= OUT_KVP + (size_t)NBATCH * TPOS * KVW;
constexpr size_t OUT_SHP = OUT_WKVP+ (size_t)NBATCH * 8 * 64 * 64;
constexpr size_t OUT_KVS = OUT_SHP + (size_t)NBATCH * RWCOLS;
constexpr size_t OUT_WKVS= OUT_KVS + (size_t)DECB * KVW;
constexpr size_t OUT_SHS = OUT_WKVS+ (size_t)DECB * 8 * 64 * 64;
constexpr size_t OUT_END = OUT_SHS + (size_t)DECB * RWCOLS;

enum { I_XP = 0, I_XS, I_CACHE, I_PT, I_SWKV, I_SSHIFT, I_META, I_GFINAL, I_GMIX, I_WIN, I_GQ, I_WUQ, I_GKV, I_WUK, I_WUV, I_WOM, I_MU, I_W0, I_W2, I_A0, I_A2, I_G2,
       I_KK, I_KA, I_RK, I_LNW, I_LNB, I_WOR, I_WOUT, I_GFFN, I_WUP, I_WDN, N_IN };

struct Args { const void* in[N_IN]; float* out; unsigned char* ws; int ph_lo, ph_hi; };
#define INF(i) ((const float*)A.in[i])
#define WSP(T, off) ((T*)(A.ws + (off)))

__device__ __forceinline__ unsigned pk_bf16(float lo, float hi) { f32x2_t v = {lo, hi}; bf16x2_t b = __builtin_convertvector(v, bf16x2_t); return __builtin_bit_cast(unsigned, b); }
__device__ __forceinline__ bf16_t f2bf(float f) { return (bf16_t)(pk_bf16(f, 0.f) & 0xffffu); }
__device__ __forceinline__ float bf2f(bf16_t b) { return __uint_as_float((unsigned)b << 16); }
__device__ __forceinline__ u32x2 pk4(f32x4 v) { u32x2 r; r.x = pk_bf16(v[0], v[1]); r.y = pk_bf16(v[2], v[3]); return r; }
__device__ __forceinline__ float sigmoidf_(float x) { return __builtin_amdgcn_rcpf(1.0f + __expf(-x)); }
__device__ __forceinline__ float wave_sum(float v) {
#pragma unroll
    for (int o = 1; o < 64; o <<= 1) v += __shfl_xor(v, o);
    return v;
}
__device__ __forceinline__ float dpp_f(float x, const int ctrl_sel) {
    int xi = __builtin_bit_cast(int, x), r;
    if (ctrl_sel == 0) r = __builtin_amdgcn_update_dpp(0, xi, 0xB1, 0xF, 0xF, true);
    else if (ctrl_sel == 1) r = __builtin_amdgcn_update_dpp(0, xi, 0x4E, 0xF, 0xF, true);
    else if (ctrl_sel == 2) r = __builtin_amdgcn_update_dpp(0, xi, 0x141, 0xF, 0xF, true);
    else r = __builtin_amdgcn_update_dpp(0, xi, 0x140, 0xF, 0xF, true);
    return __builtin_bit_cast(float, r);
}
__device__ __forceinline__ float row16_sum(float x) { x += dpp_f(x, 0); x += dpp_f(x, 1); x += dpp_f(x, 2); x += dpp_f(x, 3); return x; }

struct XSrc { const float* xp; const float* meta; const float* xs; };
__device__ __forceinline__ const float* xrow_ptr(const XSrc& X, int row) {
    if (row < MMAIN) return X.xp + (size_t)row * DM;
    if (row < ROW_SAMP) return X.meta + (size_t)(row - ROW_META) * DM;
    if (row < ROW_PAD) return X.xs + (size_t)(row - ROW_SAMP) * DM;
    return nullptr;
}
__device__ __forceinline__ int rope_idx(int row) {
    if (row < MMAIN) return NMETA + (row & (SEQ - 1));
    if (row < ROW_SAMP) return row - ROW_META;
    if (row < ROW_PAD) return ROPE_SAMP;
    return 0;
}

__device__ __forceinline__ size_t scn_base(int row, int h, int& ncopies) {
    if (row < MMAIN) { ncopies = 1; return ((size_t)((row >> 11) * 8 + h) * TPOS + NMETA + (row & (SEQ - 1))) * 384; }
    if (row < ROW_SAMP) { ncopies = NBATCH; return ((size_t)h * TPOS + (row - ROW_META)) * 384; }
    if (row < ROW_PAD) { ncopies = 1; return SCN_TOTAL + (size_t)((row - ROW_SAMP) * 8 + h) * 384; }
    ncopies = 0; return 0;
}

__device__ __forceinline__ int win_cmap(int n) {
    if (n < 256) return 384 + n;
    if (n < 640) return n - 256;
    if (n < 672) return n;
    if (n < 768) return -1;
    return n - 96;
}
struct TJob { const float* src; int ldsrc; const float* kscale; bf16_t* dst; int ldd; int N, K; int mode; };
__device__ __forceinline__ void transpose_tile(const TJob& J, int tile, LAS float* scr) {
    const int ntk = J.K >> 6, tn = tile / ntk, tk = tile - tn * ntk, tid = threadIdx.x;
    {
        const int n_l = tid & 63, k0 = tid >> 6, n = tn * 64 + n_l, c = J.mode ? win_cmap(n) : n;
#pragma unroll
        for (int i = 0; i < 8; ++i) {
            const int k_l = k0 + 8 * i, k = tk * 64 + k_l;
            float v = 0.f;
            if (c >= 0) { v = J.src[(size_t)k * J.ldsrc + c]; if (J.kscale) v *= J.kscale[k]; }
            scr[k_l * 65 + n_l] = v;
        }
    }
    __syncthreads();
    {
        const int k_l = tid & 63, n0 = tid >> 6;
#pragma unroll
        for (int i = 0; i < 8; ++i) {
            const int n_l = n0 + 8 * i;
            J.dst[(size_t)(tn * 64 + n_l) * J.ldd + tk * 64 + k_l] = f2bf(scr[k_l * 65 + n_l]);
        }
    }
    __syncthreads();
}
constexpr int NJOBS = 12;
__device__ __forceinline__ TJob get_job(const Args& A, int j) {
    TJob J; J.kscale = nullptr; J.mode = 0;
    switch (j) {
    case 0:  J.src = INF(I_WIN);  J.ldsrc = INCOLS; J.kscale = INF(I_GMIX); J.dst = WSP(bf16_t, WS_WIN); J.ldd = 1024; J.N = INPAD; J.K = 1024; J.mode = 1; break;
    case 1:  J.src = INF(I_WUQ);  J.ldsrc = 768;  J.kscale = INF(I_GQ); J.dst = WSP(bf16_t, WS_WUQ); J.ldd = 384; J.N = 768; J.K = 384; break;
    case 2:  J.src = INF(I_WUK);  J.ldsrc = 512;  J.dst = WSP(bf16_t, WS_WKV); J.ldd = 256; J.N = 512; J.K = 256; break;
    case 3:  J.src = INF(I_WUV);  J.ldsrc = 512;  J.dst = WSP(bf16_t, WS_WKV) + (size_t)512 * 256; J.ldd = 256; J.N = 512; J.K = 256; break;
    case 4:  J.src = INF(I_W2);   J.ldsrc = 512;  J.dst = WSP(bf16_t, WS_WLORA); J.ldd = 256; J.N = 512; J.K = 64; break;
    case 5:  J.src = INF(I_A2);   J.ldsrc = 512;  J.dst = WSP(bf16_t, WS_WLORA) + (size_t)512 * 256 + 64; J.ldd = 256; J.N = 512; J.K = 64; break;
    case 6:  J.src = INF(I_G2);   J.ldsrc = 512;  J.dst = WSP(bf16_t, WS_WLORA) + (size_t)1024 * 256 + 128; J.ldd = 256; J.N = 512; J.K = 128; break;
    case 7:  J.src = INF(I_WOM);  J.ldsrc = 1024; J.dst = WSP(bf16_t, WS_WOM); J.ldd = 512; J.N = 1024; J.K = 512; break;
    case 8:  J.src = INF(I_WOR);  J.ldsrc = 1024; J.dst = WSP(bf16_t, WS_WOR); J.ldd = 512; J.N = 1024; J.K = 512; break;
    case 9:  J.src = INF(I_WOUT); J.ldsrc = 1024; J.dst = WSP(bf16_t, WS_WOUT); J.ldd = 1024; J.N = 1024; J.K = 1024; break;
    case 10: J.src = INF(I_WUP);  J.ldsrc = 4096; J.kscale = INF(I_GFFN); J.dst = WSP(bf16_t, WS_WUP); J.ldd = 1024; J.N = 4096; J.K = 1024; break;
    default: J.src = INF(I_WDN);  J.ldsrc = 1024; J.dst = WSP(bf16_t, WS_WDN); J.ldd = 4096; J.N = 1024; J.K = 4096; break;
    }
    return J;
}
__device__ __forceinline__ void p0_prologue(const Args& A, LAS unsigned char* lds) {
    const int tid = threadIdx.x, lane = tid & 63, wid = tid >> 6, G = gridDim.x;
    {
        int base = 0;
        for (int j = 0; j < NJOBS; ++j) {
            const TJob J = get_job(A, j);
            const int nt = (J.N >> 6) * (J.K >> 6);
            int t = ((int)blockIdx.x - base % G + G) % G;
            for (; t < nt; t += G) transpose_tile(J, t, (LAS float*)lds);
            base += nt;
        }
    }
    const int gtid = blockIdx.x * NTHREADS + tid, gthreads = G * NTHREADS;
    for (int i = gtid; i < 1536 * 256; i += gthreads) {
        const int n = i >> 8, k = i & 255, blk = n >> 9;
        const bool nz = (blk == 0) ? (k < 64) : (blk == 1) ? (k >= 64 && k < 128) : (k >= 128);
        if (!nz) WSP(bf16_t, WS_WLORA)[i] = 0;
    }
    for (int i = gtid; i < 2048 * 384; i += gthreads) {
        const int k = i % 384, n = i / 384, h = n >> 8, c = n & 255;
        const float* a = INF(I_WUQ) + (size_t)k * 768 + h * 96;
        const float* b = INF(I_WUK) + (size_t)c * 512 + h * 64;
        float s = 0.f;
#pragma unroll
        for (int q = 0; q < 16; ++q) { const f32x4 av = *(const f32x4*)(a + 4 * q), bv = *(const f32x4*)(b + 4 * q); s += av[0] * bv[0] + av[1] * bv[1] + av[2] * bv[2] + av[3] * bv[3]; }
        WSP(bf16_t, WS_WQABS)[i] = f2bf(s * INF(I_GQ)[k]);
    }
    for (int i = gtid; i < 2065 * 16; i += gthreads) {
        const int idx = i >> 4, f = i & 15;
        const double pos = (idx == ROPE_SAMP) ? (double)PASTLEN : (double)idx;
        const double ang = pos * pow(10000.0, -(double)f / 16.0);
        WSP(float, WS_ROPE)[idx * 32 + f] = (float)cos(ang);
        WSP(float, WS_ROPE)[idx * 32 + 16 + f] = (float)sin(ang);
    }
    for (int row = blockIdx.x * NWAVES + wid; row < MROWS; row += G * NWAVES) {
        const XSrc XS{INF(I_XP), INF(I_META), INF(I_XS)};
        const float* xr = xrow_ptr(XS, row);
        bf16_t* o = WSP(bf16_t, WS_XB) + (size_t)row * DM;
        f32x4 v[4]; float ss = 0.f;
#pragma unroll
        for (int i = 0; i < 4; ++i) { v[i] = xr ? *(const f32x4*)(xr + i * 256 + lane * 4) : (f32x4){0.f, 0.f, 0.f, 0.f}; ss += v[i][0] * v[i][0] + v[i][1] * v[i][1] + v[i][2] * v[i][2] + v[i][3] * v[i][3]; }
        ss = wave_sum(ss);
        const float rs = rsqrtf(ss * (1.0f / DM) + NORM_EPS);
#pragma unroll
        for (int i = 0; i < 4; ++i) *(u32x2*)(o + i * 256 + lane * 4) = pk4(v[i] * rs);
    }
}

#define EPI_ROWS_BEGIN _Pragma("unroll") for (int ai = 0; ai < 2; ++ai) _Pragma("unroll") for (int m = 0; m < 4; ++m) { const int row = u.pm * 256 + ai * 128 + wr * 64 + m * 16 + fr;
#define EPI_COLS_BEGIN _Pragma("unroll") for (int bj = 0; bj < 2; ++bj) _Pragma("unroll") for (int n = 0; n < 2; ++n) { const int col = u.pn * 256 + bj * 128 + wc * 32 + n * 16 + fq * 4; const f32x4 v = acc[ai][bj][m][n];
#define EPI_END }

struct EpiG1 {
    static constexpr bool PERM = false, AFTER_DRAIN = false;
    float* zs; float* rw; bf16_t* gate;
    __device__ __forceinline__ void operator()(const f32x4 (&acc)[2][2][4][2], const Unit& u, int wr, int wc, int fr, int fq) const {
        EPI_ROWS_BEGIN
            EPI_COLS_BEGIN
                if (u.pn < 3) *(f32x4*)(zs + (size_t)row * 768 + col) = v;
                else if (u.pn < 10) *(f32x4*)(rw + (size_t)row * RWCOLS + (col - 768)) = v;
                else { f32x4 s; s[0] = sigmoidf_(v[0]); s[1] = sigmoidf_(v[1]); s[2] = sigmoidf_(v[2]); s[3] = sigmoidf_(v[3]); *(u32x2*)(gate + (size_t)row * 2048 + (col - 2560)) = pk4(s); }
            EPI_END
        EPI_END
    }
};
struct EpiKV {
    static constexpr bool PERM = false, AFTER_DRAIN = false;
    bf16_t* kn; bf16_t* vt;
    __device__ __forceinline__ void operator()(const f32x4 (&acc)[2][2][4][2], const Unit& u, int wr, int wc, int fr, int fq) const {
        EPI_ROWS_BEGIN
            int b0, b1, pos;
            if (row < MMAIN) { b0 = row >> 11; b1 = b0 + 1; pos = NMETA + (row & (SEQ - 1)); }
            else if (row < ROW_SAMP) { b0 = 0; b1 = NBATCH; pos = row - ROW_META; }
            else { b0 = 0; b1 = 0; pos = 0; }
            EPI_COLS_BEGIN
                if (u.pn < 2) { const u32x2 w = pk4(v); for (int b = b0; b < b1; ++b) *(u32x2*)(kn + ((size_t)b * KPITCH + pos) * 512 + col) = w; }
                else { const int hv = col - 512;
                    for (int b = b0; b < b1; ++b) { bf16_t* p = vt + ((size_t)b * 512 + hv) * KPITCH + pos;
                        p[0] = f2bf(v[0]); p[KPITCH] = f2bf(v[1]); p[2 * KPITCH] = f2bf(v[2]); p[3 * KPITCH] = f2bf(v[3]); } }
            EPI_END
        EPI_END
    }
};
struct EpiLora {
    static constexpr bool PERM = false, AFTER_DRAIN = false;
    const float* w0; const float* a0; const float* k_a; const float* zk; float* scn; bf16_t* gb;
    __device__ __forceinline__ void operator()(const f32x4 (&acc)[2][2][4][2], const Unit& u, int wr, int wc, int fr, int fq) const {
        EPI_ROWS_BEGIN
            EPI_COLS_BEGIN
                if (u.pn < 2) {
                    const f32x4 w = *(const f32x4*)(w0 + col); f32x4 d;
#pragma unroll
                    for (int e = 0; e < 4; ++e) d[e] = __expf(-0.6065306597126334f * sigmoidf_(w[e] + v[e]));
                    int nc; const size_t sb = scn_base(row, col >> 6, nc) + 1 * 64 + (col & 63);
                    for (int i = 0; i < nc; ++i) *(f32x4*)(scn + sb + i * SCN_BSTRIDE) = d;
                } else if (u.pn < 4) {
                    const int c = col - 512;
                    int nc; const size_t sb = scn_base(row, c >> 6, nc) + (c & 63);
                    if (nc > 0) {
                        const f32x4 a0v = *(const f32x4*)(a0 + c), kav = *(const f32x4*)(k_a + c), zkv = *(const f32x4*)(zk + (size_t)row * 512 + c), nk = *(const f32x4*)(scn + sb + 3 * 64);
                        f32x4 ko, bo;
#pragma unroll
                        for (int e = 0; e < 4; ++e) { const float a = sigmoidf_(a0v[e] + v[e]); ko[e] = zkv[e] * (1.0f + (a - 1.0f) * kav[e]); bo[e] = -nk[e] * a; }
                        for (int i = 0; i < nc; ++i) { *(f32x4*)(scn + sb + i * SCN_BSTRIDE + 2 * 64) = ko; *(f32x4*)(scn + sb + i * SCN_BSTRIDE + 4 * 64) = bo; }
                    }
                } else {
                    *(u32x2*)(gb + (size_t)row * 512 + (col - 1024)) = pk4(v);
                }
            EPI_END
        EPI_END
    }
};
struct EpiQ {
    static constexpr bool PERM = false, AFTER_DRAIN = false;
    bf16_t* q; bf16_t* qf; const float* rope;
    __device__ __forceinline__ void operator()(const f32x4 (&acc)[2][2][4][2], const Unit& u, int wr, int wc, int fr, int fq) const {
        EPI_ROWS_BEGIN
            const int ri = rope_idx(row);
#pragma unroll
            for (int bj = 0; bj < 2; ++bj) {
                const int cb = u.pn * 256 + bj * 128 + wc * 32;
                const int g32 = cb >> 5, h = g32 / 3, part = g32 - 3 * h;
                f32x4 v0 = acc[ai][bj][m][0] * QSCALE, v1 = acc[ai][bj][m][1] * QSCALE;
                if (part == 2) {
                    const f32x4 cs = *(const f32x4*)(rope + ri * 32 + fq * 4), sn = *(const f32x4*)(rope + ri * 32 + 16 + fq * 4);
                    const f32x4 o0 = v0 * cs - v1 * sn, o1 = v0 * sn + v1 * cs; v0 = o0; v1 = o1;
                    if (row >= ROW_SAMP && row < ROW_PAD) { bf16_t* p = qf + ((size_t)(row - ROW_SAMP) * 8 + h) * 288 + 256 + fq * 4; *(u32x2*)p = pk4(v0); *(u32x2*)(p + 16) = pk4(v1); }
                }
                bf16_t* p = q + (size_t)row * 768 + cb + fq * 4;
                *(u32x2*)p = pk4(v0); *(u32x2*)(p + 16) = pk4(v1);
            }
        EPI_END
    }
};
struct EpiQabs {
    static constexpr bool PERM = false, AFTER_DRAIN = false;
    bf16_t* qf;
    __device__ __forceinline__ void operator()(const f32x4 (&acc)[2][2][4][2], const Unit& u, int wr, int wc, int fr, int fq) const {
        EPI_ROWS_BEGIN
            const int sb = row - (ROW_SAMP - ROW_META);
            EPI_COLS_BEGIN
                if (sb >= 0 && sb < DECB) { const int h = col >> 8, c = col & 255; *(u32x2*)(qf + ((size_t)sb * 8 + h) * 288 + c) = pk4(v * QSCALE); }
            EPI_END
        EPI_END
    }
};
struct EpiG4 {
    static constexpr bool PERM = false, AFTER_DRAIN = false;
    const bf16_t* gate; bf16_t* mrg;
    __device__ __forceinline__ void operator()(const f32x4 (&acc)[2][2][4][2], const Unit& u, int wr, int wc, int fr, int fq) const {
        EPI_ROWS_BEGIN
            EPI_COLS_BEGIN
                const u32x2 g = *(const u32x2*)(gate + (size_t)row * 2048 + col);
                f32x4 o; o[0] = v[0] * __uint_as_float(g.x << 16); o[1] = v[1] * __uint_as_float(g.x & 0xffff0000u); o[2] = v[2] * __uint_as_float(g.y << 16); o[3] = v[3] * __uint_as_float(g.y & 0xffff0000u);
                *(u32x2*)(mrg + (size_t)row * 1024 + col) = pk4(o);
            EPI_END
        EPI_END
    }
};
struct EpiG5 {
    static constexpr bool PERM = false, AFTER_DRAIN = false;
    const bf16_t* gate; bf16_t* mrg;
    __device__ __forceinline__ void operator()(const f32x4 (&acc)[2][2][4][2], const Unit& u, int wr, int wc, int fr, int fq) const {
        EPI_ROWS_BEGIN
            EPI_COLS_BEGIN
                const u32x2 g = *(const u32x2*)(gate + (size_t)row * 2048 + 1024 + col);
                const u32x2 t = *(const u32x2*)(mrg + (size_t)row * 1024 + col);
                f32x4 o; o[0] = __uint_as_float(t.x << 16) + v[0] * __uint_as_float(g.x << 16); o[1] = __uint_as_float(t.x & 0xffff0000u) + v[1] * __uint_as_float(g.x & 0xffff0000u);
                o[2] = __uint_as_float(t.y << 16) + v[2] * __uint_as_float(g.y << 16); o[3] = __uint_as_float(t.y & 0xffff0000u) + v[3] * __uint_as_float(g.y & 0xffff0000u);
                *(u32x2*)(mrg + (size_t)row * 1024 + col) = pk4(o);
            EPI_END
        EPI_END
    }
};
struct EpiG6 {
    static constexpr bool PERM = false, AFTER_DRAIN = false;
    XSrc X; float* x1; bf16_t* x1b; float* ssq;
    __device__ __forceinline__ void operator()(const f32x4 (&acc)[2][2][4][2], const Unit& u, int wr, int wc, int fr, int fq) const {
        EPI_ROWS_BEGIN
            const float* xr = xrow_ptr(X, row); float ss = 0.f;
            EPI_COLS_BEGIN
                const f32x4 xv = xr ? *(const f32x4*)(xr + col) : (f32x4){0.f, 0.f, 0.f, 0.f};
                const f32x4 o = xv + v;
                ss += o[0] * o[0] + o[1] * o[1] + o[2] * o[2] + o[3] * o[3];
                *(f32x4*)(x1 + (size_t)row * 1024 + col) = o; *(u32x2*)(x1b + (size_t)row * 1024 + col) = pk4(o);
            EPI_END
            ss += __shfl_xor(ss, 16); ss += __shfl_xor(ss, 32);
            if (fq == 0) atomicAdd(ssq + row, ss);
        EPI_END
    }
};
struct EpiG7 {
    static constexpr bool PERM = false, AFTER_DRAIN = false;
    const float* ssq; bf16_t* act;
    __device__ __forceinline__ void operator()(const f32x4 (&acc)[2][2][4][2], const Unit& u, int wr, int wc, int fr, int fq) const {
        EPI_ROWS_BEGIN
            const float rs = rsqrtf(ssq[row] * (1.0f / DM) + NORM_EPS);
            EPI_COLS_BEGIN
                f32x4 o;
#pragma unroll
                for (int e = 0; e < 4; ++e) { const float t = fmaxf(v[e] * rs, 0.f); o[e] = t * t; }
                *(u32x2*)(act + (size_t)row * DFF + col) = pk4(o);
            EPI_END
        EPI_END
    }
};
struct EpiG8 {
    static constexpr bool PERM = false, AFTER_DRAIN = false;
    const float* x1; float* x2; float* ssq;
    __device__ __forceinline__ void operator()(const f32x4 (&acc)[2][2][4][2], const Unit& u, int wr, int wc, int fr, int fq) const {
        EPI_ROWS_BEGIN
            float ss = 0.f;
            EPI_COLS_BEGIN
                const f32x4 o = *(const f32x4*)(x1 + (size_t)row * 1024 + col) + v;
                ss += o[0] * o[0] + o[1] * o[1] + o[2] * o[2] + o[3] * o[3];
                *(f32x4*)(x2 + (size_t)row * 1024 + col) = o;
            EPI_END
            ss += __shfl_xor(ss, 16); ss += __shfl_xor(ss, 32);
            if (fq == 0) atomicAdd(ssq + row, ss);
        EPI_END
    }
};

__device__ __forceinline__ void p2a_rows(const Args& A) {
    const int tid = threadIdx.x, lane = tid & 63, wid = tid >> 6, G = gridDim.x;
    const float* zs = WSP(float, WS_ZS); const float* rw = WSP(float, WS_RW); const float* rope = WSP(float, WS_ROPE);
    for (int row = blockIdx.x * NWAVES + wid; row < MROWS; row += G * NWAVES) {
        bf16_t* qn = WSP(bf16_t, WS_QN) + (size_t)row * 384; bf16_t* ckv = WSP(bf16_t, WS_CKV) + (size_t)row * 256; bf16_t* lin = WSP(bf16_t, WS_LIN) + (size_t)row * 256;
        if (row >= ROW_PAD) {
            *(u32x2*)(qn + lane * 4) = (u32x2){0u, 0u}; *(unsigned*)(qn + 256 + lane * 2) = 0u; *(u32x2*)(ckv + lane * 4) = (u32x2){0u, 0u}; *(u32x2*)(lin + lane * 4) = (u32x2){0u, 0u};
            continue;
        }
        int kind, b = 0, pos, ri; const float* prev;
        if (row < MMAIN) { kind = 0; b = row >> 11; const int t = row & (SEQ - 1); pos = NMETA + t; ri = pos; prev = rw + (size_t)(t == 0 ? ROW_META + NMETA - 1 : row - 1) * RWCOLS; }
        else if (row < ROW_SAMP) { kind = 1; pos = row - ROW_META; ri = pos; prev = (pos == 0) ? nullptr : rw + (size_t)(row - 1) * RWCOLS; }
        else { kind = 2; b = row - ROW_SAMP; pos = 0; ri = ROPE_SAMP; prev = INF(I_SSHIFT) + (size_t)b * RWCOLS; }
        const float* z = zs + (size_t)row * 768;
        {
            const f32x4 kv = *(const f32x4*)(z + lane * 4);
            const float ss = wave_sum(kv[0] * kv[0] + kv[1] * kv[1] + kv[2] * kv[2] + kv[3] * kv[3]);
            const float rs = rsqrtf(ss * (1.0f / KVLORA) + NORM_EPS);
            const f32x4 c = kv * rs * *(const f32x4*)(INF(I_GKV) + lane * 4);
            *(u32x2*)(ckv + lane * 4) = pk4(c);
            if (kind == 0) *(f32x4*)(A.out + OUT_KVP + ((size_t)b * TPOS + pos) * KVW + lane * 4) = c;
            else if (kind == 1) { for (int bb = 0; bb < NBATCH; ++bb) *(f32x4*)(A.out + OUT_KVP + ((size_t)bb * TPOS + pos) * KVW + lane * 4) = c; }
            else *(f32x4*)(A.out + OUT_KVS + (size_t)b * KVW + lane * 4) = c;
        }
        {
            const f32x4 q0 = *(const f32x4*)(z + 256 + lane * 4); const f32x2_t q1 = *(const f32x2_t*)(z + 512 + lane * 2);
            const float ss = wave_sum(q0[0] * q0[0] + q0[1] * q0[1] + q0[2] * q0[2] + q0[3] * q0[3] + q1[0] * q1[0] + q1[1] * q1[1]);
            const float rs = rsqrtf(ss * (1.0f / QLORA) + NORM_EPS);
            *(u32x2*)(qn + lane * 4) = pk4(q0 * rs); *(unsigned*)(qn + 256 + lane * 2) = pk_bf16(q1[0] * rs, q1[1] * rs);
        }
        if (lane < 16) {
            const float x1 = z[640 + lane], x2 = z[656 + lane], cs = rope[ri * 32 + lane], sn = rope[ri * 32 + 16 + lane];
            const float o1 = x1 * cs - x2 * sn, o2 = x1 * sn + x2 * cs;
            if (kind == 2) { float* o = A.out + OUT_KVS + (size_t)b * KVW + 256; o[lane] = o1; o[16 + lane] = o2; }
            else {
                const int b0 = (kind == 0) ? b : 0, b1 = (kind == 0) ? b + 1 : NBATCH;
                for (int bb = b0; bb < b1; ++bb) {
                    float* o = A.out + OUT_KVP + ((size_t)bb * TPOS + pos) * KVW + 256; o[lane] = o1; o[16 + lane] = o2;
                    bf16_t* kr = WSP(bf16_t, WS_KR) + ((size_t)bb * KPITCH + pos) * 32; kr[lane] = f2bf(o1); kr[16 + lane] = f2bf(o2);
                }
            }
        }
        {
            const float* c = rw + (size_t)row * RWCOLS; const float* mu = INF(I_MU);
            float* shout = (kind == 0 && (row & (SEQ - 1)) == SEQ - 1) ? A.out + OUT_SHP + (size_t)b * RWCOLS : (kind == 2) ? A.out + OUT_SHS + (size_t)b * RWCOLS : nullptr;
#pragma unroll
            for (int j = 0; j < 7; ++j) {
                const int col = 4 * (lane + 64 * j);
                const f32x4 cc = *(const f32x4*)(c + col), pp = prev ? *(const f32x4*)(prev + col) : (f32x4){0.f, 0.f, 0.f, 0.f}, mm = *(const f32x4*)(mu + col);
                const f32x4 zz = cc + (pp - cc) * mm;
                if (shout) *(f32x4*)(shout + col) = cc;
                if (j < 6) {
                    const int cw = col & 511, hd = cw >> 6, wi = cw & 63;
                    int nc; const size_t sbase = scn_base(row, hd, nc) + wi; float* scn = WSP(float, WS_SCN);
                    if (j < 2) { for (int i = 0; i < nc; ++i) *(f32x4*)(scn + sbase + i * SCN_BSTRIDE) = zz; }
                    else if (j < 4) {
                        *(f32x4*)(WSP(float, WS_ZK) + (size_t)row * 512 + cw) = zz;
                        const f32x4 kk = zz * *(const f32x4*)(INF(I_KK) + cw);
                        const float ss = row16_sum(kk[0] * kk[0] + kk[1] * kk[1] + kk[2] * kk[2] + kk[3] * kk[3]);
                        const float inv = -1.0f / fmaxf(sqrtf(ss), 1e-12f);
                        const f32x4 nk = kk * inv;
                        for (int i = 0; i < nc; ++i) *(f32x4*)(scn + sbase + i * SCN_BSTRIDE + 3 * 64) = nk;
                    } else { for (int i = 0; i < nc; ++i) *(f32x4*)(scn + sbase + i * SCN_BSTRIDE + 5 * 64) = zz; }
                }
                else {
                    f32x4 o;
                    if (lane < 16) { for (int e = 0; e < 4; ++e) o[e] = tanhf(zz[e]); }
                    else if (lane < 32) o = zz;
                    else { for (int e = 0; e < 4; ++e) o[e] = sigmoidf_(zz[e]); }
                    *(u32x2*)(lin + lane * 4) = pk4(o);
                }
            }
        }
    }
}

__device__ __forceinline__ void attn_unit(const Args& A, int b, int h, int qblk, int wid, int lane) {
    const int c = lane & 31, hh = lane >> 5;
    const int qrow = b * SEQ + qblk * 256 + wid * 32 + c, qpos = NMETA + qblk * 256 + wid * 32 + c;
    const bf16_t* qp = WSP(bf16_t, WS_Q) + (size_t)qrow * 768 + h * 96 + 8 * hh;
    bf16x8 qf[6];
#pragma unroll
    for (int s = 0; s < 6; ++s) qf[s] = *(const bf16x8*)(qp + 16 * s);
    f32x16 o0, o1;
#pragma unroll
    for (int i = 0; i < 16; ++i) { o0[i] = 0.f; o1[i] = 0.f; }
    float mrun = -1e30f, lrun = 0.f;
    const int nkt = 8 * qblk + wid + 2;
    const bf16_t* kn = WSP(bf16_t, WS_KN) + (size_t)b * KPITCH * 512 + h * 64 + 8 * hh;
    const bf16_t* kr = WSP(bf16_t, WS_KR) + (size_t)b * KPITCH * 32 + 8 * hh;
    const bf16_t* vt = WSP(bf16_t, WS_VT) + ((size_t)(b * 8 + h) * 64 + c) * KPITCH + 4 * hh;
    const int qmin = NMETA + qblk * 256 + wid * 32;
    for (int kt = 0; kt < nkt; ++kt) {
        const int kpos = 32 * kt + c;
        bf16x8 kf[6];
#pragma unroll
        for (int s = 0; s < 4; ++s) kf[s] = *(const bf16x8*)(kn + (size_t)kpos * 512 + 16 * s);
#pragma unroll
        for (int s = 0; s < 2; ++s) kf[4 + s] = *(const bf16x8*)(kr + (size_t)kpos * 32 + 16 * s);
        u32x2 vlo[2][2], vhi[2][2];
#pragma unroll
        for (int mt = 0; mt < 2; ++mt)
#pragma unroll
            for (int s = 0; s < 2; ++s) { const bf16_t* p = vt + (size_t)(32 * mt) * KPITCH + 32 * kt + 16 * s; vlo[mt][s] = *(const u32x2*)p; vhi[mt][s] = *(const u32x2*)(p + 8); }
        f32x16 sa;
#pragma unroll
        for (int i = 0; i < 16; ++i) sa[i] = 0.f;
#pragma unroll
        for (int s = 0; s < 6; ++s) sa = __builtin_amdgcn_mfma_f32_32x32x16_bf16(kf[s], qf[s], sa, 0, 0, 0);
        if (32 * kt + 31 > qmin) {
#pragma unroll
            for (int i = 0; i < 16; ++i) { const int key = 32 * kt + (i & 3) + 8 * (i >> 2) + 4 * hh; if (key > qpos) sa[i] = -1e30f; }
        }
        float mx = sa[0];
#pragma unroll
        for (int i = 1; i < 16; ++i) mx = fmaxf(mx, sa[i]);
        mx = fmaxf(mx, __shfl_xor(mx, 32));
        const float mnew = fmaxf(mrun, mx), alpha = exp2f(mrun - mnew);
        float ps = 0.f;
#pragma unroll
        for (int i = 0; i < 16; ++i) { sa[i] = exp2f(sa[i] - mnew); ps += sa[i]; }
        ps += __shfl_xor(ps, 32);
        lrun = lrun * alpha + ps; mrun = mnew;
        o0 *= alpha; o1 *= alpha;
#pragma unroll
        for (int s = 0; s < 2; ++s) {
            u32x4 pw; pw[0] = pk_bf16(sa[8 * s], sa[8 * s + 1]); pw[1] = pk_bf16(sa[8 * s + 2], sa[8 * s + 3]); pw[2] = pk_bf16(sa[8 * s + 4], sa[8 * s + 5]); pw[3] = pk_bf16(sa[8 * s + 6], sa[8 * s + 7]);
            const bf16x8 pf = __builtin_bit_cast(bf16x8, pw);
            u32x4 v0w; v0w[0] = vlo[0][s].x; v0w[1] = vlo[0][s].y; v0w[2] = vhi[0][s].x; v0w[3] = vhi[0][s].y;
            u32x4 v1w; v1w[0] = vlo[1][s].x; v1w[1] = vlo[1][s].y; v1w[2] = vhi[1][s].x; v1w[3] = vhi[1][s].y;
            o0 = __builtin_amdgcn_mfma_f32_32x32x16_bf16(__builtin_bit_cast(bf16x8, v0w), pf, o0, 0, 0, 0);
            o1 = __builtin_amdgcn_mfma_f32_32x32x16_bf16(__builtin_bit_cast(bf16x8, v1w), pf, o1, 0, 0, 0);
        }
    }
    const float inv = 1.0f / lrun;
    bf16_t* op = WSP(bf16_t, WS_O) + (size_t)qrow * 512 + h * 64 + 4 * hh;
#pragma unroll
    for (int g = 0; g < 4; ++g) {
        *(u32x2*)(op + 8 * g) = pk4((f32x4){o0[4 * g] * inv, o0[4 * g + 1] * inv, o0[4 * g + 2] * inv, o0[4 * g + 3] * inv});
        *(u32x2*)(op + 32 + 8 * g) = pk4((f32x4){o1[4 * g] * inv, o1[4 * g + 1] * inv, o1[4 * g + 2] * inv, o1[4 * g + 3] * inv});
    }
}
__device__ __forceinline__ void p3_attention(const Args& A) {
    const int tid = threadIdx.x, lane = tid & 63, wid = tid >> 6;
    for (int p = blockIdx.x; p < 256; p += gridDim.x) {
        const int b = p >> 5, h = (p >> 2) & 7, qq = p & 3;
        attn_unit(A, b, h, 7 - qq, wid, lane);
        attn_unit(A, b, h, qq, wid, lane);
    }
}

__device__ __forceinline__ void scan_sample_step(const Args& A, int slot, int lane) {
    const int sb = slot >> 3, h = slot & 7, rho = lane >> 4, kq = lane & 15, row = ROW_SAMP + sb;
    const float* rec = WSP(float, WS_SCN) + SCN_TOTAL + (size_t)slot * 384;
    const f32x4 rr = *(const f32x4*)(rec + 4 * kq), ww = *(const f32x4*)(rec + 64 + 4 * kq), kk = *(const f32x4*)(rec + 128 + 4 * kq),
                aa = *(const f32x4*)(rec + 192 + 4 * kq), bb = *(const f32x4*)(rec + 256 + 4 * kq);
    const float* s0 = INF(I_SWKV) + (size_t)slot * 4096; float* s1 = A.out + OUT_WKVS + (size_t)slot * 4096;
#pragma unroll 4
    for (int i = 0; i < 16; ++i) {
        const int v = 4 * i + rho;
        f32x4 S = *(const f32x4*)(s0 + v * 64 + 4 * kq);
        const float vv = rec[320 + v];
        const float sa = row16_sum(S[0] * aa[0] + S[1] * aa[1] + S[2] * aa[2] + S[3] * aa[3]);
        S = S * ww + sa * bb + vv * kk;
        const float y = row16_sum(S[0] * rr[0] + S[1] * rr[1] + S[2] * rr[2] + S[3] * rr[3]);
        *(f32x4*)(s1 + v * 64 + 4 * kq) = S;
        if (kq == 0) WSP(float, WS_Y)[(size_t)row * 512 + h * 64 + v] = y;
    }
}
constexpr int SCAN_RING_BYTES = 5 * 6144;
struct ScanRegs { f32x4 r, w, k, a, b; float v; };
__device__ __forceinline__ void scan_prompt(const Args& A, int slot, int lane, int wid, LAS unsigned char* lds) {
    const int bh = slot >> 4, rg = slot & 15, b = bh >> 3, h = bh & 7, rho = lane >> 4, kq = lane & 15, v = 4 * rg + rho;
    LAS unsigned char* ring = lds + wid * SCAN_RING_BYTES;
    const char* gsrc = (const char*)(WSP(float, WS_SCN) + (size_t)bh * TPOS * 384) + lane * 16;
    float* py = WSP(float, WS_Y) + h * 64 + v;
    constexpr int NCH = TPOS / 4;
#define SCAN_DMA(chunk, sl) do { _Pragma("unroll") for (int _i = 0; _i < 6; ++_i) \
        __builtin_amdgcn_global_load_lds((const unsigned*)(gsrc + (size_t)(chunk) * 6144 + _i * 1024), (LAS unsigned*)(ring + (sl) * 6144 + _i * 1024), 16, 0, 0); } while (0)
#define SCAN_READ(dst, sl, idx) do { const LAS unsigned char* _p = ring + (sl) * 6144 + (idx) * 1536; \
        dst.r = *(const LAS f32x4*)(_p + kq * 16); dst.w = *(const LAS f32x4*)(_p + 256 + kq * 16); dst.k = *(const LAS f32x4*)(_p + 512 + kq * 16); \
        dst.a = *(const LAS f32x4*)(_p + 768 + kq * 16); dst.b = *(const LAS f32x4*)(_p + 1024 + kq * 16); dst.v = *(const LAS float*)(_p + 1280 + v * 4); } while (0)
    SCAN_DMA(0, 0); SCAN_DMA(1, 1); SCAN_DMA(2, 2); SCAN_DMA(3, 3);
    asm volatile("s_waitcnt vmcnt(18)" ::: "memory");
    f32x4 S = {0.f, 0.f, 0.f, 0.f};
    ScanRegs cur, nxt;
    SCAN_READ(cur, 0, 0);
    int sl = 0;
    for (int j = 0; j < NCH; ++j) {
        { const int cn = (j + 4 < NCH) ? j + 4 : NCH - 1; const int sn = (sl == 0) ? 4 : sl - 1; SCAN_DMA(cn, sn); }
        const int sl1 = (sl == 4) ? 0 : sl + 1;
        float ysel = 0.f;
#pragma unroll
        for (int i = 0; i < 4; ++i) {
            if (i == 3) { asm volatile("s_waitcnt vmcnt(18)" ::: "memory"); SCAN_READ(nxt, sl1, 0); }
            else SCAN_READ(nxt, sl, i + 1);
            const float sa = row16_sum(S[0] * cur.a[0] + S[1] * cur.a[1] + S[2] * cur.a[2] + S[3] * cur.a[3]);
            S = S * cur.w + sa * cur.b + cur.v * cur.k;
            const float y = row16_sum(S[0] * cur.r[0] + S[1] * cur.r[1] + S[2] * cur.r[2] + S[3] * cur.r[3]);
            if (kq == i) ysel = y;
            cur = nxt;
        }
        if (kq < 4) { const int t = 4 * j + kq; py[(size_t)(t < NMETA ? ROW_META + t : b * SEQ + (t - NMETA)) * 512] = ysel; }
        sl = sl1;
    }
    asm volatile("s_waitcnt vmcnt(0)" ::: "memory");
    *(f32x4*)(A.out + OUT_WKVP + ((size_t)bh * 64 + v) * 64 + 4 * kq) = S;
#undef SCAN_DMA
#undef SCAN_READ
}

__device__ __forceinline__ void decode_item(const Args& A, int item, int lane, LAS unsigned char* qlds) {
    const int sb = item >> 3, chunk = item & 7, c = lane & 15, q = lane >> 4;
    {
        const bf16_t* qg = WSP(bf16_t, WS_QF) + (size_t)sb * 8 * 288;
#pragma unroll
        for (int i = 0; i < 5; ++i) { const int o = (i * 64 + lane) * 16; if (o < 4608) *(LAS u32x4*)(qlds + o) = *(const u32x4*)((const char*)qg + o); }
        if (lane < 36) *(LAS u32x4*)(qlds + 4608 + lane * 16) = (u32x4){0u, 0u, 0u, 0u};
    }
    const LAS unsigned char* qrd = qlds + (c < 8 ? c : 8) * 576 + q * 16;
    bf16x8 sel0, sel1;
#pragma unroll
    for (int e = 0; e < 8; ++e) { sel0[e] = (q == (c >> 3) && e == (c & 7)) ? (short)0x3F80 : (short)0; sel1[e] = (q == 2 + (c >> 3) && e == (c & 7)) ? (short)0x3F80 : (short)0; }
    f32x4 acc[16];
#pragma unroll
    for (int i = 0; i < 16; ++i) acc[i] = (f32x4){0.f, 0.f, 0.f, 0.f};
    float mrun = -1e30f, lpart = 0.f;
    const int* pt = (const int*)A.in[I_PT] + sb * NPAGES + chunk * 8;
    f32x4 X[18];
    const size_t lane_off = (size_t)c * KVW + 8 * q;
#define DEC_LOAD(ptr) do { _Pragma("unroll") for (int _s = 0; _s < 9; ++_s) { X[2 * _s] = *(const f32x4*)((ptr) + 32 * _s); X[2 * _s + 1] = *(const f32x4*)((ptr) + 32 * _s + 4); } } while (0)
    const float* page = INF(I_CACHE) + (size_t)pt[0] * (PAGESZ * KVW);
    DEC_LOAD(page + lane_off);
    asm volatile("" ::: "memory");
    for (int tile = 0; tile < 64; ++tile) {
        bf16x8 C[9];
#pragma unroll
        for (int s = 0; s < 9; ++s) { u32x4 w; w[0] = pk_bf16(X[2 * s][0], X[2 * s][1]); w[1] = pk_bf16(X[2 * s][2], X[2 * s][3]); w[2] = pk_bf16(X[2 * s + 1][0], X[2 * s + 1][1]); w[3] = pk_bf16(X[2 * s + 1][2], X[2 * s + 1][3]); C[s] = __builtin_bit_cast(bf16x8, w); }
        asm volatile("" ::: "memory");
        {
            const int tn = (tile + 1 < 64) ? tile + 1 : tile;
            const float* pg = INF(I_CACHE) + (size_t)pt[tn >> 3] * (PAGESZ * KVW) + (size_t)((tn & 7) * 16) * KVW;
            DEC_LOAD(pg + lane_off);
        }
        asm volatile("" ::: "memory");
        f32x4 st = {0.f, 0.f, 0.f, 0.f};
#pragma unroll
        for (int s = 0; s < 9; ++s) st = __builtin_amdgcn_mfma_f32_16x16x32_bf16(C[s], *(const LAS bf16x8*)(qrd + 64 * s), st, 0, 0, 0);
        float mx = fmaxf(fmaxf(st[0], st[1]), fmaxf(st[2], st[3]));
        mx = fmaxf(mx, __shfl_xor(mx, 16)); mx = fmaxf(mx, __shfl_xor(mx, 32));
        const float mnew = fmaxf(mrun, mx), alpha = exp2f(mrun - mnew);
        mrun = mnew;
        f32x4 p; float ps = 0.f;
#pragma unroll
        for (int r = 0; r < 4; ++r) { p[r] = exp2f(st[r] - mnew); ps += p[r]; }
        lpart = lpart * alpha + ps;
        u32x4 pw; pw[0] = pk_bf16(p[0], p[1]); pw[1] = pk_bf16(p[2], p[3]); pw[2] = 0u; pw[3] = 0u;
        const bf16x8 pa = __builtin_bit_cast(bf16x8, pw);
        if (__any(alpha != 1.0f)) {
            f32x4 al;
#pragma unroll
            for (int r = 0; r < 4; ++r) al[r] = __shfl(alpha, (4 * q + r) & 7);
#pragma unroll
            for (int g = 0; g < 16; ++g) acc[g] *= al;
        }
#pragma unroll
        for (int s = 0; s < 8; ++s) {
            const f32x4 z4 = {0.f, 0.f, 0.f, 0.f};
            const f32x4 t0 = __builtin_amdgcn_mfma_f32_16x16x32_bf16(C[s], sel0, z4, 0, 0, 0);
            const f32x4 t1 = __builtin_amdgcn_mfma_f32_16x16x32_bf16(C[s], sel1, z4, 0, 0, 0);
            u32x4 b0; b0[0] = pk_bf16(t0[0], t0[1]); b0[1] = pk_bf16(t0[2], t0[3]); b0[2] = 0u; b0[3] = 0u;
            u32x4 b1; b1[0] = pk_bf16(t1[0], t1[1]); b1[1] = pk_bf16(t1[2], t1[3]); b1[2] = 0u; b1[3] = 0u;
            acc[2 * s] = __builtin_amdgcn_mfma_f32_16x16x32_bf16(pa, __builtin_bit_cast(bf16x8, b0), acc[2 * s], 0, 0, 0);
            acc[2 * s + 1] = __builtin_amdgcn_mfma_f32_16x16x32_bf16(pa, __builtin_bit_cast(bf16x8, b1), acc[2 * s + 1], 0, 0, 0);
        }
    }
#undef DEC_LOAD
    float lsum = lpart; lsum += __shfl_xor(lsum, 16); lsum += __shfl_xor(lsum, 32);
    float* part = WSP(float, WS_PART) + (size_t)item * (8 * 260);
    if (q < 2) {
#pragma unroll
        for (int g = 0; g < 16; ++g)
#pragma unroll
            for (int r = 0; r < 4; ++r) part[(4 * q + r) * 260 + 16 * g + c] = acc[g][r];
    }
    if (q == 0 && c < 8) { part[c * 260 + 256] = mrun; part[c * 260 + 257] = lsum; }
}
__device__ __forceinline__ void p4_scan_decode(const Args& A, LAS unsigned char* lds) {
    const int tid = threadIdx.x, lane = tid & 63, wid = __builtin_amdgcn_readfirstlane(tid >> 6), G = gridDim.x;
    if (wid < 4) {
        for (int s = blockIdx.x * 4 + wid; s < 1024; s += G * 4) scan_sample_step(A, s, lane);
#ifndef REP_S
#define REP_S 1
#endif
        for (int r = 0; r < REP_S; ++r) for (int s = blockIdx.x * 4 + wid; s < 1024; s += G * 4) scan_prompt(A, s, lane, wid, lds);
    } else {
#ifndef REP_D
#define REP_D 1
#endif
        for (int r = 0; r < REP_D; ++r) for (int it = blockIdx.x * 4 + (wid - 4); it < 1024; it += G * 4) decode_item(A, it, lane, lds + LDS_DECQ + (wid - 4) * 5184);
    }
}

__device__ __forceinline__ void p5a_post(const Args& A, LAS unsigned char* lds) {
    const int tid = threadIdx.x, lane = tid & 63, wid = tid >> 6, G = gridDim.x;
    for (int row = blockIdx.x * NWAVES + wid; row < MROWS; row += G * NWAVES) {
        bf16_t* o = WSP(bf16_t, WS_ORW) + (size_t)row * 512 + lane * 8;
        if (row >= ROW_PAD || (row >= ROW_META && row < ROW_SAMP)) { *(u32x4*)o = (u32x4){0u, 0u, 0u, 0u}; continue; }
        const size_t ro = (size_t)row * 512 + lane * 8;
        int ncop; const float* rec = WSP(float, WS_SCN) + scn_base(row, lane >> 3, ncop) + (lane & 7) * 8;
        f32x4 y[2], r[2], k[2], v[2];
#pragma unroll
        for (int i = 0; i < 2; ++i) { y[i] = *(const f32x4*)(WSP(float, WS_Y) + ro + 4 * i); r[i] = *(const f32x4*)(rec + 4 * i); k[i] = *(const f32x4*)(rec + 128 + 4 * i); v[i] = *(const f32x4*)(rec + 320 + 4 * i); }
        float s1 = 0.f, rk = 0.f;
#pragma unroll
        for (int i = 0; i < 2; ++i) { const f32x4 rkw = *(const f32x4*)(INF(I_RK) + lane * 8 + 4 * i);
            for (int e = 0; e < 4; ++e) { s1 += y[i][e]; rk += r[i][e] * k[i][e] * rkw[e]; } }
        s1 += __shfl_xor(s1, 1); s1 += __shfl_xor(s1, 2); s1 += __shfl_xor(s1, 4);
        rk += __shfl_xor(rk, 1); rk += __shfl_xor(rk, 2); rk += __shfl_xor(rk, 4);
        const float mean = s1 * (1.0f / 64.0f);
        float s2 = 0.f;
#pragma unroll
        for (int i = 0; i < 2; ++i) for (int e = 0; e < 4; ++e) { const float d = y[i][e] - mean; s2 += d * d; }
        s2 += __shfl_xor(s2, 1); s2 += __shfl_xor(s2, 2); s2 += __shfl_xor(s2, 4);
        const float rstd = rsqrtf(s2 * (1.0f / 64.0f) + GN_EPS);
        const u32x4 gw = *(const u32x4*)(WSP(bf16_t, WS_GB) + ro);
        f32x4 out[2];
#pragma unroll
        for (int i = 0; i < 2; ++i) { const f32x4 lw = *(const f32x4*)(INF(I_LNW) + lane * 8 + 4 * i), lb = *(const f32x4*)(INF(I_LNB) + lane * 8 + 4 * i);
            for (int e = 0; e < 4; ++e) { const unsigned g2 = gw[2 * i + (e >> 1)]; const float g = __uint_as_float((e & 1) ? (g2 & 0xffff0000u) : (g2 << 16));
                out[i][e] = ((y[i][e] - mean) * rstd * lw[e] + lb[e] + rk * v[i][e]) * g; } }
        const u32x2 a = pk4(out[0]), b2 = pk4(out[1]);
        *(u32x4*)o = (u32x4){a.x, a.y, b2.x, b2.y};
    }
    LAS float* ol = (LAS float*)lds;
    for (int sb = blockIdx.x; sb < DECB; sb += G) {
        const int h = tid >> 6, c4 = (tid & 63) * 4;
        const float* kvs = A.out + OUT_KVS + (size_t)sb * KVW;
        const bf16_t* qf = WSP(bf16_t, WS_QF) + ((size_t)sb * 8 + h) * 288;
        float sp = 0.f;
        { const u32x2 qw = *(const u32x2*)(qf + c4); const f32x4 kv = *(const f32x4*)(kvs + c4);
          sp = __uint_as_float(qw.x << 16) * kv[0] + __uint_as_float(qw.x & 0xffff0000u) * kv[1] + __uint_as_float(qw.y << 16) * kv[2] + __uint_as_float(qw.y & 0xffff0000u) * kv[3];
          if (lane < 32) sp += bf2f(qf[256 + lane]) * kvs[256 + lane]; }
        const float sself = wave_sum(sp);
        const float* part = WSP(float, WS_PART) + (size_t)(sb * 8) * (8 * 260) + h * 260;
        float M = sself;
#pragma unroll
        for (int i = 0; i < 8; ++i) M = fmaxf(M, part[(size_t)i * (8 * 260) + 256]);
        const float wself = exp2f(sself - M);
        float L = wself; f32x4 o = *(const f32x4*)(kvs + c4) * wself;
#pragma unroll
        for (int i = 0; i < 8; ++i) { const float* pi = part + (size_t)i * (8 * 260); const float w = exp2f(pi[256] - M); L += pi[257] * w; o += *(const f32x4*)(pi + c4) * w; }
        const float invL = 1.0f / L;
        __syncthreads();
        ol[h * 256 + c4] = o[0] * invL; ol[h * 256 + c4 + 1] = o[1] * invL; ol[h * 256 + c4 + 2] = o[2] * invL; ol[h * 256 + c4 + 3] = o[3] * invL;
        __syncthreads();
        { const int hv = tid, hh = hv >> 6; const float* wv = INF(I_WUV) + hv; float s = 0.f;
#pragma unroll 8
          for (int cc = 0; cc < 256; ++cc) s += ol[hh * 256 + cc] * wv[(size_t)cc * 512];
          WSP(bf16_t, WS_O)[(size_t)(ROW_SAMP + sb) * 512 + hv] = f2bf(s); }
    }
    for (int i = blockIdx.x * NTHREADS + tid; i < (MROWS - MMAIN) * 512; i += G * NTHREADS) {
        const int row = MMAIN + i / 512; if (row < ROW_SAMP || row >= ROW_PAD) WSP(bf16_t, WS_O)[(size_t)MMAIN * 512 + i] = 0;
    }
}

template <int KS, class Epi>
__device__ __forceinline__ void skinny_gemm(const bf16_t* A_, const bf16_t* Bt, int N, int K, const Epi& E, LAS unsigned char* lds) {
    constexpr int MT = 8 / KS, MG = 8 / MT;
    const int tid = threadIdx.x, lane = tid & 63, wid = __builtin_amdgcn_readfirstlane(tid >> 6), c = lane & 15, q = lane >> 4;
    const int n_items = (N >> 4) * MG, kw = K / KS;
    for (int it = blockIdx.x; it < n_items; it += gridDim.x) {
        const int nt = it / MG, mg = it - nt * MG, mtl = wid % MT, ks = wid / MT, mt = mg * MT + mtl;
        const bf16_t* ap = A_ + (size_t)(mt * 16 + c) * K + ks * kw + 8 * q;
        const bf16_t* bp = Bt + (size_t)(nt * 16 + c) * K + ks * kw + 8 * q;
        f32x4 acc = {0.f, 0.f, 0.f, 0.f};
#pragma unroll 8
        for (int k = 0; k < kw; k += 32) acc = __builtin_amdgcn_mfma_f32_16x16x32_bf16(*(const bf16x8*)(ap + k), *(const bf16x8*)(bp + k), acc, 0, 0, 0);
        if (KS > 1) {
            *(LAS f32x4*)(lds + wid * 1024 + lane * 16) = acc;
            __syncthreads();
            if (ks == 0) {
#pragma unroll
                for (int s = 1; s < KS; ++s) acc += *(const LAS f32x4*)(lds + (s * MT + mtl) * 1024 + lane * 16);
            }
            __syncthreads();
        }
        if (ks == 0) E(acc, mt * 16 + 4 * q, nt * 16 + c, c);
    }
}
struct SkG4 { const bf16_t* gate; bf16_t* mrg;
    __device__ __forceinline__ void operator()(const f32x4& acc, int sr0, int col, int) const {
#pragma unroll
        for (int r = 0; r < 4; ++r) { const size_t row = ROW_SAMP + sr0 + r; mrg[row * 1024 + col] = f2bf(acc[r] * bf2f(gate[row * 2048 + col])); } } };
struct SkG5 { const bf16_t* gate; bf16_t* mrg;
    __device__ __forceinline__ void operator()(const f32x4& acc, int sr0, int col, int) const {
#pragma unroll
        for (int r = 0; r < 4; ++r) { const size_t row = ROW_SAMP + sr0 + r; mrg[row * 1024 + col] = f2bf(bf2f(mrg[row * 1024 + col]) + acc[r] * bf2f(gate[row * 2048 + 1024 + col])); } } };
struct SkG6 { const float* xs; float* x1; bf16_t* x1b; float* ssq;
    __device__ __forceinline__ void operator()(const f32x4& acc, int sr0, int col, int) const {
#pragma unroll
        for (int r = 0; r < 4; ++r) { const size_t row = ROW_SAMP + sr0 + r; const float o = xs[(size_t)(sr0 + r) * DM + col] + acc[r];
            x1[row * 1024 + col] = o; x1b[row * 1024 + col] = f2bf(o); const float ss = row16_sum(o * o); if ((threadIdx.x & 15) == 0) atomicAdd(ssq + row, ss); } } };
struct SkG7 { const float* ssq; bf16_t* act;
    __device__ __forceinline__ void operator()(const f32x4& acc, int sr0, int col, int) const {
#pragma unroll
        for (int r = 0; r < 4; ++r) { const size_t row = ROW_SAMP + sr0 + r; const float t = fmaxf(acc[r] * rsqrtf(ssq[row] * (1.0f / DM) + NORM_EPS), 0.f); act[row * DFF + col] = f2bf(t * t); } } };
struct SkG8 { const float* x1; float* x2; float* ssq;
    __device__ __forceinline__ void operator()(const f32x4& acc, int sr0, int col, int) const {
#pragma unroll
        for (int r = 0; r < 4; ++r) { const size_t row = ROW_SAMP + sr0 + r; const float o = x1[row * 1024 + col] + acc[r];
            x2[row * 1024 + col] = o; const float ss = row16_sum(o * o); if ((threadIdx.x & 15) == 0) atomicAdd(ssq + row, ss); } } };

__device__ __forceinline__ void p9_final(const Args& A) {
    const int tid = threadIdx.x, lane = tid & 63, wid = tid >> 6, G = gridDim.x;
    for (int row = blockIdx.x * NWAVES + wid; row < ROW_PAD; row += G * NWAVES) {
        float* o;
        if (row < MMAIN) o = A.out + OUT_YP + (size_t)row * DM;
        else if (row >= ROW_SAMP) o = A.out + OUT_YS + (size_t)(row - ROW_SAMP) * DM;
        else continue;
        const float rs = rsqrtf(WSP(float, WS_SSQ2)[row] * (1.0f / DM) + NORM_EPS);
        const float* x = WSP(float, WS_X2) + (size_t)row * DM;
#pragma unroll
        for (int i = 0; i < 4; ++i) *(f32x4*)(o + i * 256 + lane * 4) = *(const f32x4*)(x + i * 256 + lane * 4) * rs * *(const f32x4*)(INF(I_GFINAL) + i * 256 + lane * 4);
    }
}

#ifndef MK_LAUNCHES
#define MK_LAUNCHES 1
#endif
#ifndef REP_A
#define REP_A 1
#endif
#ifndef REP_B
#define REP_B 1
#endif
#ifndef REP_T
#define REP_T 1
#endif
constexpr int NPHASES = 11;
constexpr int CW_BAR = 0;

__global__ void __launch_bounds__(NTHREADS, 2) mk_fwd(Args A) {
    extern __shared__ __attribute__((aligned(16))) unsigned char lds_raw[];
    LAS unsigned char* lds = (LAS unsigned char*)lds_raw;
    volatile LAS unsigned* misc = (volatile LAS unsigned*)(lds + LDS_MISC);
    const int tid = threadIdx.x;
    if (tid < 64) misc[tid] = 0u;
    __syncthreads();
    const int lo = A.ph_lo, hi = A.ph_hi;
    XcdBarrier bar; bar.bar = WSP(unsigned, WS_CTL) + CW_BAR; bar.x = 0; bar.st = nullptr;
    if (hi - lo > 1) bar = xcd_barrier_post(WSP(unsigned, WS_CTL) + CW_BAR, misc + 8);
#ifndef PH_MASK
#define PH_MASK 0x7ff
#endif
#define IN(k) (((PH_MASK >> (k)) & 1) && lo <= (k) && (k) < hi)
#define SEAM(k) do { if (IN(k) && IN((k) + 1)) xcd_barrier(bar); } while (0)
    const int G = gridDim.x, cid = blockIdx.x;

    if (IN(0)) { for (int r = 0; r < REP_T; ++r) p0_prologue(A, lds); }
    SEAM(0);
    if (IN(1)) {
        pg8::Gemm g{WSP(bf16_t, WS_XB), WSP(bf16_t, WS_WIN), MROWS, INPAD, DM}; pg8::StaticOrder S; S.init(MROWS, INPAD, G, cid);
        EpiG1 E{WSP(float, WS_ZS), WSP(float, WS_RW), WSP(bf16_t, WS_GATE)};
#ifndef REP_G1
#define REP_G1 1
#endif
        for (int r = 0; r < REP_G1; ++r) pg8::gemm_phase<EpiG1, pg8::StaticOrder, false, false>(lds, g, S, E);
    }
    SEAM(1);
    if (IN(2)) { for (int r = 0; r < REP_T; ++r) p2a_rows(A); }
    SEAM(2);
    if (IN(3)) {
#ifndef P3SEL
#define P3SEL 15
#endif
        if (P3SEL & 1) {
            pg8::Gemm g{WSP(bf16_t, WS_CKV), WSP(bf16_t, WS_WKV), MROWS, 1024, 256}; pg8::StaticOrder S; S.init(MROWS, 1024, G, cid);
            EpiKV E{WSP(bf16_t, WS_KN), WSP(bf16_t, WS_VT)};
            pg8::gemm_phase<EpiKV, pg8::StaticOrder, false, false>(lds, g, S, E);
        }
        if (P3SEL & 2) {
            pg8::Gemm g{WSP(bf16_t, WS_LIN), WSP(bf16_t, WS_WLORA), MROWS, 1536, 256}; pg8::StaticOrder S; S.init(MROWS, 1536, G, cid);
            EpiLora E{INF(I_W0), INF(I_A0), INF(I_KA), WSP(float, WS_ZK), WSP(float, WS_SCN), WSP(bf16_t, WS_GB)};
            pg8::gemm_phase<EpiLora, pg8::StaticOrder, false, false>(lds, g, S, E);
        }
        if (P3SEL & 4) {
            pg8::Gemm g{WSP(bf16_t, WS_QN), WSP(bf16_t, WS_WUQ), MROWS, 768, 384}; pg8::StaticOrder S; S.init(MROWS, 768, G, cid);
            EpiQ E{WSP(bf16_t, WS_Q), WSP(bf16_t, WS_QF), WSP(float, WS_ROPE)};
            pg8::gemm_phase<EpiQ, pg8::StaticOrder, false, false>(lds, g, S, E);
        }
        if (P3SEL & 8) {
            pg8::Gemm g{WSP(bf16_t, WS_QN) + (size_t)ROW_META * 384, WSP(bf16_t, WS_WQABS), 256, 2048, 384}; pg8::StaticOrder S; S.init(256, 2048, G, cid);
            EpiQabs E{WSP(bf16_t, WS_QF)};
            pg8::gemm_phase<EpiQabs, pg8::StaticOrder, false, false>(lds, g, S, E);
        }
    }
    SEAM(3);
    if (IN(4)) { for (int r = 0; r < REP_A; ++r) p3_attention(A); for (int r = 0; r < REP_B; ++r) p4_scan_decode(A, lds); }
    SEAM(4);
    if (IN(5)) { for (int r = 0; r < REP_T; ++r) p5a_post(A, lds); }
    SEAM(5);
    if (IN(6)) {
        {   pg8::Gemm g{WSP(bf16_t, WS_O), WSP(bf16_t, WS_WOM), MMAIN, 1024, 512}; pg8::StaticOrder S; S.init(MMAIN, 1024, G, cid);
            EpiG4 E{WSP(bf16_t, WS_GATE), WSP(bf16_t, WS_MRG)};
            pg8::gemm_phase<EpiG4, pg8::StaticOrder, false, false>(lds, g, S, E); }
        {   pg8::Gemm g{WSP(bf16_t, WS_ORW), WSP(bf16_t, WS_WOR), MMAIN, 1024, 512}; pg8::StaticOrder S; S.init(MMAIN, 1024, G, cid);
            EpiG5 E{WSP(bf16_t, WS_GATE), WSP(bf16_t, WS_MRG)};
            pg8::gemm_phase<EpiG5, pg8::StaticOrder, false, false>(lds, g, S, E); }
        skinny_gemm<4>(WSP(bf16_t, WS_O) + (size_t)ROW_SAMP * 512, WSP(bf16_t, WS_WOM), 1024, 512, SkG4{WSP(bf16_t, WS_GATE), WSP(bf16_t, WS_MRG)}, lds);
        skinny_gemm<4>(WSP(bf16_t, WS_ORW) + (size_t)ROW_SAMP * 512, WSP(bf16_t, WS_WOR), 1024, 512, SkG5{WSP(bf16_t, WS_GATE), WSP(bf16_t, WS_MRG)}, lds);
    }
    SEAM(6);
    if (IN(7)) {
        pg8::Gemm g{WSP(bf16_t, WS_MRG), WSP(bf16_t, WS_WOUT), MMAIN, 1024, 1024}; pg8::StaticOrder S; S.init(MMAIN, 1024, G, cid);
        EpiG6 E{XSrc{INF(I_XP), INF(I_META), INF(I_XS)}, WSP(float, WS_X1), WSP(bf16_t, WS_X1B), WSP(float, WS_SSQ1)};
        pg8::gemm_phase<EpiG6, pg8::StaticOrder, false, false>(lds, g, S, E);
        skinny_gemm<4>(WSP(bf16_t, WS_MRG) + (size_t)ROW_SAMP * 1024, WSP(bf16_t, WS_WOUT), 1024, 1024, SkG6{INF(I_XS), WSP(float, WS_X1), WSP(bf16_t, WS_X1B), WSP(float, WS_SSQ1)}, lds);
    }
    SEAM(7);
    if (IN(8)) {
        pg8::Gemm g{WSP(bf16_t, WS_X1B), WSP(bf16_t, WS_WUP), MMAIN, DFF, 1024}; pg8::StaticOrder S; S.init(MMAIN, DFF, G, cid);
        EpiG7 E{WSP(float, WS_SSQ1), WSP(bf16_t, WS_ACT)};
#ifndef REP_G7
#define REP_G7 1
#endif
        for (int r = 0; r < REP_G7; ++r) pg8::gemm_phase<EpiG7, pg8::StaticOrder, false, false>(lds, g, S, E);
        skinny_gemm<1>(WSP(bf16_t, WS_X1B) + (size_t)ROW_SAMP * 1024, WSP(bf16_t, WS_WUP), DFF, 1024, SkG7{WSP(float, WS_SSQ1), WSP(bf16_t, WS_ACT)}, lds);
    }
    SEAM(8);
    if (IN(9)) {
        pg8::Gemm g{WSP(bf16_t, WS_ACT), WSP(bf16_t, WS_WDN), MMAIN, 1024, DFF}; pg8::StaticOrder S; S.init(MMAIN, 1024, G, cid);
        EpiG8 E{WSP(float, WS_X1), WSP(float, WS_X2), WSP(float, WS_SSQ2)};
        pg8::gemm_phase<EpiG8, pg8::StaticOrder, false, false>(lds, g, S, E);
        skinny_gemm<4>(WSP(bf16_t, WS_ACT) + (size_t)ROW_SAMP * DFF, WSP(bf16_t, WS_WDN), 1024, DFF, SkG8{WSP(float, WS_X1), WSP(float, WS_X2), WSP(float, WS_SSQ2)}, lds);
    }
    SEAM(9);
    if (IN(10)) { for (int r = 0; r < REP_T; ++r) p9_final(A); }
#undef IN
#undef SEAM
}

extern "C" void kernel_launch(void* const* d_in, const int* in_sizes, int n_in, void* d_out, int out_size, void* d_ws, size_t ws_size, hipStream_t stream) {
    static int grid = 0;
    if (grid == 0) {
        if (n_in != N_IN || (size_t)out_size != OUT_END || ws_size < WS_END) { fprintf(stderr, "kernel_launch: unexpected sizes: n_in %d out %d (want %zu) ws %zu (want %zu)\n", n_in, out_size, (size_t)OUT_END, ws_size, (size_t)WS_END); grid = -1; return; }
        int dev = 0, cus = 0, per_cu = 0;
        if (hipGetDevice(&dev) != hipSuccess || hipDeviceGetAttribute(&cus, hipDeviceAttributeMultiprocessorCount, dev) != hipSuccess) { grid = -1; return; }
        if (hipFuncSetAttribute((const void*)mk_fwd, hipFuncAttributeMaxDynamicSharedMemorySize, LDS_BYTES) != hipSuccess) { fprintf(stderr, "kernel_launch: hipFuncSetAttribute failed\n"); grid = -1; return; }
        if (hipOccupancyMaxActiveBlocksPerMultiprocessor(&per_cu, (const void*)mk_fwd, NTHREADS, LDS_BYTES) != hipSuccess || per_cu < 1) { fprintf(stderr, "kernel_launch: occupancy query says %d\n", per_cu); }
        (void)hipGetLastError();
        grid = cus;
    }
    if (grid < 0) return;
    (void)hipMemsetAsync(d_ws, 0, WS_ZERO_END, stream);
    Args a{};
    for (int i = 0; i < N_IN; ++i) a.in[i] = d_in[i];
    a.out = (float*)d_out; a.ws = (unsigned char*)d_ws;
#if MK_LAUNCHES == 1
    a.ph_lo = 0; a.ph_hi = NPHASES;
    hipLaunchKernelGGL(mk_fwd, dim3(grid), dim3(NTHREADS), LDS_BYTES, stream, a);
#else
    for (int ph = 0; ph < NPHASES; ++ph) { a.ph_lo = ph; a.ph_hi = ph + 1; hipLaunchKernelGGL(mk_fwd, dim3(grid), dim3(NTHREADS), LDS_BYTES, stream, a); }
#endif
}
```

```cpp
#include <hip/hip_runtime.h>
#include <cstdio>
#include <cstdint>
#define LAS __attribute__((address_space(3)))
#define MK_LAUNCHES 1
namespace pg8 {
#define PG8_LAS __attribute__((address_space(3)))
typedef unsigned short bf16_t;
typedef short bf16x8 __attribute__((ext_vector_type(8)));
typedef float f32x4 __attribute__((ext_vector_type(4)));
typedef unsigned u32x4 __attribute__((ext_vector_type(4)));
constexpr int BM = 256, BK = 64, HALF = 128, HTB = HALF * BK * 2  , STAGE_BYTES = 8 * HTB, NXCD = 8, WGM = 8;

__host__ __device__ __forceinline__ int lds_byte(int r, int c) { const int st = (r >> 4) * 2 + (c >> 5), rr = r & 15, cc = c & 31, ob = rr * 64 + cc * 2; return st * 1024 + (ob ^ (((ob >> 9) & 1) << 5)); }
__host__ __device__ __forceinline__ void stage_rc(int b, int& R, int& C) { const int st = b / 1024, sb = b % 1024, swz = sb ^ (((sb >> 9) & 1) << 5); R = (st >> 1) * 16 + swz / 64; C = (st & 1) * 32 + (swz % 64) / 2; }
__host__ __device__ __forceinline__ int perm32(int rho) { const int n = rho >> 4, i = rho & 15; return 8 * (i >> 2) + 4 * n + (i & 3); }

struct Unit { int pm, pn; };
struct Gemm { const bf16_t* A; const bf16_t* Bt; int M, N, K; };

struct StaticOrder {
    int nM, nN, nwg, G, c;
    __host__ __device__ void init(int M, int N, int G_, int c_) { nM = M / BM; nN = N / BM; nwg = nM * nN; G = G_; c = c_; }
    __host__ __device__ bool next(int i, Unit& u) const {
        const long L = (long)i * G + c; if (L >= nwg) return false;
        int wgid = (int)L; { const int q = nwg / NXCD, r = nwg % NXCD, xcd = wgid % NXCD, off = wgid / NXCD; wgid = (xcd < r ? xcd * (q + 1) : r * (q + 1) + (xcd - r) * q) + off; }
        const int nig = WGM * nN, gid = wgid / nig, fm = gid * WGM, gsz = (nM - fm) < WGM ? (nM - fm) : WGM;
        u.pm = fm + ((wgid % nig) % gsz); u.pn = (wgid % nig) / gsz; return true;
    }
    __device__ __forceinline__ void a_ready(const Unit&) const {}
    __device__ __forceinline__ void done(const Unit&) const {}
};


template <class Epi, class Sched, bool ALIGN_EPI = false, bool SP2 = false>
__device__ __forceinline__ void gemm_phase(PG8_LAS unsigned char* lds, const Gemm g, const Sched& S, const Epi& E) {
    const int tid = threadIdx.x, wid = __builtin_amdgcn_readfirstlane(tid >> 6), lane = tid & 63, wr = wid >> 2, wc = wid & 3, fr = lane & 15, fq = lane >> 4;
    const int K = g.K, nt = K / BK;
    unsigned voffA[2], voffB[2];
#pragma unroll
    for (int i = 0; i < 2; ++i) { int R, C; stage_rc(tid * 16 + i * 8192, R, C); const int Rb = Epi::PERM ? ((R & ~31) + perm32(R & 31)) : R;
        voffA[i] = (unsigned)(R * K + C) * 2u; voffB[i] = (unsigned)(Rb * K + C) * 2u; }
    const size_t kstep = (size_t)(BK * 2);
    const size_t hstep = (size_t)HALF * K * 2;
    const size_t tstep = 2 * hstep;
    const unsigned ldsw = (unsigned)wid * 1024u;
    const int aoff = lds_byte(wr * 64 + fr, fq * 8), boff = lds_byte(wc * 32 + fr, fq * 8);
#define PG8_SA(b, h) (((b) * 2 + (h)) * HTB)
#define PG8_SB(b, h) ((4 + (b) * 2 + (h)) * HTB)
#define PG8_STAGE(bufoff, gbase, voff) do { _Pragma("unroll") for (int _i = 0; _i < 2; ++_i) \
        __builtin_amdgcn_global_load_lds((const unsigned*)((const char*)(gbase) + (voff)[_i]), (PG8_LAS unsigned*)(lds + (bufoff) + ldsw + _i * 8192), 16, 0, 0); } while (0)
#define PG8_LDA(dst, b, h) do { _Pragma("unroll") for (int m = 0; m < 4; ++m) _Pragma("unroll") for (int k = 0; k < 2; ++k) dst[m][k] = *(const PG8_LAS bf16x8*)(lds + PG8_SA(b, h) + aoff + m * 2048 + k * 1024); } while (0)
#define PG8_LDB(dst, b, h) do { _Pragma("unroll") for (int n = 0; n < 2; ++n) _Pragma("unroll") for (int k = 0; k < 2; ++k) dst[n][k] = *(const PG8_LAS bf16x8*)(lds + PG8_SB(b, h) + boff + n * 2048 + k * 1024); } while (0)
#define PG8_MMA(ai, bj, At, Bt) do { __builtin_amdgcn_s_setprio(1); _Pragma("unroll") for (int m = 0; m < 4; ++m) _Pragma("unroll") for (int n = 0; n < 2; ++n) _Pragma("unroll") for (int k = 0; k < 2; ++k) \
        acc[ai][bj][m][n] = __builtin_amdgcn_mfma_f32_16x16x32_bf16(Bt[n][k], At[m][k], acc[ai][bj][m][n], 0, 0, 0); __builtin_amdgcn_s_setprio(0); } while (0)
#define PG8_WAIT_V(n) asm volatile("s_waitcnt vmcnt(" #n ")" ::: "memory")
#define PG8_WAIT_L(n) asm volatile("s_waitcnt lgkmcnt(" #n ")" ::: "memory")
#define PG8_BAR __builtin_amdgcn_s_barrier()
#define PG8_SCHED __builtin_amdgcn_sched_barrier(0)
    Unit cur, nxt; int ui = 0;
    if (!S.next(0, cur)) return;
    f32x4 acc[2][2][4][2];
#pragma unroll
    for (int a = 0; a < 2; ++a)
#pragma unroll
        for (int b = 0; b < 2; ++b)
#pragma unroll
            for (int m = 0; m < 4; ++m)
#pragma unroll
                for (int n = 0; n < 2; ++n) acc[a][b][m][n] = (f32x4){0.f, 0.f, 0.f, 0.f};
    bf16x8 At[4][2], B0[2][2], B1[2][2];
    const char* cA = (const char*)g.A + (size_t)cur.pm * tstep; const char* cB = (const char*)g.Bt + (size_t)cur.pn * tstep;
    S.a_ready(cur);
    if constexpr (SP2) {
        PG8_STAGE(PG8_SB(0, 0), cB, voffB); PG8_STAGE(PG8_SB(0, 1), cB + hstep, voffB); PG8_STAGE(PG8_SA(0, 0), cA, voffA); PG8_STAGE(PG8_SA(0, 1), cA + hstep, voffA);
        if (wr == 1) PG8_BAR;
        PG8_WAIT_V(2); PG8_BAR;
        PG8_STAGE(PG8_SB(1, 0), cB + kstep, voffB); PG8_STAGE(PG8_SA(1, 0), cA + kstep, voffA); PG8_STAGE(PG8_SB(1, 1), cB + hstep + kstep, voffB);
        PG8_WAIT_V(6); PG8_BAR;
    } else {
        PG8_STAGE(PG8_SB(0, 0), cB, voffB); PG8_STAGE(PG8_SA(0, 0), cA, voffA); PG8_STAGE(PG8_SB(0, 1), cB + hstep, voffB); PG8_STAGE(PG8_SA(0, 1), cA + hstep, voffA);
        if (wr == 1) PG8_BAR;
        PG8_WAIT_V(4); PG8_BAR;
        PG8_STAGE(PG8_SB(1, 0), cB + kstep, voffB); PG8_STAGE(PG8_SA(1, 0), cA + kstep, voffA); PG8_STAGE(PG8_SB(1, 1), cB + hstep + kstep, voffB);
        PG8_WAIT_V(6); PG8_BAR;
    }
    for (;;) {
        const bool has_next = S.next(ui + 1, nxt);
        const char* nA = has_next ? (const char*)g.A + (size_t)nxt.pm * tstep : cA; const char* nB = has_next ? (const char*)g.Bt + (size_t)nxt.pn * tstep : cB;
_Pragma("nounroll")
        for (int t = 0; t < nt; t += 2) {
            const bool last = (t == nt - 2);
            const char* a1 = cA + (size_t)(t + 1) * kstep;
            const char* a2 = last ? nA : cA + (size_t)(t + 2) * kstep; const char* b2 = last ? nB : cB + (size_t)(t + 2) * kstep;
            const char* a3 = a2 + kstep; const char* b3 = b2 + kstep;
            if (last && has_next) S.a_ready(nxt);
            if constexpr (SP2) {
            PG8_LDB(B0, 0, 0); PG8_LDB(B1, 0, 1); PG8_SCHED; PG8_LDA(At, 0, 0); PG8_STAGE(PG8_SA(1, 1), a1 + hstep, voffA);
            PG8_WAIT_V(8); PG8_WAIT_L(0); PG8_BAR; PG8_MMA(0, 0, At, B0); PG8_MMA(0, 1, At, B1); PG8_BAR; PG8_SCHED;
            PG8_LDA(At, 0, 1); PG8_STAGE(PG8_SB(0, 0), b2, voffB); PG8_STAGE(PG8_SB(0, 1), b2 + hstep, voffB); PG8_STAGE(PG8_SA(0, 0), a2, voffA);
            PG8_WAIT_V(8); PG8_WAIT_L(0); PG8_BAR; PG8_MMA(1, 0, At, B0); PG8_MMA(1, 1, At, B1); PG8_BAR; PG8_SCHED;
            PG8_LDB(B0, 1, 0); PG8_LDB(B1, 1, 1); PG8_SCHED; PG8_LDA(At, 1, 0); PG8_STAGE(PG8_SA(0, 1), a2 + hstep, voffA);
            PG8_WAIT_V(8); PG8_WAIT_L(0); PG8_BAR; PG8_MMA(0, 0, At, B0); PG8_MMA(0, 1, At, B1); PG8_BAR; PG8_SCHED;
            PG8_LDA(At, 1, 1); PG8_STAGE(PG8_SB(1, 0), b3, voffB); PG8_STAGE(PG8_SB(1, 1), b3 + hstep, voffB); PG8_STAGE(PG8_SA(1, 0), a3, voffA);
            PG8_WAIT_V(8); PG8_WAIT_L(0); PG8_BAR; PG8_MMA(1, 0, At, B0); PG8_MMA(1, 1, At, B1); PG8_BAR; PG8_SCHED;
            } else {
            PG8_LDB(B0, 0, 0); PG8_SCHED; PG8_LDA(At, 0, 0); PG8_STAGE(PG8_SA(1, 1), a1 + hstep, voffA);
            PG8_WAIT_L(8); PG8_BAR; PG8_WAIT_L(0); PG8_MMA(0, 0, At, B0); PG8_BAR; PG8_SCHED;
            PG8_LDB(B1, 0, 1); PG8_STAGE(PG8_SB(0, 0), b2, voffB);
            PG8_BAR; PG8_WAIT_L(0); PG8_MMA(0, 1, At, B1); PG8_BAR;
            PG8_LDA(At, 0, 1); PG8_STAGE(PG8_SA(0, 0), a2, voffA);
            PG8_BAR; PG8_WAIT_L(0); PG8_MMA(1, 0, At, B0); PG8_BAR; PG8_SCHED;
            PG8_STAGE(PG8_SB(0, 1), b2 + hstep, voffB);
            PG8_WAIT_V(6); PG8_BAR; PG8_MMA(1, 1, At, B1); PG8_BAR;
            PG8_LDB(B0, 1, 0); PG8_SCHED; PG8_LDA(At, 1, 0); PG8_STAGE(PG8_SA(0, 1), a2 + hstep, voffA);
            PG8_WAIT_L(8); PG8_BAR; PG8_WAIT_L(0); PG8_MMA(0, 0, At, B0); PG8_BAR; PG8_SCHED;
            PG8_LDB(B1, 1, 1); PG8_STAGE(PG8_SB(1, 0), b3, voffB);
            PG8_BAR; PG8_WAIT_L(0); PG8_MMA(0, 1, At, B1); PG8_BAR;
            PG8_LDA(At, 1, 1); PG8_STAGE(PG8_SA(1, 0), a3, voffA);
            PG8_BAR; PG8_WAIT_L(0); PG8_MMA(1, 0, At, B0); PG8_BAR; PG8_SCHED;
            PG8_STAGE(PG8_SB(1, 1), b3 + hstep, voffB);
            PG8_WAIT_V(6); PG8_BAR; PG8_MMA(1, 1, At, B1); PG8_BAR;
            }
        }
        if constexpr (ALIGN_EPI) { if (wr == 0) PG8_BAR; }
        if constexpr (!Epi::AFTER_DRAIN) { E(acc, cur, wr, wc, fr, fq); S.done(cur); }
        if (!has_next) break;
#pragma unroll
        for (int a = 0; a < 2; ++a)
#pragma unroll
            for (int b = 0; b < 2; ++b)
#pragma unroll
                for (int m = 0; m < 4; ++m)
#pragma unroll
                    for (int n = 0; n < 2; ++n) acc[a][b][m][n] = (f32x4){0.f, 0.f, 0.f, 0.f};
        cur = nxt; cA = nA; cB = nB; ++ui;
        if constexpr (ALIGN_EPI) { if (wr == 1) PG8_BAR; }
    }
    PG8_WAIT_V(0);
    if constexpr (!ALIGN_EPI) { if (wr == 0) PG8_BAR; }
    PG8_BAR;
    if constexpr (Epi::AFTER_DRAIN) { E.fused(acc, cur, wr, wc, fr, fq, lds, wid, lane); S.done(cur); }
#undef PG8_SA
#undef PG8_SB
#undef PG8_STAGE
#undef PG8_LDA
#undef PG8_LDB
#undef PG8_MMA
#undef PG8_WAIT_V
#undef PG8_WAIT_L
#undef PG8_BAR
#undef PG8_SCHED
}
}
#define GAS __attribute__((address_space(1)))
#define XB_TMO      128
#define XB_XCNT(j)  (256  + 64 * (j))
#define XB_XSUB(j)  (1280 + 64 * (j))
#define XB_XGEN(j)  (2304 + 64 * (j))
#define XB_TOP      3328
#define XB_TOPGEN   3392
#define XCD_BAR_WORDS 3456
#define XB_SPIN_CAP (1u << 18)

__device__ __forceinline__ unsigned xb_ld(unsigned* p)              { return __hip_atomic_load(p, __ATOMIC_RELAXED, __HIP_MEMORY_SCOPE_AGENT); }
__device__ __forceinline__ unsigned xb_add(unsigned* p, unsigned v) { return __hip_atomic_fetch_add(p, v, __ATOMIC_RELAXED, __HIP_MEMORY_SCOPE_AGENT); }
__device__ __forceinline__ unsigned xb_xcc_id() { return (unsigned)__builtin_amdgcn_s_getreg((3 << 11) | 20) & 0xFu; }
#define XB_SPIN(cond, bar) do { unsigned _sp = 0; while (cond) { __builtin_amdgcn_s_sleep(1); \
    if ((++_sp & 255u) == 0u) { if (xb_ld(&(bar)[XB_TMO])) break; if (_sp > XB_SPIN_CAP) { atomicAdd(&(bar)[XB_TMO], 1u); break; } } } } while (0)

struct XcdBarrier {
    unsigned* bar; unsigned x;
    volatile LAS unsigned* st;
};

__device__ __forceinline__ XcdBarrier xcd_barrier_post(unsigned* bar, volatile LAS unsigned* st) {
    XcdBarrier b; b.bar = bar; b.x = xb_xcc_id(); b.st = st;
    if (threadIdx.x == 0) (void)xb_add(&bar[XB_XCNT(b.x)], 1u);
    return b;
}
__device__ __forceinline__ void xcd_barrier_complete(unsigned* bar, unsigned x, unsigned& nloc, unsigned& nx) {
    const unsigned G = gridDim.x * gridDim.y * gridDim.z;
    unsigned sum, cnt, mine, sp = 0u;
    for (;;) {
        sum = 0u; cnt = 0u; mine = 0u;
#pragma unroll
        for (unsigned j = 0; j < 16; ++j) { const unsigned c = xb_ld(&bar[XB_XCNT(j)]); sum += c; cnt += (c > 0u) ? 1u : 0u; mine = (j == x) ? c : mine; }
        if (sum == G) break;
        __builtin_amdgcn_s_sleep(1);
        if ((++sp & 255u) == 0u) { if (xb_ld(&bar[XB_TMO])) break; if (sp > XB_SPIN_CAP) { atomicAdd(&bar[XB_TMO], 1u); break; } }
    }
    nloc = mine > 0u ? mine : 1u; nx = cnt > 0u ? cnt : 1u;
}

__device__ __forceinline__ void xcd_barrier(const XcdBarrier& b) {
    asm volatile("s_waitcnt vmcnt(0)" ::: "memory");
    __syncthreads();
    if (threadIdx.x == 0) {
        unsigned* bar = b.bar;
        __builtin_amdgcn_s_waitcnt(0);
        unsigned nloc = b.st[0], nx = b.st[1];
        if (nloc == 0u) { xcd_barrier_complete(bar, b.x, nloc, nx); b.st[0] = nloc; b.st[1] = nx; }
        const unsigned old = xb_add(&bar[XB_XSUB(b.x)], 1u);
        const unsigned gen = old / nloc;
        if (old + 1u == (gen + 1u) * nloc) {
            __builtin_amdgcn_fence(__ATOMIC_RELEASE, "agent");
            asm volatile("s_waitcnt vmcnt(0)" ::: "memory");
            const unsigned og = xb_add(&bar[XB_TOP], 1u);
            const unsigned tg = og / nx;
            if (og + 1u == (tg + 1u) * nx) xb_add(&bar[XB_TOPGEN], 1u);
            else XB_SPIN(xb_ld(&bar[XB_TOPGEN]) == tg, bar);
            __builtin_amdgcn_fence(__ATOMIC_ACQUIRE, "agent");
            xb_add(&bar[XB_XGEN(b.x)], 1u);
            asm volatile("s_waitcnt vmcnt(0)" ::: "memory");
        } else {
            XB_SPIN(xb_ld(&bar[XB_XGEN(b.x)]) == gen, bar);
            __builtin_amdgcn_fence(__ATOMIC_ACQUIRE, "agent");
            asm volatile("s_waitcnt vmcnt(0)" ::: "memory");
        }
    }
    __syncthreads();
}

using pg8::bf16_t; using pg8::bf16x8; using pg8::f32x4; using pg8::Unit;
typedef float f32x16 __attribute__((ext_vector_type(16)));
typedef float f32x2_t __attribute__((ext_vector_type(2)));
typedef __bf16 bf16x2_t __attribute__((ext_vector_type(2)));
typedef unsigned u32x2 __attribute__((ext_vector_type(2)));
typedef unsigned u32x4 __attribute__((ext_vector_type(4)));

constexpr int DM = 1024, NBATCH = 8, SEQ = 2048, NMETA = 16, TPOS = 2064, DECB = 128, PASTLEN = 8192, PAGESZ = 128, NPAGES = 64;
constexpr int NHEAD = 8, QLORA = 384, KVLORA = 256, KVW = 288;
constexpr int RWW = 512, RWCOLS = 1792, INCOLS = 4512, INPAD = 4608, DFF = 4096;
constexpr int MMAIN = 16384, ROW_META = 16384, ROW_SAMP = 16400, ROW_PAD = 16528, MROWS = 16640;
constexpr int KPITCH = 2112;
constexpr int ROPE_SAMP = 2064;
constexpr float NORM_EPS = 1e-6f, GN_EPS = 64e-5f;
constexpr float QSCALE = 0.10206207261596577f * 1.4426950408889634f;
constexpr int NTHREADS = 512, NWAVES = 8;
constexpr int LDS_RING = 131072, LDS_DECQ = 0  , LDS_DECT = 41472  , LDS_MISC = 162048, LDS_BYTES = LDS_MISC + 1024;

constexpr size_t al256(size_t x) { return (x + 255) & ~(size_t)255; }
constexpr size_t WS_CTL   = 0;
constexpr size_t WS_SSQ1  = 65536;
constexpr size_t WS_SSQ2  = WS_SSQ1 + al256((size_t)MROWS * 4);
constexpr size_t WS_ZERO_END = WS_SSQ2 + al256((size_t)MROWS * 4);
constexpr size_t WS_WIN   = al256(WS_ZERO_END);
constexpr size_t WS_WUQ   = WS_WIN   + (size_t)INPAD * DM * 2;
constexpr size_t WS_WQABS = WS_WUQ   + (size_t)768 * 384 * 2;
constexpr size_t WS_WKV   = WS_WQABS + (size_t)2048 * 384 * 2;
constexpr size_t WS_WLORA = WS_WKV   + (size_t)1024 * 256 * 2;
constexpr size_t WS_WOM   = WS_WLORA + (size_t)1536 * 256 * 2;
constexpr size_t WS_WOR   = WS_WOM   + (size_t)1024 * 512 * 2;
constexpr size_t WS_WOUT  = WS_WOR   + (size_t)1024 * 512 * 2;
constexpr size_t WS_WUP   = WS_WOUT  + (size_t)1024 * 1024 * 2;
constexpr size_t WS_WDN   = WS_WUP   + (size_t)4096 * 1024 * 2;
constexpr size_t WS_ROPE  = WS_WDN   + (size_t)1024 * 4096 * 2;
constexpr size_t WS_XB    = al256(WS_ROPE + (size_t)2065 * 32 * 4);
constexpr size_t WS_ZS    = WS_XB    + (size_t)MROWS * 1024 * 2;
constexpr size_t WS_RW    = WS_ZS    + (size_t)MROWS * 768 * 4;
constexpr size_t WS_GATE  = WS_RW    + (size_t)MROWS * 1792 * 4;
constexpr size_t WS_QN    = WS_GATE  + (size_t)MROWS * 2048 * 2;
constexpr size_t WS_CKV   = WS_QN    + (size_t)MROWS * 384 * 2;
constexpr size_t WS_LIN   = WS_CKV   + (size_t)MROWS * 256 * 2;
constexpr size_t WS_ZK    = WS_LIN   + (size_t)MROWS * 256 * 2;
constexpr size_t SCN_TOTAL = (size_t)64 * TPOS * 384;
constexpr size_t SCN_BSTRIDE = (size_t)8 * TPOS * 384;
constexpr size_t WS_SCN   = WS_ZK    + (size_t)MROWS * 512 * 4;
constexpr size_t WS_B2    = WS_SCN   + (SCN_TOTAL + (size_t)1024 * 384) * 4;
constexpr size_t WS_Y     = WS_B2;
constexpr size_t WS_GB    = WS_Y     + (size_t)MROWS * 512 * 4;
constexpr size_t WS_KN    = WS_GB    + (size_t)MROWS * 512 * 2;
constexpr size_t WS_KR    = WS_KN    + (size_t)NBATCH * KPITCH * 512 * 2;
constexpr size_t WS_VT    = WS_KR    + (size_t)NBATCH * KPITCH * 32 * 2;
constexpr size_t WS_Q     = WS_VT    + (size_t)NBATCH * 512 * KPITCH * 2;
constexpr size_t WS_QF    = WS_Q     + (size_t)MROWS * 768 * 2;
constexpr size_t WS_PART  = al256(WS_QF + (size_t)DECB * 8 * 288 * 2);
constexpr size_t WS_O     = al256(WS_PART + (size_t)2048 * 8 * 260 * 4);
constexpr size_t WS_ORW   = WS_O     + (size_t)MROWS * 512 * 2;
constexpr size_t WS_MRG   = WS_ORW   + (size_t)MROWS * 512 * 2;
constexpr size_t WS_X1    = WS_MRG   + (size_t)MROWS * 1024 * 2;
constexpr size_t WS_X1B   = WS_X1    + (size_t)MROWS * 1024 * 4;
constexpr size_t WS_ACT   = WS_X1B   + (size_t)MROWS * 1024 * 2;
constexpr size_t WS_X2    = WS_ACT   + (size_t)MROWS * 4096 * 2;
constexpr size_t WS_CH    = WS_X2    + (size_t)MROWS * 1024 * 4;
constexpr int    CH_BYTES = 14336, CH_AR = 0, CH_MAK = 4096, CH_TT = 5120, CH_MBR = 6144, CH_BK = 7168, CH_GAM = 11264, CH_V = 11520;
constexpr size_t WS_WUVO  = WS_CH    + (size_t)64 * 129 * CH_BYTES;
constexpr size_t WS_OLAT  = WS_WUVO  + (size_t)1024 * 2048 * 2;
constexpr size_t WS_END   = WS_OLAT  + (size_t)128 * 2048 * 2;

constexpr size_t OUT_YP  = 0;
constexpr size_t OUT_YS  = OUT_YP  + (size_t)NBATCH * SEQ * DM;
constexpr size_t OUT_KVP = OUT_YS  + (size_t)DECB * DM;
constexpr size_t OUT_WKVP= OUT_KVP + (size_t)NBATCH * TPOS * KVW;
constexpr size_t OUT_SHP = OUT_WKVP+ (size_t)NBATCH * 8 * 64 * 64;
constexpr size_t OUT_KVS = OUT_SHP + (size_t)NBATCH * RWCOLS;
constexpr size_t OUT_WKVS= OUT_KVS + (size_t)DECB * KVW;
constexpr size_t OUT_SHS = OUT_WKVS+ (size_t)DECB * 8 * 64 * 64;
constexpr size_t OUT_END = OUT_SHS + (size_t)DECB * RWCOLS;

enum { I_XP = 0, I_XS, I_CACHE, I_PT, I_SWKV, I_SSHIFT, I_META, I_GFINAL, I_GMIX, I_WIN, I_GQ, I_WUQ, I_GKV, I_WUK, I_WUV, I_WOM, I_MU, I_W0, I_W2, I_A0, I_A2, I_G2,
       I_KK, I_KA, I_RK, I_LNW, I_LNB, I_WOR, I_WOUT, I_GFFN, I_WUP, I_WDN, N_IN };

struct Args { const void* in[N_IN]; float* out; unsigned char* ws; int ph_lo, ph_hi; };
#define INF(i) ((const float*)A.in[i])
#define WSP(T, off) ((T*)(A.ws + (off)))

__device__ __forceinline__ unsigned pk_bf16(float lo, float hi) { f32x2_t v = {lo, hi}; bf16x2_t b = __builtin_convertvector(v, bf16x2_t); return __builtin_bit_cast(unsigned, b); }
__device__ __forceinline__ bf16_t f2bf(float f) { return (bf16_t)(pk_bf16(f, 0.f) & 0xffffu); }
__device__ __forceinline__ float bf2f(bf16_t b) { return __uint_as_float((unsigned)b << 16); }
__device__ __forceinline__ u32x2 pk4(f32x4 v) { u32x2 r; r.x = pk_bf16(v[0], v[1]); r.y = pk_bf16(v[2], v[3]); return r; }
__device__ __forceinline__ float sigmoidf_(float x) { return __builtin_amdgcn_rcpf(1.0f + __expf(-x)); }
__device__ __forceinline__ float wave_sum(float v) {
#pragma unroll
    for (int o = 1; o < 64; o <<= 1) v += __shfl_xor(v, o);
    return v;
}
__device__ __forceinline__ float dpp_f(float x, const int ctrl_sel) {
    int xi = __builtin_bit_cast(int, x), r;
    if (ctrl_sel == 0) r = __builtin_amdgcn_update_dpp(0, xi, 0xB1, 0xF, 0xF, true);
    else if (ctrl_sel == 1) r = __builtin_amdgcn_update_dpp(0, xi, 0x4E, 0xF, 0xF, true);
    else if (ctrl_sel == 2) r = __builtin_amdgcn_update_dpp(0, xi, 0x141, 0xF, 0xF, true);
    else r = __builtin_amdgcn_update_dpp(0, xi, 0x140, 0xF, 0xF, true);
    return __builtin_bit_cast(float, r);
}
__device__ __forceinline__ float row16_sum(float x) { x += dpp_f(x, 0); x += dpp_f(x, 1); x += dpp_f(x, 2); x += dpp_f(x, 3); return x; }

struct XSrc { const float* xp; const float* meta; const float* xs; };
__device__ __forceinline__ const float* xrow_ptr(const XSrc& X, int row) {
    if (row < MMAIN) return X.xp + (size_t)row * DM;
    if (row < ROW_SAMP) return X.meta + (size_t)(row - ROW_META) * DM;
    if (row < ROW_PAD) return X.xs + (size_t)(row - ROW_SAMP) * DM;
    return nullptr;
}
__device__ __forceinline__ int rope_idx(int row) {
    if (row < MMAIN) return NMETA + (row & (SEQ - 1));
    if (row < ROW_SAMP) return row - ROW_META;
    if (row < ROW_PAD) return ROPE_SAMP;
    return 0;
}

__device__ __forceinline__ size_t scn_base(int row, int h, int& ncopies) {
    if (row < MMAIN) { ncopies = 1; return ((size_t)((row >> 11) * 8 + h) * TPOS + NMETA + (row & (SEQ - 1))) * 384; }
    if (row < ROW_SAMP) { ncopies = NBATCH; return ((size_t)h * TPOS + (row - ROW_META)) * 384; }
    if (row < ROW_PAD) { ncopies = 1; return SCN_TOTAL + (size_t)((row - ROW_SAMP) * 8 + h) * 384; }
    ncopies = 0; return 0;
}

__device__ __forceinline__ int win_cmap(int n) {
    if (n < 256) return 384 + n;
    if (n < 640) return n - 256;
    if (n < 672) return n;
    if (n < 768) return -1;
    return n - 96;
}
struct TJob { const float* src; int ldsrc; const float* kscale; bf16_t* dst; int ldd; int N, K; int mode; };
__device__ __forceinline__ void transpose_tile(const TJob& J, int tile, LAS float* scr) {
    const int ntk = J.K >> 6, tn = tile / ntk, tk = tile - tn * ntk, tid = threadIdx.x;
    {
        const int n_l = tid & 63, k0 = tid >> 6, n = tn * 64 + n_l, c = J.mode ? win_cmap(n) : n;
#pragma unroll
        for (int i = 0; i < 8; ++i) {
            const int k_l = k0 + 8 * i, k = tk * 64 + k_l;
            float v = 0.f;
            if (c >= 0) { v = J.src[(size_t)k * J.ldsrc + c]; if (J.kscale) v *= J.kscale[k]; }
            scr[k_l * 65 + n_l] = v;
        }
    }
    __syncthreads();
    {
        const int k_l = tid & 63, n0 = tid >> 6;
#pragma unroll
        for (int i = 0; i < 8; ++i) {
            const int n_l = n0 + 8 * i;
            J.dst[(size_t)(tn * 64 + n_l) * J.ldd + tk * 64 + k_l] = f2bf(scr[k_l * 65 + n_l]);
        }
    }
    __syncthreads();
}
constexpr int NJOBS = 12;
__device__ __forceinline__ TJob get_job(const Args& A, int j) {
    TJob J; J.kscale = nullptr; J.mode = 0;
    switch (j) {
    case 0:  J.src = INF(I_WIN);  J.ldsrc = INCOLS; J.kscale = INF(I_GMIX); J.dst = WSP(bf16_t, WS_WIN); J.ldd = 1024; J.N = INPAD; J.K = 1024; J.mode = 1; break;
    case 1:  J.src = INF(I_WUQ);  J.ldsrc = 768;  J.kscale = INF(I_GQ); J.dst = WSP(bf16_t, WS_WUQ); J.ldd = 384; J.N = 768; J.K = 384; break;
    case 2:  J.src = INF(I_WUK);  J.ldsrc = 512;  J.dst = WSP(bf16_t, WS_WKV); J.ldd = 256; J.N = 512; J.K = 256; break;
    case 3:  J.src = INF(I_WUV);  J.ldsrc = 512;  J.dst = WSP(bf16_t, WS_WKV) + (size_t)512 * 256; J.ldd = 256; J.N = 512; J.K = 256; break;
    case 4:  J.src = INF(I_W2);   J.ldsrc = 512;  J.dst = WSP(bf16_t, WS_WLORA); J.ldd = 256; J.N = 512; J.K = 64; break;
    case 5:  J.src = INF(I_A2);   J.ldsrc = 512;  J.dst = WSP(bf16_t, WS_WLORA) + (size_t)512 * 256 + 64; J.ldd = 256; J.N = 512; J.K = 64; break;
    case 6:  J.src = INF(I_G2);   J.ldsrc = 512;  J.dst = WSP(bf16_t, WS_WLORA) + (size_t)1024 * 256 + 128; J.ldd = 256; J.N = 512; J.K = 128; break;
    case 7:  J.src = INF(I_WOM);  J.ldsrc = 1024; J.dst = WSP(bf16_t, WS_WOM); J.ldd = 512; J.N = 1024; J.K = 512; break;
    case 8:  J.src = INF(I_WOR);  J.ldsrc = 1024; J.dst = WSP(bf16_t, WS_WOR); J.ldd = 512; J.N = 1024; J.K = 512; break;
    case 9:  J.src = INF(I_WOUT); J.ldsrc = 1024; J.dst = WSP(bf16_t, WS_WOUT); J.ldd = 1024; J.N = 1024; J.K = 1024; break;
    case 10: J.src = INF(I_WUP);  J.ldsrc = 4096; J.kscale = INF(I_GFFN); J.dst = WSP(bf16_t, WS_WUP); J.ldd = 1024; J.N = 4096; J.K = 1024; break;
    default: J.src = INF(I_WDN);  J.ldsrc = 1024; J.dst = WSP(bf16_t, WS_WDN); J.ldd = 4096; J.N = 1024; J.K = 4096; break;
    }
    return J;
}
__device__ __forceinline__ void p0_weights(const Args& A, int gtid, int gthreads, int j_lo, int j_hi, bool rest) {
#pragma unroll 1
    for (int j = j_lo; j < j_hi; ++j) {
        const TJob J = get_job(A, j);
        const int items = J.N * (J.K >> 3);
#pragma unroll 2
        for (int i = gtid; i < items; i += gthreads) {
            const int kb = i / J.N, n = i - kb * J.N, k0 = kb * 8, c = J.mode ? win_cmap(n) : n;
            float v[8];
#pragma unroll
            for (int e = 0; e < 8; ++e) v[e] = (c >= 0) ? J.src[(size_t)(k0 + e) * J.ldsrc + c] : 0.f;
            if (J.kscale) {
#pragma unroll
                for (int e = 0; e < 8; ++e) v[e] *= J.kscale[k0 + e];
            }
            *(u32x4*)(J.dst + (size_t)n * J.ldd + k0) = (u32x4){pk_bf16(v[0], v[1]), pk_bf16(v[2], v[3]), pk_bf16(v[4], v[5]), pk_bf16(v[6], v[7])};
        }
    }
    if (!rest) return;
    for (int i = gtid; i < 1536 * 256; i += gthreads) {
        const int n = i >> 8, k = i & 255, blk = n >> 9;
        const bool nz = (blk == 0) ? (k < 64) : (blk == 1) ? (k >= 64 && k < 128) : (k >= 128);
        if (!nz) WSP(bf16_t, WS_WLORA)[i] = 0;
    }
    for (int i = gtid; i < 2048 * 384; i += gthreads) {
        const int k = i % 384, n = i / 384, h = n >> 8, c = n & 255;
        const float* a = INF(I_WUQ) + (size_t)k * 768 + h * 96;
        const float* b = INF(I_WUK) + (size_t)c * 512 + h * 64;
        float s = 0.f;
#pragma unroll
        for (int q = 0; q < 16; ++q) { const f32x4 av = *(const f32x4*)(a + 4 * q), bv = *(const f32x4*)(b + 4 * q); s += av[0] * bv[0] + av[1] * bv[1] + av[2] * bv[2] + av[3] * bv[3]; }
        WSP(bf16_t, WS_WQABS)[i] = f2bf(s * INF(I_GQ)[k]);
    }
}
constexpr int P1_TAIL_CU0 = 146;
__device__ __forceinline__ void p0_prologue(const Args& A, LAS unsigned char* lds) {
    const int tid = threadIdx.x, lane = tid & 63, wid = tid >> 6, G = gridDim.x;
    const int gtid = blockIdx.x * NTHREADS + tid, gthreads = G * NTHREADS;
    p0_weights(A, gtid, gthreads, 0, 10, true);
    for (int i = gtid; i < 2065 * 16; i += gthreads) {
        const int idx = i >> 4, f = i & 15;
        const double pos = (idx == ROPE_SAMP) ? (double)PASTLEN : (double)idx;
        const double ang = pos * pow(10000.0, -(double)f / 16.0);
        WSP(float, WS_ROPE)[idx * 32 + f] = (float)cos(ang);
        WSP(float, WS_ROPE)[idx * 32 + 16 + f] = (float)sin(ang);
    }
    for (int row = blockIdx.x * NWAVES + wid; row < MROWS; row += G * NWAVES) {
        const XSrc XS{INF(I_XP), INF(I_META), INF(I_XS)};
        const float* xr = xrow_ptr(XS, row);
        bf16_t* o = WSP(bf16_t, WS_XB) + (size_t)row * DM;
        f32x4 v[4]; float ss = 0.f;
#pragma unroll
        for (int i = 0; i < 4; ++i) { v[i] = xr ? *(const f32x4*)(xr + i * 256 + lane * 4) : (f32x4){0.f, 0.f, 0.f, 0.f}; ss += v[i][0] * v[i][0] + v[i][1] * v[i][1] + v[i][2] * v[i][2] + v[i][3] * v[i][3]; }
        ss = wave_sum(ss);
        const float rs = rsqrtf(ss * (1.0f / DM) + NORM_EPS);
#pragma unroll
        for (int i = 0; i < 4; ++i) *(u32x2*)(o + i * 256 + lane * 4) = pk4(v[i] * rs);
    }
}

#define EPI_ROWS_BEGIN _Pragma("unroll") for (int ai = 0; ai < 2; ++ai) _Pragma("unroll") for (int m = 0; m < 4; ++m) { const int row = u.pm * 256 + ai * 128 + wr * 64 + m * 16 + fr;
#define EPI_COLS_BEGIN _Pragma("unroll") for (int bj = 0; bj < 2; ++bj) _Pragma("unroll") for (int n = 0; n < 2; ++n) { const int col = u.pn * 256 + bj * 128 + wc * 32 + n * 16 + fq * 4; const f32x4 v = acc[ai][bj][m][n];
#define EPI_END }

struct EpiG1 {
    static constexpr bool PERM = false, AFTER_DRAIN = false;
    float* zs; float* rw; bf16_t* gate;
    __device__ __forceinline__ void operator()(const f32x4 (&acc)[2][2][4][2], const Unit& u, int wr, int wc, int fr, int fq) const {
        EPI_ROWS_BEGIN
            EPI_COLS_BEGIN
                if (u.pn < 3) *(f32x4*)(zs + (size_t)row * 768 + col) = v;
                else if (u.pn < 10) *(f32x4*)(rw + (size_t)row * RWCOLS + (col - 768)) = v;
                else { f32x4 s; s[0] = sigmoidf_(v[0]); s[1] = sigmoidf_(v[1]); s[2] = sigmoidf_(v[2]); s[3] = sigmoidf_(v[3]); *(u32x2*)(gate + (size_t)row * 2048 + (col - 2560)) = pk4(s); }
            EPI_END
        EPI_END
    }
};
struct EpiKV {
    static constexpr bool PERM = false, AFTER_DRAIN = false;
    bf16_t* kn; bf16_t* vt;
    __device__ __forceinline__ void operator()(const f32x4 (&acc)[2][2][4][2], const Unit& u, int wr, int wc, int fr, int fq) const {
        EPI_ROWS_BEGIN
            int b0, b1, pos;
            if (row < MMAIN) { b0 = row >> 11; b1 = b0 + 1; pos = NMETA + (row & (SEQ - 1)); }
            else if (row < ROW_SAMP) { b0 = 0; b1 = NBATCH; pos = row - ROW_META; }
            else { b0 = 0; b1 = 0; pos = 0; }
            EPI_COLS_BEGIN
                if (u.pn < 2) { const u32x2 w = pk4(v); for (int b = b0; b < b1; ++b) *(u32x2*)(kn + ((size_t)b * KPITCH + pos) * 512 + col) = w; }
                else { const int hv = col - 512;
                    const int pp = (pos & ~12) | ((pos & 4) << 1) | ((pos & 8) >> 1);
                    for (int b = b0; b < b1; ++b) { bf16_t* p = vt + ((size_t)b * 512 + hv) * KPITCH + pp;
                        p[0] = f2bf(v[0]); p[KPITCH] = f2bf(v[1]); p[2 * KPITCH] = f2bf(v[2]); p[3 * KPITCH] = f2bf(v[3]); } }
            EPI_END
        EPI_END
    }
};
struct EpiLora {
    static constexpr bool PERM = false, AFTER_DRAIN = false;
    const float* w0; const float* a0; const float* k_a; const float* zk; float* scn; bf16_t* gb;
    __device__ __forceinline__ void operator()(const f32x4 (&acc)[2][2][4][2], const Unit& u, int wr, int wc, int fr, int fq) const {
        EPI_ROWS_BEGIN
            EPI_COLS_BEGIN
                if (u.pn < 2) {
                    const f32x4 w = *(const f32x4*)(w0 + col); f32x4 d;
#pragma unroll
                    for (int e = 0; e < 4; ++e) d[e] = __expf(-0.6065306597126334f * sigmoidf_(w[e] + v[e]));
                    int nc; const size_t sb = scn_base(row, col >> 6, nc) + 1 * 64 + (col & 63);
                    for (int i = 0; i < nc; ++i) *(f32x4*)(scn + sb + i * SCN_BSTRIDE) = d;
                } else if (u.pn < 4) {
                    const int c = col - 512;
                    int nc; const size_t sb = scn_base(row, c >> 6, nc) + (c & 63);
                    if (nc > 0) {
                        const f32x4 a0v = *(const f32x4*)(a0 + c), kav = *(const f32x4*)(k_a + c), zkv = *(const f32x4*)(zk + (size_t)row * 512 + c), nk = *(const f32x4*)(scn + sb + 3 * 64);
                        f32x4 ko, bo;
#pragma unroll
                        for (int e = 0; e < 4; ++e) { const float a = sigmoidf_(a0v[e] + v[e]); ko[e] = zkv[e] * (1.0f + (a - 1.0f) * kav[e]); bo[e] = -nk[e] * a; }
                        for (int i = 0; i < nc; ++i) { *(f32x4*)(scn + sb + i * SCN_BSTRIDE + 2 * 64) = ko; *(f32x4*)(scn + sb + i * SCN_BSTRIDE + 4 * 64) = bo; }
                    }
                } else {
                    *(u32x2*)(gb + (size_t)row * 512 + (col - 1024)) = pk4(v);
                }
            EPI_END
        EPI_END
    }
};
struct EpiQ {
    static constexpr bool PERM = false, AFTER_DRAIN = false;
    bf16_t* q; bf16_t* qf; const float* rope;
    __device__ __forceinline__ void operator()(const f32x4 (&acc)[2][2][4][2], const Unit& u, int wr, int wc, int fr, int fq) const {
        EPI_ROWS_BEGIN
            const int ri = rope_idx(row);
#pragma unroll
            for (int bj = 0; bj < 2; ++bj) {
                const int cb = u.pn * 256 + bj * 128 + wc * 32;
                const int g32 = cb >> 5, h = g32 / 3, part = g32 - 3 * h;
                f32x4 v0 = acc[ai][bj][m][0] * QSCALE, v1 = acc[ai][bj][m][1] * QSCALE;
                if (part == 2) {
                    const f32x4 cs = *(const f32x4*)(rope + ri * 32 + fq * 4), sn = *(const f32x4*)(rope + ri * 32 + 16 + fq * 4);
                    const f32x4 o0 = v0 * cs - v1 * sn, o1 = v0 * sn + v1 * cs; v0 = o0; v1 = o1;
                    if (row >= ROW_SAMP && row < ROW_PAD) { bf16_t* p = qf + ((size_t)(row - ROW_SAMP) * 8 + h) * 288 + 256 + fq * 4; *(u32x2*)p = pk4(v0); *(u32x2*)(p + 16) = pk4(v1); }
                }
                bf16_t* p = q + (size_t)row * 768 + cb + fq * 4;
                *(u32x2*)p = pk4(v0); *(u32x2*)(p + 16) = pk4(v1);
            }
        EPI_END
    }
};
struct EpiQabs {
    static constexpr bool PERM = false, AFTER_DRAIN = false;
    bf16_t* qf;
    __device__ __forceinline__ void operator()(const f32x4 (&acc)[2][2][4][2], const Unit& u, int wr, int wc, int fr, int fq) const {
        EPI_ROWS_BEGIN
            const int sb = row - (ROW_SAMP - ROW_META);
            EPI_COLS_BEGIN
                if (sb >= 0 && sb < DECB) { const int h = col >> 8, c = col & 255; *(u32x2*)(qf + ((size_t)sb * 8 + h) * 288 + c) = pk4(v * QSCALE); }
            EPI_END
        EPI_END
    }
};
struct EpiG4 {
    static constexpr bool PERM = false, AFTER_DRAIN = false;
    const bf16_t* gate; bf16_t* mrg;
    __device__ __forceinline__ void operator()(const f32x4 (&acc)[2][2][4][2], const Unit& u, int wr, int wc, int fr, int fq) const {
        EPI_ROWS_BEGIN
            EPI_COLS_BEGIN
                const u32x2 g = *(const u32x2*)(gate + (size_t)row * 2048 + col);
                f32x4 o; o[0] = v[0] * __uint_as_float(g.x << 16); o[1] = v[1] * __uint_as_float(g.x & 0xffff0000u); o[2] = v[2] * __uint_as_float(g.y << 16); o[3] = v[3] * __uint_as_float(g.y & 0xffff0000u);
                *(u32x2*)(mrg + (size_t)row * 1024 + col) = pk4(o);
            EPI_END
        EPI_END
    }
};
struct EpiG5 {
    static constexpr bool PERM = false, AFTER_DRAIN = false;
    const bf16_t* gate; bf16_t* mrg;
    __device__ __forceinline__ void operator()(const f32x4 (&acc)[2][2][4][2], const Unit& u, int wr, int wc, int fr, int fq) const {
        EPI_ROWS_BEGIN
            EPI_COLS_BEGIN
                const u32x2 g = *(const u32x2*)(gate + (size_t)row * 2048 + 1024 + col);
                const u32x2 t = *(const u32x2*)(mrg + (size_t)row * 1024 + col);
                f32x4 o; o[0] = __uint_as_float(t.x << 16) + v[0] * __uint_as_float(g.x << 16); o[1] = __uint_as_float(t.x & 0xffff0000u) + v[1] * __uint_as_float(g.x & 0xffff0000u);
                o[2] = __uint_as_float(t.y << 16) + v[2] * __uint_as_float(g.y << 16); o[3] = __uint_as_float(t.y & 0xffff0000u) + v[3] * __uint_as_float(g.y & 0xffff0000u);
                *(u32x2*)(mrg + (size_t)row * 1024 + col) = pk4(o);
            EPI_END
        EPI_END
    }
};
struct EpiG6 {
    static constexpr bool PERM = false, AFTER_DRAIN = false;
    XSrc X; float* x1; bf16_t* x1b; float* ssq;
    __device__ __forceinline__ void operator()(const f32x4 (&acc)[2][2][4][2], const Unit& u, int wr, int wc, int fr, int fq) const {
        EPI_ROWS_BEGIN
            const float* xr = xrow_ptr(X, row); float ss = 0.f;
            EPI_COLS_BEGIN
                const f32x4 xv = xr ? *(const f32x4*)(xr + col) : (f32x4){0.f, 0.f, 0.f, 0.f};
                const f32x4 o = xv + v;
                ss += o[0] * o[0] + o[1] * o[1] + o[2] * o[2] + o[3] * o[3];
                *(f32x4*)(x1 + (size_t)row * 1024 + col) = o; *(u32x2*)(x1b + (size_t)row * 1024 + col) = pk4(o);
            EPI_END
            ss += __shfl_xor(ss, 16); ss += __shfl_xor(ss, 32);
            if (fq == 0) atomicAdd(ssq + row, ss);
        EPI_END
    }
};
struct EpiG7 {
    static constexpr bool PERM = false, AFTER_DRAIN = false;
    const float* ssq; bf16_t* act;
    __device__ __forceinline__ void operator()(const f32x4 (&acc)[2][2][4][2], const Unit& u, int wr, int wc, int fr, int fq) const {
        EPI_ROWS_BEGIN
            const float rs = rsqrtf(ssq[row] * (1.0f / DM) + NORM_EPS);
            EPI_COLS_BEGIN
                f32x4 o;
#pragma unroll
                for (int e = 0; e < 4; ++e) { const float t = fmaxf(v[e] * rs, 0.f); o[e] = t * t; }
                *(u32x2*)(act + (size_t)row * DFF + col) = pk4(o);
            EPI_END
        EPI_END
    }
};
struct EpiG8 {
    static constexpr bool PERM = false, AFTER_DRAIN = false;
    const float* x1; float* x2; float* ssq;
    __device__ __forceinline__ void operator()(const f32x4 (&acc)[2][2][4][2], const Unit& u, int wr, int wc, int fr, int fq) const {
        EPI_ROWS_BEGIN
            float ss = 0.f;
            EPI_COLS_BEGIN
                const f32x4 o = *(const f32x4*)(x1 + (size_t)row * 1024 + col) + v;
                ss += o[0] * o[0] + o[1] * o[1] + o[2] * o[2] + o[3] * o[3];
                *(f32x4*)(x2 + (size_t)row * 1024 + col) = o;
            EPI_END
            ss += __shfl_xor(ss, 16); ss += __shfl_xor(ss, 32);
            if (fq == 0) atomicAdd(ssq + row, ss);
        EPI_END
    }
};

__device__ __forceinline__ void p2a_rows(const Args& A) {
    const int tid = threadIdx.x, lane = tid & 63, wid = tid >> 6, G = gridDim.x;
    const float* zs = WSP(float, WS_ZS); const float* rw = WSP(float, WS_RW); const float* rope = WSP(float, WS_ROPE);
    for (int row = blockIdx.x * NWAVES + wid; row < MROWS; row += G * NWAVES) {
        bf16_t* qn = WSP(bf16_t, WS_QN) + (size_t)row * 384; bf16_t* ckv = WSP(bf16_t, WS_CKV) + (size_t)row * 256; bf16_t* lin = WSP(bf16_t, WS_LIN) + (size_t)row * 256;
        if (row >= ROW_PAD) {
            *(u32x2*)(qn + lane * 4) = (u32x2){0u, 0u}; *(unsigned*)(qn + 256 + lane * 2) = 0u; *(u32x2*)(ckv + lane * 4) = (u32x2){0u, 0u}; *(u32x2*)(lin + lane * 4) = (u32x2){0u, 0u};
            continue;
        }
        int kind, b = 0, pos, ri; const float* prev;
        if (row < MMAIN) { kind = 0; b = row >> 11; const int t = row & (SEQ - 1); pos = NMETA + t; ri = pos; prev = rw + (size_t)(t == 0 ? ROW_META + NMETA - 1 : row - 1) * RWCOLS; }
        else if (row < ROW_SAMP) { kind = 1; pos = row - ROW_META; ri = pos; prev = (pos == 0) ? nullptr : rw + (size_t)(row - 1) * RWCOLS; }
        else { kind = 2; b = row - ROW_SAMP; pos = 0; ri = ROPE_SAMP; prev = INF(I_SSHIFT) + (size_t)b * RWCOLS; }
        const float* z = zs + (size_t)row * 768;
        const float* c = rw + (size_t)row * RWCOLS; const float* mu = INF(I_MU);
        const f32x4 kv = *(const f32x4*)(z + lane * 4), q0 = *(const f32x4*)(z + 256 + lane * 4); const f32x2_t q1 = *(const f32x2_t*)(z + 512 + lane * 2);
        const float rx1 = z[640 + (lane & 15)], rx2 = z[656 + (lane & 15)];
        f32x4 cc[7], pp[7];
#pragma unroll
        for (int j = 0; j < 7; ++j) { const int col = 4 * (lane + 64 * j); cc[j] = *(const f32x4*)(c + col); pp[j] = prev ? *(const f32x4*)(prev + col) : (f32x4){0.f, 0.f, 0.f, 0.f}; }
        asm volatile("" ::: "memory");
        {
            const float ss = wave_sum(kv[0] * kv[0] + kv[1] * kv[1] + kv[2] * kv[2] + kv[3] * kv[3]);
            const float rs = rsqrtf(ss * (1.0f / KVLORA) + NORM_EPS);
            const f32x4 cv = kv * rs * *(const f32x4*)(INF(I_GKV) + lane * 4);
            *(u32x2*)(ckv + lane * 4) = pk4(cv);
            if (kind == 0) *(f32x4*)(A.out + OUT_KVP + ((size_t)b * TPOS + pos) * KVW + lane * 4) = cv;
            else if (kind == 1) { for (int bb = 0; bb < NBATCH; ++bb) *(f32x4*)(A.out + OUT_KVP + ((size_t)bb * TPOS + pos) * KVW + lane * 4) = cv; }
            else *(f32x4*)(A.out + OUT_KVS + (size_t)b * KVW + lane * 4) = cv;
        }
        {
            const float ss = wave_sum(q0[0] * q0[0] + q0[1] * q0[1] + q0[2] * q0[2] + q0[3] * q0[3] + q1[0] * q1[0] + q1[1] * q1[1]);
            const float rs = rsqrtf(ss * (1.0f / QLORA) + NORM_EPS);
            *(u32x2*)(qn + lane * 4) = pk4(q0 * rs); *(unsigned*)(qn + 256 + lane * 2) = pk_bf16(q1[0] * rs, q1[1] * rs);
        }
        if (lane < 16) {
            const float cs = rope[ri * 32 + lane], sn = rope[ri * 32 + 16 + lane];
            const float o1 = rx1 * cs - rx2 * sn, o2 = rx1 * sn + rx2 * cs;
            if (kind == 2) { float* o = A.out + OUT_KVS + (size_t)b * KVW + 256; o[lane] = o1; o[16 + lane] = o2; }
            else {
                const int b0 = (kind == 0) ? b : 0, b1 = (kind == 0) ? b + 1 : NBATCH;
                for (int bb = b0; bb < b1; ++bb) {
                    float* o = A.out + OUT_KVP + ((size_t)bb * TPOS + pos) * KVW + 256; o[lane] = o1; o[16 + lane] = o2;
                    bf16_t* kr = WSP(bf16_t, WS_KR) + ((size_t)bb * KPITCH + pos) * 32; kr[lane] = f2bf(o1); kr[16 + lane] = f2bf(o2);
                }
            }
        }
        {
            float* shout = (kind == 0 && (row & (SEQ - 1)) == SEQ - 1) ? A.out + OUT_SHP + (size_t)b * RWCOLS : (kind == 2) ? A.out + OUT_SHS + (size_t)b * RWCOLS : nullptr;
#pragma unroll
            for (int j = 0; j < 7; ++j) {
                const int col = 4 * (lane + 64 * j);
                const f32x4 mm = *(const f32x4*)(mu + col);
                const f32x4 zz = cc[j] + (pp[j] - cc[j]) * mm;
                if (shout) *(f32x4*)(shout + col) = cc[j];
                if (j < 6) {
                    const int cw = col & 511, hd = cw >> 6, wi = cw & 63;
                    int nc; const size_t sbase = scn_base(row, hd, nc) + wi; float* scn = WSP(float, WS_SCN);
                    if (j < 2) { for (int i = 0; i < nc; ++i) *(f32x4*)(scn + sbase + i * SCN_BSTRIDE) = zz; }
                    else if (j < 4) {
                        *(f32x4*)(WSP(float, WS_ZK) + (size_t)row * 512 + cw) = zz;
                        const f32x4 kk = zz * *(const f32x4*)(INF(I_KK) + cw);
                        const float ss = row16_sum(kk[0] * kk[0] + kk[1] * kk[1] + kk[2] * kk[2] + kk[3] * kk[3]);
                        const float inv = -1.0f / fmaxf(sqrtf(ss), 1e-12f);
                        const f32x4 nk = kk * inv;
                        for (int i = 0; i < nc; ++i) *(f32x4*)(scn + sbase + i * SCN_BSTRIDE + 3 * 64) = nk;
                    } else { for (int i = 0; i < nc; ++i) *(f32x4*)(scn + sbase + i * SCN_BSTRIDE + 5 * 64) = zz; }
                }
                else {
                    f32x4 o;
                    if (lane < 16) { for (int e = 0; e < 4; ++e) o[e] = tanhf(zz[e]); }
                    else if (lane < 32) o = zz;
                    else { for (int e = 0; e < 4; ++e) o[e] = sigmoidf_(zz[e]); }
                    *(u32x2*)(lin + lane * 4) = pk4(o);
                }
            }
        }
    }
}

constexpr int AT_KP = 208, AT_VP = 144, AT_KBYTES = 64 * AT_KP, AT_STAGE = AT_KBYTES + 64 * AT_VP;
__device__ __forceinline__ void attn_unit(const Args& A, int b, int h, int qblk, int wid, int lane, LAS unsigned char* lds) {
    const int tid = threadIdx.x, c = lane & 31, hh = lane >> 5;
    const int qrow = b * SEQ + qblk * 256 + wid * 32 + c, qpos = NMETA + qblk * 256 + wid * 32 + c;
    const bf16_t* qp = WSP(bf16_t, WS_Q) + (size_t)qrow * 768 + h * 96 + 8 * hh;
    bf16x8 qf[6];
#pragma unroll
    for (int s = 0; s < 6; ++s) qf[s] = *(const bf16x8*)(qp + 16 * s);
    f32x16 o0, o1;
#pragma unroll
    for (int i = 0; i < 16; ++i) { o0[i] = 0.f; o1[i] = 0.f; }
    float mrun = -1e30f, lrun = 0.f;
    const int nkt = 8 * qblk + wid + 2;
    const int nst = 4 * qblk + 5;
    const int qmin = NMETA + qblk * 256 + wid * 32;
    const bf16_t* gkn = WSP(bf16_t, WS_KN) + ((size_t)b * KPITCH + (tid >> 3)) * 512 + h * 64 + (tid & 7) * 8;
    const bf16_t* gvt = WSP(bf16_t, WS_VT) + ((size_t)(b * 8 + h) * 64 + (tid >> 3)) * KPITCH + (tid & 7) * 8;
    const bf16_t* gkr = WSP(bf16_t, WS_KR) + ((size_t)b * KPITCH + ((tid & 255) >> 2)) * 32 + (tid & 3) * 8;
    const int lkn = (tid >> 3) * AT_KP + (tid & 7) * 16, lvt = AT_KBYTES + (tid >> 3) * AT_VP + (tid & 7) * 16, lkr = ((tid & 255) >> 2) * AT_KP + 128 + (tid & 3) * 16;
    u32x4 rk, rv, rr;
#define AT_GLOAD(st) do { rk = *(const u32x4*)(gkn + (size_t)(st) * (64 * 512)); rv = *(const u32x4*)(gvt + (st) * 64); if (tid < 256) rr = *(const u32x4*)(gkr + (size_t)(st) * (64 * 32)); } while (0)
#define AT_LSTORE(buf) do { LAS unsigned char* _b = lds + (buf) * AT_STAGE; *(LAS u32x4*)(_b + lkn) = rk; *(LAS u32x4*)(_b + lvt) = rv; if (tid < 256) *(LAS u32x4*)(_b + lkr) = rr; } while (0)
    __syncthreads();
    AT_GLOAD(0); AT_LSTORE(0);
    __syncthreads();
    for (int st = 0; st < nst; ++st) {
        const LAS unsigned char* kb = lds + (st & 1) * AT_STAGE;
        if (st + 1 < nst) AT_GLOAD(st + 1);
#pragma unroll
        for (int half = 0; half < 2; ++half) {
            const int kt = 2 * st + half;
            if (kt < nkt) {
                const LAS unsigned char* kp = kb + (32 * half + c) * AT_KP + 16 * hh;
                const LAS unsigned char* vp = kb + AT_KBYTES + c * AT_VP + (32 * half) * 2 + 16 * hh;
                f32x16 sa;
#pragma unroll
                for (int i = 0; i < 16; ++i) sa[i] = 0.f;
#pragma unroll
                for (int s = 0; s < 6; ++s) sa = __builtin_amdgcn_mfma_f32_32x32x16_bf16(*(const LAS bf16x8*)(kp + 32 * s), qf[s], sa, 0, 0, 0);
                if (32 * kt + 31 > qmin) {
#pragma unroll
                    for (int i = 0; i < 16; ++i) { const int key = 32 * kt + (i & 3) + 8 * (i >> 2) + 4 * hh; if (key > qpos) sa[i] = -1e30f; }
                }
                float mx = sa[0];
#pragma unroll
                for (int i = 1; i < 16; ++i) mx = fmaxf(mx, sa[i]);
                mx = fmaxf(mx, __shfl_xor(mx, 32));
                const float mnew = fmaxf(mrun, mx), alpha = __builtin_amdgcn_exp2f(mrun - mnew);
                float ps = 0.f;
#pragma unroll
                for (int i = 0; i < 16; ++i) { sa[i] = __builtin_amdgcn_exp2f(sa[i] - mnew); ps += sa[i]; }
                ps += __shfl_xor(ps, 32);
                lrun = lrun * alpha + ps; mrun = mnew;
                if (__any(alpha != 1.0f)) { o0 *= alpha; o1 *= alpha; }
#pragma unroll
                for (int s = 0; s < 2; ++s) {
                    u32x4 pw; pw[0] = pk_bf16(sa[8 * s], sa[8 * s + 1]); pw[1] = pk_bf16(sa[8 * s + 2], sa[8 * s + 3]); pw[2] = pk_bf16(sa[8 * s + 4], sa[8 * s + 5]); pw[3] = pk_bf16(sa[8 * s + 6], sa[8 * s + 7]);
                    const bf16x8 pf = __builtin_bit_cast(bf16x8, pw);
                    o0 = __builtin_amdgcn_mfma_f32_32x32x16_bf16(*(const LAS bf16x8*)(vp + 32 * s), pf, o0, 0, 0, 0);
                    o1 = __builtin_amdgcn_mfma_f32_32x32x16_bf16(*(const LAS bf16x8*)(vp + 32 * AT_VP + 32 * s), pf, o1, 0, 0, 0);
                }
            }
        }
        if (st + 1 < nst) AT_LSTORE((st + 1) & 1);
        __syncthreads();
    }
#undef AT_GLOAD
#undef AT_LSTORE
    const float inv = 1.0f / lrun;
    bf16_t* op = WSP(bf16_t, WS_O) + (size_t)qrow * 512 + h * 64 + 4 * hh;
#pragma unroll
    for (int g = 0; g < 4; ++g) {
        *(u32x2*)(op + 8 * g) = pk4((f32x4){o0[4 * g] * inv, o0[4 * g + 1] * inv, o0[4 * g + 2] * inv, o0[4 * g + 3] * inv});
        *(u32x2*)(op + 32 + 8 * g) = pk4((f32x4){o1[4 * g] * inv, o1[4 * g + 1] * inv, o1[4 * g + 2] * inv, o1[4 * g + 3] * inv});
    }
}
__device__ __forceinline__ void p3_attention(const Args& A, LAS unsigned char* lds) {
    const int tid = threadIdx.x, lane = tid & 63, wid = tid >> 6;
    for (int p = blockIdx.x; p < 256; p += gridDim.x) {
        const int b = p >> 5, h = (p >> 2) & 7, qq = p & 3;
        attn_unit(A, b, h, 7 - qq, wid, lane, lds);
        attn_unit(A, b, h, qq, wid, lane, lds);
    }
}

__device__ __forceinline__ void bar4(volatile LAS unsigned* cnt, unsigned& epoch, int lane) {
    epoch += 4u;
    asm volatile("s_waitcnt lgkmcnt(0)" ::: "memory");
    if (lane == 0) (void)__hip_atomic_fetch_add((LAS unsigned*)cnt, 1u, __ATOMIC_RELAXED, __HIP_MEMORY_SCOPE_WORKGROUP);
    for (unsigned sp = 0;; ++sp) { const unsigned v = (unsigned)__builtin_amdgcn_readfirstlane((int)*cnt); if ((int)(v - epoch) >= 0 || sp > (1u << 24)) break; __builtin_amdgcn_s_sleep(1); }
    asm volatile("" ::: "memory");
}
__device__ __forceinline__ void attn_unit4(const Args& A, int b, int h, int qblk, int hf, int wid, int lane, LAS unsigned char* lds, volatile LAS unsigned* bcnt, unsigned& epoch) {
    const int tid = wid * 64 + lane, c = lane & 31, hh = lane >> 5;
    const int r0 = qblk * 256 + hf * 128 + wid * 32;
    const int qrow = b * SEQ + r0 + c, qpos = NMETA + r0 + c;
    const bf16_t* qp = WSP(bf16_t, WS_Q) + (size_t)qrow * 768 + h * 96 + 8 * hh;
    bf16x8 qf[6];
#pragma unroll
    for (int s = 0; s < 6; ++s) qf[s] = *(const bf16x8*)(qp + 16 * s);
    f32x16 o0, o1;
#pragma unroll
    for (int i = 0; i < 16; ++i) { o0[i] = 0.f; o1[i] = 0.f; }
    float mrun = -1e30f, lrun = 0.f;
    const int nkt = 8 * qblk + 4 * hf + wid + 2;
    const int nst = 4 * qblk + 2 * hf + 3;
    const int qmin = NMETA + r0;
    const bf16_t* gkn = WSP(bf16_t, WS_KN) + ((size_t)b * KPITCH + (tid >> 3)) * 512 + h * 64 + (tid & 7) * 8;
    const bf16_t* gvt = WSP(bf16_t, WS_VT) + ((size_t)(b * 8 + h) * 64 + (tid >> 3)) * KPITCH + (tid & 7) * 8;
    const bf16_t* gkr = WSP(bf16_t, WS_KR) + ((size_t)b * KPITCH + (tid >> 2)) * 32 + (tid & 3) * 8;
    const int lkn = (tid >> 3) * AT_KP + (tid & 7) * 16, lvt = AT_KBYTES + (tid >> 3) * AT_VP + (tid & 7) * 16, lkr = (tid >> 2) * AT_KP + 128 + (tid & 3) * 16;
    u32x4 rk0, rk1, rv0, rv1, rr;
#define AT_GLOAD(st) do { rk0 = *(const u32x4*)(gkn + (size_t)(st) * (64 * 512)); rk1 = *(const u32x4*)(gkn + (size_t)(st) * (64 * 512) + 32 * 512); \
        rv0 = *(const u32x4*)(gvt + (st) * 64); rv1 = *(const u32x4*)(gvt + (st) * 64 + (size_t)32 * KPITCH); rr = *(const u32x4*)(gkr + (size_t)(st) * (64 * 32)); } while (0)
#define AT_LSTORE(buf) do { LAS unsigned char* _b = lds + (buf) * AT_STAGE; *(LAS u32x4*)(_b + lkn) = rk0; *(LAS u32x4*)(_b + lkn + 32 * AT_KP) = rk1; \
        *(LAS u32x4*)(_b + lvt) = rv0; *(LAS u32x4*)(_b + lvt + 32 * AT_VP) = rv1; *(LAS u32x4*)(_b + lkr) = rr; } while (0)
    bar4(bcnt, epoch, lane);
    AT_GLOAD(0); AT_LSTORE(0);
    bar4(bcnt, epoch, lane);
    for (int st = 0; st < nst; ++st) {
        const LAS unsigned char* kb = lds + (st & 1) * AT_STAGE;
        if (st + 1 < nst) AT_GLOAD(st + 1);
#pragma unroll
        for (int half = 0; half < 2; ++half) {
            const int kt = 2 * st + half;
            if (kt < nkt) {
                const LAS unsigned char* kp = kb + (32 * half + c) * AT_KP + 16 * hh;
                const LAS unsigned char* vp = kb + AT_KBYTES + c * AT_VP + (32 * half) * 2 + 16 * hh;
                f32x16 sa;
#pragma unroll
                for (int i = 0; i < 16; ++i) sa[i] = 0.f;
#pragma unroll
                for (int s = 0; s < 6; ++s) sa = __builtin_amdgcn_mfma_f32_32x32x16_bf16(*(const LAS bf16x8*)(kp + 32 * s), qf[s], sa, 0, 0, 0);
                if (32 * kt + 31 > qmin) {
#pragma unroll
                    for (int i = 0; i < 16; ++i) { const int key = 32 * kt + (i & 3) + 8 * (i >> 2) + 4 * hh; if (key > qpos) sa[i] = -1e30f; }
                }
                float mx = sa[0];
#pragma unroll
                for (int i = 1; i < 16; ++i) mx = fmaxf(mx, sa[i]);
                mx = fmaxf(mx, __shfl_xor(mx, 32));
                const float mnew = fmaxf(mrun, mx), alpha = __builtin_amdgcn_exp2f(mrun - mnew);
                float ps = 0.f;
#pragma unroll
                for (int i = 0; i < 16; ++i) { sa[i] = __builtin_amdgcn_exp2f(sa[i] - mnew); ps += sa[i]; }
                ps += __shfl_xor(ps, 32);
                lrun = lrun * alpha + ps; mrun = mnew;
                if (__any(alpha != 1.0f)) { o0 *= alpha; o1 *= alpha; }
#pragma unroll
                for (int s = 0; s < 2; ++s) {
                    u32x4 pw; pw[0] = pk_bf16(sa[8 * s], sa[8 * s + 1]); pw[1] = pk_bf16(sa[8 * s + 2], sa[8 * s + 3]); pw[2] = pk_bf16(sa[8 * s + 4], sa[8 * s + 5]); pw[3] = pk_bf16(sa[8 * s + 6], sa[8 * s + 7]);
                    const bf16x8 pf = __builtin_bit_cast(bf16x8, pw);
                    o0 = __builtin_amdgcn_mfma_f32_32x32x16_bf16(*(const LAS bf16x8*)(vp + 32 * s), pf, o0, 0, 0, 0);
                    o1 = __builtin_amdgcn_mfma_f32_32x32x16_bf16(*(const LAS bf16x8*)(vp + 32 * AT_VP + 32 * s), pf, o1, 0, 0, 0);
                }
            }
        }
        if (st + 1 < nst) AT_LSTORE((st + 1) & 1);
        bar4(bcnt, epoch, lane);
    }
#undef AT_GLOAD
#undef AT_LSTORE
    const float inv = 1.0f / lrun;
    bf16_t* op = WSP(bf16_t, WS_O) + (size_t)qrow * 512 + h * 64 + 4 * hh;
#pragma unroll
    for (int g = 0; g < 4; ++g) {
        *(u32x2*)(op + 8 * g) = pk4((f32x4){o0[4 * g] * inv, o0[4 * g + 1] * inv, o0[4 * g + 2] * inv, o0[4 * g + 3] * inv});
        *(u32x2*)(op + 32 + 8 * g) = pk4((f32x4){o1[4 * g] * inv, o1[4 * g + 1] * inv, o1[4 * g + 2] * inv, o1[4 * g + 3] * inv});
    }
}

__device__ __forceinline__ void scan_sample_step(const Args& A, int slot, int lane) {
    const int sb = slot >> 3, h = slot & 7, rho = lane >> 4, kq = lane & 15, row = ROW_SAMP + sb;
    const float* rec = WSP(float, WS_SCN) + SCN_TOTAL + (size_t)slot * 384;
    const f32x4 rr = *(const f32x4*)(rec + 4 * kq), ww = *(const f32x4*)(rec + 64 + 4 * kq), kk = *(const f32x4*)(rec + 128 + 4 * kq),
                aa = *(const f32x4*)(rec + 192 + 4 * kq), bb = *(const f32x4*)(rec + 256 + 4 * kq);
    const float* s0 = INF(I_SWKV) + (size_t)slot * 4096; float* s1 = A.out + OUT_WKVS + (size_t)slot * 4096;
#pragma unroll 4
    for (int i = 0; i < 16; ++i) {
        const int v = 4 * i + rho;
        f32x4 S = *(const f32x4*)(s0 + v * 64 + 4 * kq);
        const float vv = rec[320 + v];
        const float sa = row16_sum(S[0] * aa[0] + S[1] * aa[1] + S[2] * aa[2] + S[3] * aa[3]);
        S = S * ww + sa * bb + vv * kk;
        const float y = row16_sum(S[0] * rr[0] + S[1] * rr[1] + S[2] * rr[2] + S[3] * rr[3]);
        *(f32x4*)(s1 + v * 64 + 4 * kq) = S;
        if (kq == 0) WSP(float, WS_Y)[(size_t)row * 512 + h * 64 + v] = y;
    }
}
__device__ __forceinline__ void x1_task(const Args& A, int bh, int ch, int lane, LAS unsigned char* scr) {
    const int c = lane & 15, q = lane >> 4;
    const float* src = WSP(float, WS_SCN) + ((size_t)bh * TPOS + 16 * ch) * 384;
    unsigned char* dst = A.ws + WS_CH + ((size_t)bh * 129 + ch) * CH_BYTES;
    constexpr int PIT = 144;
    constexpr int L_BH = 0, L_KH = 2304, L_AT = 4608, L_RT = 6912, L_BT = 9216, L_KT = 11264, L_VV = 13312, L_MAB = 15360;
    {
        float g = 1.f; float bt[16], kt[16], vv[16];
#pragma unroll
        for (int t = 0; t < 16; ++t) {
            const float* p = src + t * 384 + lane;
            const float r = p[0], w = p[64], k = p[128], a = p[192], b = p[256]; vv[t] = p[320];
            const float gp = g; g *= w; const float ig = 1.0f / g;
            bt[t] = b * ig; kt[t] = k * ig;
            *(LAS bf16_t*)(scr + L_BH + t * PIT + lane * 2) = f2bf(bt[t]); *(LAS bf16_t*)(scr + L_KH + t * PIT + lane * 2) = f2bf(kt[t]);
            *(LAS bf16_t*)(scr + L_AT + t * PIT + lane * 2) = f2bf(a * gp); *(LAS bf16_t*)(scr + L_RT + t * PIT + lane * 2) = f2bf(r * g);
        }
        *(float*)(dst + CH_GAM + lane * 4) = g;
        u32x4 w0, w1;
#pragma unroll
        for (int i = 0; i < 4; ++i) { w0[i] = pk_bf16(bt[2 * i] * g, bt[2 * i + 1] * g); w1[i] = pk_bf16(bt[8 + 2 * i] * g, bt[9 + 2 * i] * g); }
        *(LAS u32x4*)(scr + L_BT + lane * 32) = w0; *(LAS u32x4*)(scr + L_BT + lane * 32 + 16) = w1;
#pragma unroll
        for (int i = 0; i < 4; ++i) { w0[i] = pk_bf16(kt[2 * i] * g, kt[2 * i + 1] * g); w1[i] = pk_bf16(kt[8 + 2 * i] * g, kt[9 + 2 * i] * g); }
        *(LAS u32x4*)(scr + L_KT + lane * 32) = w0; *(LAS u32x4*)(scr + L_KT + lane * 32 + 16) = w1;
#pragma unroll
        for (int i = 0; i < 4; ++i) { w0[i] = pk_bf16(vv[2 * i], vv[2 * i + 1]); w1[i] = pk_bf16(vv[8 + 2 * i], vv[9 + 2 * i]); }
        *(LAS u32x4*)(scr + L_VV + lane * 32) = w0; *(LAS u32x4*)(scr + L_VV + lane * 32 + 16) = w1;
    }
    f32x4 mab = {0.f, 0.f, 0.f, 0.f}, mak = mab, mbr = mab, mkr = mab;
#pragma unroll
    for (int kb = 0; kb < 2; ++kb) {
        const int o = c * PIT + (32 * kb + 8 * q) * 2;
        const bf16x8 fb = *(const LAS bf16x8*)(scr + L_BH + o), fk = *(const LAS bf16x8*)(scr + L_KH + o), fa = *(const LAS bf16x8*)(scr + L_AT + o), fr = *(const LAS bf16x8*)(scr + L_RT + o);
        mab = __builtin_amdgcn_mfma_f32_16x16x32_bf16(fb, fa, mab, 0, 0, 0); mbr = __builtin_amdgcn_mfma_f32_16x16x32_bf16(fb, fr, mbr, 0, 0, 0);
        mak = __builtin_amdgcn_mfma_f32_16x16x32_bf16(fk, fa, mak, 0, 0, 0); mkr = __builtin_amdgcn_mfma_f32_16x16x32_bf16(fk, fr, mkr, 0, 0, 0);
    }
#pragma unroll
    for (int r = 0; r < 4; ++r) { const int s = 4 * q + r;
        if (!(s < c)) { mab[r] = 0.f; mak[r] = 0.f; } if (!(s <= c)) { mbr[r] = 0.f; mkr[r] = 0.f; }
        *(LAS float*)(scr + L_MAB + (s * 16 + c) * 4) = mab[r]; }
    float T[16];
#pragma unroll
    for (int s = 15; s >= 0; --s) {
        f32x4 n[4];
#pragma unroll
        for (int i = 0; i < 4; ++i) n[i] = *(const LAS f32x4*)(scr + L_MAB + s * 64 + i * 16);
        float acc = (s == c) ? 1.f : 0.f;
#pragma unroll
        for (int t = s + 1; t < 16; ++t) acc += n[t >> 2][t & 3] * T[t];
        T[s] = acc;
    }
    {
        f32x4 ts;
#pragma unroll
        for (int j = 0; j < 4; ++j) ts[j] = (q == 0) ? T[j] : (q == 1) ? T[4 + j] : (q == 2) ? T[8 + j] : T[12 + j];
        *(u32x4*)(dst + CH_TT + lane * 16) = (u32x4){pk_bf16(ts[0], ts[1]), pk_bf16(ts[2], ts[3]), 0u, 0u};
        *(u32x4*)(dst + CH_MAK + lane * 16) = (u32x4){0u, 0u, pk_bf16(mak[0], mak[1]), pk_bf16(mak[2], mak[3])};
        *(u32x4*)(dst + CH_MBR + lane * 16) = (u32x4){pk_bf16(mbr[0], mbr[1]), pk_bf16(mbr[2], mbr[3]), pk_bf16(mkr[0], mkr[1]), pk_bf16(mkr[2], mkr[3])};
#pragma unroll
        for (int tile = 0; tile < 2; ++tile)
#pragma unroll
            for (int kb = 0; kb < 2; ++kb) {
                const LAS unsigned char* p = scr + (tile ? L_RT : L_AT) + c * PIT + (32 * kb + 4 * q) * 2;
                const u32x2 lo = *(const LAS u32x2*)p, hi = *(const LAS u32x2*)(p + 32);
                *(u32x4*)(dst + CH_AR + (tile * 2 + kb) * 1024 + lane * 16) = (u32x4){lo.x, lo.y, hi.x, hi.y};
            }
#pragma unroll
        for (int mt = 0; mt < 4; ++mt) {
            const u32x2 lo = *(const LAS u32x2*)(scr + L_BT + (16 * mt + c) * 32 + 8 * q), hi = *(const LAS u32x2*)(scr + L_KT + (16 * mt + c) * 32 + 8 * q);
            *(u32x4*)(dst + CH_BK + mt * 1024 + lane * 16) = (u32x4){lo.x, lo.y, hi.x, hi.y};
            *(u32x2*)(dst + CH_V + mt * 512 + lane * 8) = *(const LAS u32x2*)(scr + L_VV + (16 * mt + c) * 32 + 8 * q);
        }
    }
}
__device__ __forceinline__ void p4_x1(const Args& A, LAS unsigned char* lds) {
    const int tid = threadIdx.x, lane = tid & 63, wid = __builtin_amdgcn_readfirstlane(tid >> 6);
    for (int task = blockIdx.x * NWAVES + wid; task < 64 * 129; task += gridDim.x * NWAVES) x1_task(A, task / 129, task % 129, lane, lds + wid * 16384);
}
struct X2Early { u32x4 ar0, ar1, mak, tt; u32x2 v; };
struct X2Late { u32x4 ar2, ar3, mbr, bk[4]; f32x4 gam[4]; };
__device__ __forceinline__ void x2_scan(const Args& A, int bh, int g, int lane) {
    const int c = lane & 15, q = lane >> 4, b = bh >> 3, h = bh & 7, vcol = 16 * g + c;
    const unsigned char* base = A.ws + WS_CH + (size_t)bh * 129 * CH_BYTES;
#define X2_LOADE(O, ch) do { const unsigned char* _p = base + (size_t)(ch) * CH_BYTES; \
        O.ar0 = *(const u32x4*)(_p + CH_AR + lane * 16); O.ar1 = *(const u32x4*)(_p + CH_AR + 1024 + lane * 16); \
        O.mak = *(const u32x4*)(_p + CH_MAK + lane * 16); O.tt = *(const u32x4*)(_p + CH_TT + lane * 16); O.v = *(const u32x2*)(_p + CH_V + g * 512 + lane * 8); } while (0)
#define X2_LOADL(O, ch) do { const unsigned char* _p = base + (size_t)(ch) * CH_BYTES; \
        O.ar2 = *(const u32x4*)(_p + CH_AR + 2048 + lane * 16); O.ar3 = *(const u32x4*)(_p + CH_AR + 3072 + lane * 16); O.mbr = *(const u32x4*)(_p + CH_MBR + lane * 16); \
        _Pragma("unroll") for (int _i = 0; _i < 4; ++_i) { O.bk[_i] = *(const u32x4*)(_p + CH_BK + _i * 1024 + lane * 16); O.gam[_i] = *(const f32x4*)(_p + CH_GAM + (16 * _i + 4 * q) * 4); } } while (0)
#define BF8(x) __builtin_bit_cast(bf16x8, x)
    f32x4 zt[4];
#pragma unroll
    for (int i = 0; i < 4; ++i) zt[i] = (f32x4){0.f, 0.f, 0.f, 0.f};
    float* py = WSP(float, WS_Y) + h * 64 + vcol;
    const f32x4 z4 = {0.f, 0.f, 0.f, 0.f};
    X2Early e0, e1, e2; X2Late l0, l1;
    X2_LOADE(e0, 0); X2_LOADL(l0, 0); X2_LOADE(e1, 1);
#pragma unroll 1
    for (int ch = 0; ch < 129; ++ch) {
        asm volatile("" ::: "memory");
        { const int c2 = (ch + 2 < 129) ? ch + 2 : 128, c1 = (ch + 1 < 129) ? ch + 1 : 128; X2_LOADE(e2, c2); X2_LOADL(l1, c1); }
        asm volatile("" ::: "memory");
        const u32x4 zb0 = {pk_bf16(zt[0][0], zt[0][1]), pk_bf16(zt[0][2], zt[0][3]), pk_bf16(zt[1][0], zt[1][1]), pk_bf16(zt[1][2], zt[1][3])};
        const u32x4 zb1 = {pk_bf16(zt[2][0], zt[2][1]), pk_bf16(zt[2][2], zt[2][3]), pk_bf16(zt[3][0], zt[3][1]), pk_bf16(zt[3][2], zt[3][3])};
        f32x4 x1a = __builtin_amdgcn_mfma_f32_16x16x32_bf16(BF8(e0.ar0), BF8(zb0), z4, 0, 0, 0);
        x1a = __builtin_amdgcn_mfma_f32_16x16x32_bf16(BF8(e0.ar1), BF8(zb1), x1a, 0, 0, 0);
        const u32x4 bp2 = {0u, 0u, e0.v.x, e0.v.y};
        const f32x4 p2 = __builtin_amdgcn_mfma_f32_16x16x32_bf16(BF8(e0.mak), BF8(bp2), x1a, 0, 0, 0);
        const u32x4 bu = {pk_bf16(p2[0], p2[1]), pk_bf16(p2[2], p2[3]), 0u, 0u};
        const f32x4 u = __builtin_amdgcn_mfma_f32_16x16x32_bf16(BF8(e0.tt), BF8(bu), z4, 0, 0, 0);
        const u32x4 buv = {pk_bf16(u[0], u[1]), pk_bf16(u[2], u[3]), e0.v.x, e0.v.y};
        f32x4 x1r = __builtin_amdgcn_mfma_f32_16x16x32_bf16(BF8(l0.ar2), BF8(zb0), z4, 0, 0, 0);
        x1r = __builtin_amdgcn_mfma_f32_16x16x32_bf16(BF8(l0.ar3), BF8(zb1), x1r, 0, 0, 0);
        const f32x4 y = __builtin_amdgcn_mfma_f32_16x16x32_bf16(BF8(l0.mbr), BF8(buv), x1r, 0, 0, 0);
#pragma unroll
        for (int i = 0; i < 4; ++i) zt[i] = __builtin_amdgcn_mfma_f32_16x16x32_bf16(BF8(l0.bk[i]), BF8(buv), zt[i] * l0.gam[i], 0, 0, 0);
#pragma unroll
        for (int r = 0; r < 4; ++r) { const int t = 16 * ch + 4 * q + r; py[(size_t)(t < NMETA ? ROW_META + t : b * SEQ + (t - NMETA)) * 512] = y[r]; }
        e0 = e1; e1 = e2; l0 = l1;
    }
#undef X2_LOADE
#undef X2_LOADL
#undef BF8
#pragma unroll
    for (int i = 0; i < 4; ++i) *(f32x4*)(A.out + OUT_WKVP + ((size_t)bh * 64 + vcol) * 64 + 16 * i + 4 * q) = zt[i];
}

__device__ __forceinline__ void decode_run(const Args& A, int cu, int wid, int lane, const LAS unsigned char* qlds, LAS unsigned char* tl, volatile LAS unsigned* qctr) {
    const int sb = cu >> 1, c = lane & 15, q = lane >> 4;
    const LAS unsigned char* qrd = qlds + (c < 8 ? c : 8) * 576 + q * 16;
    bf16x8 sel0, sel1;
#pragma unroll
    for (int e = 0; e < 8; ++e) { sel0[e] = (q == (c >> 3) && e == (c & 7)) ? (short)0x3F80 : (short)0; sel1[e] = (q == 2 + (c >> 3) && e == (c & 7)) ? (short)0x3F80 : (short)0; }
    f32x4 acc[16];
#pragma unroll
    for (int i = 0; i < 16; ++i) acc[i] = (f32x4){0.f, 0.f, 0.f, 0.f};
    float mrun = -1e30f, lpart = 0.f;
    const int* ptb = (const int*)A.in[I_PT] + sb * NPAGES + (cu & 1) * 32;
    f32x4 X[18];
    const size_t lane_off = (size_t)lane * 4;
    const LAS unsigned char* trd = tl + c * 576 + 16 * q; LAS unsigned char* twr = tl + lane * 8;
#define DEC_LOAD(ptr) do { _Pragma("unroll") for (int _n = 0; _n < 18; ++_n) X[_n] = *(const f32x4*)((ptr) + 256 * _n); } while (0)
    for (;;) {
    unsigned kk = 0;
    if (lane == 0) kk = __hip_atomic_fetch_add((LAS unsigned*)qctr, 1u, __ATOMIC_RELAXED, __HIP_MEMORY_SCOPE_WORKGROUP);
    kk = __builtin_amdgcn_readfirstlane(kk);
    if (kk >= 16u) break;
    const int* pt = ptb + 2 * (int)kk;
    const float* page = INF(I_CACHE) + (size_t)pt[0] * (PAGESZ * KVW);
    DEC_LOAD(page + lane_off);
    asm volatile("" ::: "memory");
#pragma unroll 1
    for (int tile = 0; tile < 16; ++tile) {
        bf16x8 C[9];
#pragma unroll
        for (int n = 0; n < 18; ++n) *(LAS u32x2*)(twr + 512 * n) = (u32x2){pk_bf16(X[n][0], X[n][1]), pk_bf16(X[n][2], X[n][3])};
#pragma unroll
        for (int s = 0; s < 9; ++s) C[s] = *(const LAS bf16x8*)(trd + 64 * s);
        asm volatile("" ::: "memory");
        {
            const int tn = (tile + 1 < 16) ? tile + 1 : tile;
            const float* pg = INF(I_CACHE) + (size_t)pt[tn >> 3] * (PAGESZ * KVW) + (size_t)((tn & 7) * 16) * KVW;
            DEC_LOAD(pg + lane_off);
        }
        asm volatile("" ::: "memory");
        f32x4 st = {0.f, 0.f, 0.f, 0.f};
#pragma unroll
        for (int s = 0; s < 9; ++s) st = __builtin_amdgcn_mfma_f32_16x16x32_bf16(C[s], *(const LAS bf16x8*)(qrd + 64 * s), st, 0, 0, 0);
        float mx = fmaxf(fmaxf(st[0], st[1]), fmaxf(st[2], st[3]));
        mx = fmaxf(mx, __shfl_xor(mx, 16)); mx = fmaxf(mx, __shfl_xor(mx, 32));
        const float mnew = fmaxf(mrun, mx), alpha = exp2f(mrun - mnew);
        mrun = mnew;
        f32x4 p; float ps = 0.f;
#pragma unroll
        for (int r = 0; r < 4; ++r) { p[r] = exp2f(st[r] - mnew); ps += p[r]; }
        lpart = lpart * alpha + ps;
        u32x4 pw; pw[0] = pk_bf16(p[0], p[1]); pw[1] = pk_bf16(p[2], p[3]); pw[2] = 0u; pw[3] = 0u;
        const bf16x8 pa = __builtin_bit_cast(bf16x8, pw);
        if (__any(alpha != 1.0f)) {
            f32x4 al;
#pragma unroll
            for (int r = 0; r < 4; ++r) al[r] = __shfl(alpha, (4 * q + r) & 7);
#pragma unroll
            for (int g = 0; g < 16; ++g) acc[g] *= al;
        }
#pragma unroll
        for (int s = 0; s < 8; ++s) {
            const f32x4 z4 = {0.f, 0.f, 0.f, 0.f};
            const f32x4 t0 = __builtin_amdgcn_mfma_f32_16x16x32_bf16(C[s], sel0, z4, 0, 0, 0);
            const f32x4 t1 = __builtin_amdgcn_mfma_f32_16x16x32_bf16(C[s], sel1, z4, 0, 0, 0);
            u32x4 b0; b0[0] = pk_bf16(t0[0], t0[1]); b0[1] = pk_bf16(t0[2], t0[3]); b0[2] = 0u; b0[3] = 0u;
            u32x4 b1; b1[0] = pk_bf16(t1[0], t1[1]); b1[1] = pk_bf16(t1[2], t1[3]); b1[2] = 0u; b1[3] = 0u;
            acc[2 * s] = __builtin_amdgcn_mfma_f32_16x16x32_bf16(pa, __builtin_bit_cast(bf16x8, b0), acc[2 * s], 0, 0, 0);
            acc[2 * s + 1] = __builtin_amdgcn_mfma_f32_16x16x32_bf16(pa, __builtin_bit_cast(bf16x8, b1), acc[2 * s + 1], 0, 0, 0);
        }
    }
    }
#undef DEC_LOAD
    float lsum = lpart; lsum += __shfl_xor(lsum, 16); lsum += __shfl_xor(lsum, 32);
    float* part = WSP(float, WS_PART) + (size_t)(cu * 8 + wid) * (8 * 260);
    if (q < 2) {
#pragma unroll
        for (int g = 0; g < 16; ++g)
#pragma unroll
            for (int r = 0; r < 4; ++r) part[(4 * q + r) * 260 + 16 * g + c] = acc[g][r];
    }
    if (q == 0 && c < 8) { part[c * 260 + 256] = mrun; part[c * 260 + 257] = lsum; }
}
#define EVT(e) do { if (lane == 0) ((volatile LAS unsigned*)(lds + LDS_MISC))[32 + (e)] = (unsigned)__builtin_amdgcn_s_memrealtime(); } while (0)
constexpr int LDS5_DECQ = 2 * AT_STAGE, LDS5_DECT = LDS5_DECQ + 5184;
__device__ __forceinline__ void p5_mixed(const Args& A, LAS unsigned char* lds) {
    const int tid = threadIdx.x, lane = tid & 63, wid = __builtin_amdgcn_readfirstlane(tid >> 6), G = gridDim.x, cu = blockIdx.x;
    volatile LAS unsigned* misc = (volatile LAS unsigned*)(lds + LDS_MISC);
    {
        LAS unsigned char* qlds = lds + LDS5_DECQ; const bf16_t* qg = WSP(bf16_t, WS_QF) + (size_t)(cu >> 1) * 8 * 288;
        if (tid < 288) *(LAS u32x4*)(qlds + tid * 16) = *(const u32x4*)((const char*)qg + tid * 16);
        else if (tid < 324) *(LAS u32x4*)(qlds + tid * 16) = (u32x4){0u, 0u, 0u, 0u};
    }
    __syncthreads();
    if (wid < 4) {
        unsigned epoch = 0u;
        const int b = cu >> 5, h = (cu >> 2) & 7, qq = cu & 3;
        attn_unit4(A, b, h, 7 - qq, 1, wid, lane, lds, misc + 48, epoch);
        attn_unit4(A, b, h, 7 - qq, 0, wid, lane, lds, misc + 48, epoch);
        attn_unit4(A, b, h, qq, 1, wid, lane, lds, misc + 48, epoch);
        attn_unit4(A, b, h, qq, 0, wid, lane, lds, misc + 48, epoch);
    } else {
        const int dw = wid - 4;
        for (int s = cu * 4 + dw; s < 1024; s += G * 4) scan_sample_step(A, s, lane);
        if (dw == 0) x2_scan(A, cu >> 2, cu & 3, lane);
    }
    decode_run(A, cu, wid, lane, lds + LDS5_DECQ, lds + LDS5_DECT + wid * 9216, misc + 40);
}

__device__ __forceinline__ void p5a_post(const Args& A, LAS unsigned char* lds) {
    const int tid = threadIdx.x, lane = tid & 63, wid = tid >> 6, G = gridDim.x;
    for (int row = blockIdx.x * NWAVES + wid; row < MROWS; row += G * NWAVES) {
        bf16_t* o = WSP(bf16_t, WS_ORW) + (size_t)row * 512 + lane * 8;
        if (row >= ROW_PAD || (row >= ROW_META && row < ROW_SAMP)) { *(u32x4*)o = (u32x4){0u, 0u, 0u, 0u}; continue; }
        const size_t ro = (size_t)row * 512 + lane * 8;
        int ncop; const float* rec = WSP(float, WS_SCN) + scn_base(row, lane >> 3, ncop) + (lane & 7) * 8;
        f32x4 y[2], r[2], k[2], v[2];
#pragma unroll
        for (int i = 0; i < 2; ++i) { y[i] = *(const f32x4*)(WSP(float, WS_Y) + ro + 4 * i); r[i] = *(const f32x4*)(rec + 4 * i); k[i] = *(const f32x4*)(rec + 128 + 4 * i); v[i] = *(const f32x4*)(rec + 320 + 4 * i); }
        float s1 = 0.f, rk = 0.f;
#pragma unroll
        for (int i = 0; i < 2; ++i) { const f32x4 rkw = *(const f32x4*)(INF(I_RK) + lane * 8 + 4 * i);
            for (int e = 0; e < 4; ++e) { s1 += y[i][e]; rk += r[i][e] * k[i][e] * rkw[e]; } }
        s1 += __shfl_xor(s1, 1); s1 += __shfl_xor(s1, 2); s1 += __shfl_xor(s1, 4);
        rk += __shfl_xor(rk, 1); rk += __shfl_xor(rk, 2); rk += __shfl_xor(rk, 4);
        const float mean = s1 * (1.0f / 64.0f);
        float s2 = 0.f;
#pragma unroll
        for (int i = 0; i < 2; ++i) for (int e = 0; e < 4; ++e) { const float d = y[i][e] - mean; s2 += d * d; }
        s2 += __shfl_xor(s2, 1); s2 += __shfl_xor(s2, 2); s2 += __shfl_xor(s2, 4);
        const float rstd = rsqrtf(s2 * (1.0f / 64.0f) + GN_EPS);
        const u32x4 gw = *(const u32x4*)(WSP(bf16_t, WS_GB) + ro);
        f32x4 out[2];
#pragma unroll
        for (int i = 0; i < 2; ++i) { const f32x4 lw = *(const f32x4*)(INF(I_LNW) + lane * 8 + 4 * i), lb = *(const f32x4*)(INF(I_LNB) + lane * 8 + 4 * i);
            for (int e = 0; e < 4; ++e) { const unsigned g2 = gw[2 * i + (e >> 1)]; const float g = __uint_as_float((e & 1) ? (g2 & 0xffff0000u) : (g2 << 16));
                out[i][e] = ((y[i][e] - mean) * rstd * lw[e] + lb[e] + rk * v[i][e]) * g; } }
        const u32x2 a = pk4(out[0]), b2 = pk4(out[1]);
        *(u32x4*)o = (u32x4){a.x, a.y, b2.x, b2.y};
    }
    LAS float* ol = (LAS float*)lds;
    for (int sb = blockIdx.x; sb < DECB; sb += G) {
        const int h = tid >> 6, c4 = (tid & 63) * 4;
        const float* kvs = A.out + OUT_KVS + (size_t)sb * KVW;
        const bf16_t* qf = WSP(bf16_t, WS_QF) + ((size_t)sb * 8 + h) * 288;
        float sp = 0.f;
        { const u32x2 qw = *(const u32x2*)(qf + c4); const f32x4 kv = *(const f32x4*)(kvs + c4);
          sp = __uint_as_float(qw.x << 16) * kv[0] + __uint_as_float(qw.x & 0xffff0000u) * kv[1] + __uint_as_float(qw.y << 16) * kv[2] + __uint_as_float(qw.y & 0xffff0000u) * kv[3];
          if (lane < 32) sp += bf2f(qf[256 + lane]) * kvs[256 + lane]; }
        const float sself = wave_sum(sp);
        const float* part = WSP(float, WS_PART) + (size_t)(sb * 16) * (8 * 260) + h * 260;
        float M = sself;
#pragma unroll
        for (int i = 0; i < 16; ++i) M = fmaxf(M, part[(size_t)i * (8 * 260) + 256]);
        const float wself = exp2f(sself - M);
        float L = wself; f32x4 o = *(const f32x4*)(kvs + c4) * wself;
#pragma unroll
        for (int i = 0; i < 16; ++i) { const float* pi = part + (size_t)i * (8 * 260); const float w = exp2f(pi[256] - M); L += pi[257] * w; o += *(const f32x4*)(pi + c4) * w; }
        const float invL = 1.0f / L;
        __syncthreads();
        ol[h * 256 + c4] = o[0] * invL; ol[h * 256 + c4 + 1] = o[1] * invL; ol[h * 256 + c4 + 2] = o[2] * invL; ol[h * 256 + c4 + 3] = o[3] * invL;
        __syncthreads();
        { const int hv = tid, hh = hv >> 6; const float* wv = INF(I_WUV) + hv; float s = 0.f;
#pragma unroll 8
          for (int cc = 0; cc < 256; ++cc) s += ol[hh * 256 + cc] * wv[(size_t)cc * 512];
          WSP(bf16_t, WS_O)[(size_t)(ROW_SAMP + sb) * 512 + hv] = f2bf(s); }
    }
    for (int i = blockIdx.x * NTHREADS + tid; i < (MROWS - MMAIN) * 512; i += G * NTHREADS) {
        const int row = MMAIN + i / 512; if (row < ROW_SAMP || row >= ROW_PAD) WSP(bf16_t, WS_O)[(size_t)MMAIN * 512 + i] = 0;
    }
}

template <int KS, class Epi>
__device__ __forceinline__ void skinny_gemm(const bf16_t* A_, const bf16_t* Bt, int N, int K, const Epi& E, LAS unsigned char* lds) {
    constexpr int MT = 8 / KS, MG = 8 / MT;
    const int tid = threadIdx.x, lane = tid & 63, wid = __builtin_amdgcn_readfirstlane(tid >> 6), c = lane & 15, q = lane >> 4;
    const int n_items = (N >> 4) * MG, kw = K / KS;
    for (int it = blockIdx.x; it < n_items; it += gridDim.x) {
        const int nt = it / MG, mg = it - nt * MG, mtl = wid % MT, ks = wid / MT, mt = mg * MT + mtl;
        const bf16_t* ap = A_ + (size_t)(mt * 16 + c) * K + ks * kw + 8 * q;
        const bf16_t* bp = Bt + (size_t)(nt * 16 + c) * K + ks * kw + 8 * q;
        f32x4 acc = {0.f, 0.f, 0.f, 0.f};
#pragma unroll 8
        for (int k = 0; k < kw; k += 32) acc = __builtin_amdgcn_mfma_f32_16x16x32_bf16(*(const bf16x8*)(ap + k), *(const bf16x8*)(bp + k), acc, 0, 0, 0);
        if (KS > 1) {
            *(LAS f32x4*)(lds + wid * 1024 + lane * 16) = acc;
            __syncthreads();
            if (ks == 0) {
#pragma unroll
                for (int s = 1; s < KS; ++s) acc += *(const LAS f32x4*)(lds + (s * MT + mtl) * 1024 + lane * 16);
            }
            __syncthreads();
        }
        if (ks == 0) E(acc, mt * 16 + 4 * q, nt * 16 + c, c);
    }
}
struct SkG4 { const bf16_t* gate; bf16_t* mrg;
    __device__ __forceinline__ void operator()(const f32x4& acc, int sr0, int col, int) const {
#pragma unroll
        for (int r = 0; r < 4; ++r) { const size_t row = ROW_SAMP + sr0 + r; mrg[row * 1024 + col] = f2bf(acc[r] * bf2f(gate[row * 2048 + col])); } } };
struct SkG5 { const bf16_t* gate; bf16_t* mrg;
    __device__ __forceinline__ void operator()(const f32x4& acc, int sr0, int col, int) const {
#pragma unroll
        for (int r = 0; r < 4; ++r) { const size_t row = ROW_SAMP + sr0 + r; mrg[row * 1024 + col] = f2bf(bf2f(mrg[row * 1024 + col]) + acc[r] * bf2f(gate[row * 2048 + 1024 + col])); } } };
struct SkG6 { const float* xs; float* x1; bf16_t* x1b; float* ssq;
    __device__ __forceinline__ void operator()(const f32x4& acc, int sr0, int col, int) const {
#pragma unroll
        for (int r = 0; r < 4; ++r) { const size_t row = ROW_SAMP + sr0 + r; const float o = xs[(size_t)(sr0 + r) * DM + col] + acc[r];
            x1[row * 1024 + col] = o; x1b[row * 1024 + col] = f2bf(o); const float ss = row16_sum(o * o); if ((threadIdx.x & 15) == 0) atomicAdd(ssq + row, ss); } } };
struct SkG7 { const float* ssq; bf16_t* act;
    __device__ __forceinline__ void operator()(const f32x4& acc, int sr0, int col, int) const {
#pragma unroll
        for (int r = 0; r < 4; ++r) { const size_t row = ROW_SAMP + sr0 + r; const float t = fmaxf(acc[r] * rsqrtf(ssq[row] * (1.0f / DM) + NORM_EPS), 0.f); act[row * DFF + col] = f2bf(t * t); } } };
struct SkG8 { const float* x1; float* x2; float* ssq;
    __device__ __forceinline__ void operator()(const f32x4& acc, int sr0, int col, int) const {
#pragma unroll
        for (int r = 0; r < 4; ++r) { const size_t row = ROW_SAMP + sr0 + r; const float o = x1[row * 1024 + col] + acc[r];
            x2[row * 1024 + col] = o; const float ss = row16_sum(o * o); if ((threadIdx.x & 15) == 0) atomicAdd(ssq + row, ss); } } };

__device__ __forceinline__ void p9_final(const Args& A) {
    const int tid = threadIdx.x, lane = tid & 63, wid = tid >> 6, G = gridDim.x;
    for (int row = blockIdx.x * NWAVES + wid; row < ROW_PAD; row += G * NWAVES) {
        float* o;
        if (row < MMAIN) o = A.out + OUT_YP + (size_t)row * DM;
        else if (row >= ROW_SAMP) o = A.out + OUT_YS + (size_t)(row - ROW_SAMP) * DM;
        else continue;
        const float rs = rsqrtf(WSP(float, WS_SSQ2)[row] * (1.0f / DM) + NORM_EPS);
        const float* x = WSP(float, WS_X2) + (size_t)row * DM;
#pragma unroll
        for (int i = 0; i < 4; ++i) *(f32x4*)(o + i * 256 + lane * 4) = *(const f32x4*)(x + i * 256 + lane * 4) * rs * *(const f32x4*)(INF(I_GFINAL) + i * 256 + lane * 4);
    }
}

#ifndef MK_LAUNCHES
#define MK_LAUNCHES 1
#endif
#ifndef REP_A
#define REP_A 1
#endif
#ifndef REP_B
#define REP_B 1
#endif
#ifndef REP_T
#define REP_T 1
#endif
constexpr int NPHASES = 12;
constexpr int CW_BAR = 0;

__global__ void __launch_bounds__(NTHREADS, 2) mk_fwd(Args A) {
    extern __shared__ __attribute__((aligned(16))) unsigned char lds_raw[];
    LAS unsigned char* lds = (LAS unsigned char*)lds_raw;
    volatile LAS unsigned* misc = (volatile LAS unsigned*)(lds + LDS_MISC);
    const int tid = threadIdx.x;
    if (tid < 64) misc[tid] = 0u;
    __syncthreads();
    const int lo = A.ph_lo, hi = A.ph_hi;
    XcdBarrier bar; bar.bar = WSP(unsigned, WS_CTL) + CW_BAR; bar.x = 0; bar.st = nullptr;
    if (hi - lo > 1) bar = xcd_barrier_post(WSP(unsigned, WS_CTL) + CW_BAR, misc + 8);
#ifndef PH_MASK
#define PH_MASK 0xfff
#endif
#define IN(k) (((PH_MASK >> (k)) & 1) && lo <= (k) && (k) < hi)
#define SEAM(k) do { if (IN(k) && IN((k) + 1)) xcd_barrier(bar); } while (0)
    const int G = gridDim.x, cid = blockIdx.x;
#ifdef PROBE_K
    unsigned long long pr_t0 = __builtin_amdgcn_s_memrealtime(), pr_t1 = pr_t0;
#define PROBE_AT(k) do { if ((k) == PROBE_K) pr_t1 = __builtin_amdgcn_s_memrealtime(); } while (0)
#else
#define PROBE_AT(k) do { } while (0)
#endif

    if (IN(0)) { for (int r = 0; r < REP_T; ++r) p0_prologue(A, lds); }
    SEAM(0); PROBE_AT(0);
    if (IN(1)) {
        pg8::Gemm g{WSP(bf16_t, WS_XB), WSP(bf16_t, WS_WIN), MROWS, INPAD, DM}; pg8::StaticOrder S; S.init(MROWS, INPAD, G, cid);
        EpiG1 E{WSP(float, WS_ZS), WSP(float, WS_RW), WSP(bf16_t, WS_GATE)};
#ifndef REP_G1
#define REP_G1 1
#endif
        for (int r = 0; r < REP_G1; ++r) pg8::gemm_phase<EpiG1, pg8::StaticOrder, true, true>(lds, g, S, E);
        if (cid >= P1_TAIL_CU0) p0_weights(A, (cid - P1_TAIL_CU0) * NTHREADS + tid, (G - P1_TAIL_CU0) * NTHREADS, 10, NJOBS, false);
    }
    SEAM(1); PROBE_AT(1);
    if (IN(2)) { for (int r = 0; r < REP_T; ++r) p2a_rows(A); }
    SEAM(2); PROBE_AT(2);
    if (IN(3)) {
#ifndef P3SEL
#define P3SEL 15
#endif
        if (P3SEL & 1) {
            pg8::Gemm g{WSP(bf16_t, WS_CKV), WSP(bf16_t, WS_WKV), MROWS, 1024, 256}; pg8::StaticOrder S; S.init(MROWS, 1024, G, (cid + 128) % G);
            EpiKV E{WSP(bf16_t, WS_KN), WSP(bf16_t, WS_VT)};
            pg8::gemm_phase<EpiKV, pg8::StaticOrder, false, false>(lds, g, S, E);
        }
        if (P3SEL & 2) {
            pg8::Gemm g{WSP(bf16_t, WS_LIN), WSP(bf16_t, WS_WLORA), MROWS, 1536, 256}; pg8::StaticOrder S; S.init(MROWS, 1536, G, (cid + 64) % G);
            EpiLora E{INF(I_W0), INF(I_A0), INF(I_KA), WSP(float, WS_ZK), WSP(float, WS_SCN), WSP(bf16_t, WS_GB)};
            pg8::gemm_phase<EpiLora, pg8::StaticOrder, false, false>(lds, g, S, E);
        }
        if (P3SEL & 4) {
            pg8::Gemm g{WSP(bf16_t, WS_QN), WSP(bf16_t, WS_WUQ), MROWS, 768, 384}; pg8::StaticOrder S; S.init(MROWS, 768, G, cid);
            EpiQ E{WSP(bf16_t, WS_Q), WSP(bf16_t, WS_QF), WSP(float, WS_ROPE)};
            pg8::gemm_phase<EpiQ, pg8::StaticOrder, false, false>(lds, g, S, E);
        }
        if (P3SEL & 8) {
            pg8::Gemm g{WSP(bf16_t, WS_QN) + (size_t)ROW_META * 384, WSP(bf16_t, WS_WQABS), 256, 2048, 384}; pg8::StaticOrder S; S.init(256, 2048, G, (cid + 120) % G);
            EpiQabs E{WSP(bf16_t, WS_QF)};
            pg8::gemm_phase<EpiQabs, pg8::StaticOrder, false, false>(lds, g, S, E);
        }
    }
    SEAM(3); PROBE_AT(3);
    if (IN(4)) { p4_x1(A, lds); }
    SEAM(4); PROBE_AT(4);
    if (IN(5)) {
        p5_mixed(A, lds);
    }
    SEAM(5); PROBE_AT(5);
    if (IN(6)) { for (int r = 0; r < REP_T; ++r) p5a_post(A, lds); }
    SEAM(6); PROBE_AT(6);
    if (IN(7)) {
        {   pg8::Gemm g{WSP(bf16_t, WS_O), WSP(bf16_t, WS_WOM), MMAIN, 1024, 512}; pg8::StaticOrder S; S.init(MMAIN, 1024, G, cid);
            EpiG4 E{WSP(bf16_t, WS_GATE), WSP(bf16_t, WS_MRG)};
            pg8::gemm_phase<EpiG4, pg8::StaticOrder, false, false>(lds, g, S, E); }
        {   pg8::Gemm g{WSP(bf16_t, WS_ORW), WSP(bf16_t, WS_WOR), MMAIN, 1024, 512}; pg8::StaticOrder S; S.init(MMAIN, 1024, G, cid);
            EpiG5 E{WSP(bf16_t, WS_GATE), WSP(bf16_t, WS_MRG)};
            pg8::gemm_phase<EpiG5, pg8::StaticOrder, false, false>(lds, g, S, E); }
        skinny_gemm<4>(WSP(bf16_t, WS_O) + (size_t)ROW_SAMP * 512, WSP(bf16_t, WS_WOM), 1024, 512, SkG4{WSP(bf16_t, WS_GATE), WSP(bf16_t, WS_MRG)}, lds);
        skinny_gemm<4>(WSP(bf16_t, WS_ORW) + (size_t)ROW_SAMP * 512, WSP(bf16_t, WS_WOR), 1024, 512, SkG5{WSP(bf16_t, WS_GATE), WSP(bf16_t, WS_MRG)}, lds);
    }
    SEAM(7); PROBE_AT(7);
    if (IN(8)) {
        pg8::Gemm g{WSP(bf16_t, WS_MRG), WSP(bf16_t, WS_WOUT), MMAIN, 1024, 1024}; pg8::StaticOrder S; S.init(MMAIN, 1024, G, cid);
        EpiG6 E{XSrc{INF(I_XP), INF(I_META), INF(I_XS)}, WSP(float, WS_X1), WSP(bf16_t, WS_X1B), WSP(float, WS_SSQ1)};
        pg8::gemm_phase<EpiG6, pg8::StaticOrder, false, true>(lds, g, S, E);
        skinny_gemm<4>(WSP(bf16_t, WS_MRG) + (size_t)ROW_SAMP * 1024, WSP(bf16_t, WS_WOUT), 1024, 1024, SkG6{INF(I_XS), WSP(float, WS_X1), WSP(bf16_t, WS_X1B), WSP(float, WS_SSQ1)}, lds);
    }
    SEAM(8); PROBE_AT(8);
    if (IN(9)) {
        pg8::Gemm g{WSP(bf16_t, WS_X1B), WSP(bf16_t, WS_WUP), MMAIN, DFF, 1024}; pg8::StaticOrder S; S.init(MMAIN, DFF, G, cid);
        EpiG7 E{WSP(float, WS_SSQ1), WSP(bf16_t, WS_ACT)};
#ifndef REP_G7
#define REP_G7 1
#endif
        for (int r = 0; r < REP_G7; ++r) pg8::gemm_phase<EpiG7, pg8::StaticOrder, true, true>(lds, g, S, E);
        skinny_gemm<1>(WSP(bf16_t, WS_X1B) + (size_t)ROW_SAMP * 1024, WSP(bf16_t, WS_WUP), DFF, 1024, SkG7{WSP(float, WS_SSQ1), WSP(bf16_t, WS_ACT)}, lds);
    }
    SEAM(9); PROBE_AT(9);
    if (IN(10)) {
        pg8::Gemm g{WSP(bf16_t, WS_ACT), WSP(bf16_t, WS_WDN), MMAIN, 1024, DFF}; pg8::StaticOrder S; S.init(MMAIN, 1024, G, cid);
        EpiG8 E{WSP(float, WS_X1), WSP(float, WS_X2), WSP(float, WS_SSQ2)};
        pg8::gemm_phase<EpiG8, pg8::StaticOrder, false, true>(lds, g, S, E);
        skinny_gemm<4>(WSP(bf16_t, WS_ACT) + (size_t)ROW_SAMP * DFF, WSP(bf16_t, WS_WDN), 1024, DFF, SkG8{WSP(float, WS_X1), WSP(float, WS_X2), WSP(float, WS_SSQ2)}, lds);
    }
    SEAM(10); PROBE_AT(10);
    if (IN(11)) { for (int r = 0; r < REP_T; ++r) p9_final(A); }
#ifdef PROBE_K
#ifdef PROBE_E1
    if (cid == 0 && tid == 0) { pr_t0 = misc[32 + PROBE_E1]; pr_t1 = misc[32 + PROBE_E2]; }
#endif
    if (cid == 0 && tid == 0) { const unsigned long long te = __builtin_amdgcn_s_memrealtime(), want = 4ull * (unsigned)((unsigned)pr_t1 - (unsigned)pr_t0);
        while (__builtin_amdgcn_s_memrealtime() - te < want) __builtin_amdgcn_s_sleep(16); }
#endif
#undef IN
#undef SEAM
}

extern "C" void kernel_launch(void* const* d_in, const int* in_sizes, int n_in, void* d_out, int out_size, void* d_ws, size_t ws_size, hipStream_t stream) {
    static int grid = 0;
    if (grid == 0) {
        if (n_in != N_IN || (size_t)out_size != OUT_END || ws_size < WS_END) { fprintf(stderr, "kernel_launch: unexpected sizes: n_in %d out %d (want %zu) ws %zu (want %zu)\n", n_in, out_size, (size_t)OUT_END, ws_size, (size_t)WS_END); grid = -1; return; }
        int dev = 0, cus = 0, per_cu = 0;
        if (hipGetDevice(&dev) != hipSuccess || hipDeviceGetAttribute(&cus, hipDeviceAttributeMultiprocessorCount, dev) != hipSuccess) { grid = -1; return; }
        if (hipFuncSetAttribute((const void*)mk_fwd, hipFuncAttributeMaxDynamicSharedMemorySize, LDS_BYTES) != hipSuccess) { fprintf(stderr, "kernel_launch: hipFuncSetAttribute failed\n"); grid = -1; return; }
        if (hipOccupancyMaxActiveBlocksPerMultiprocessor(&per_cu, (const void*)mk_fwd, NTHREADS, LDS_BYTES) != hipSuccess || per_cu < 1) { fprintf(stderr, "kernel_launch: occupancy query says %d\n", per_cu); }
        (void)hipGetLastError();
        if (cus < 256) { fprintf(stderr, "kernel_launch: needs 256 CUs\n"); grid = -1; return; }
        grid = 256;
    }
    if (grid < 0) return;
    (void)hipMemsetAsync(d_ws, 0, WS_ZERO_END, stream);
    Args a{};
    for (int i = 0; i < N_IN; ++i) a.in[i] = d_in[i];
    a.out = (float*)d_out; a.ws = (unsigned char*)d_ws;
#if MK_LAUNCHES == 1
    a.ph_lo = 0; a.ph_hi = NPHASES;
    hipLaunchKernelGGL(mk_fwd, dim3(grid), dim3(NTHREADS), LDS_BYTES, stream, a);
#else
    for (int ph = 0; ph < NPHASES; ++ph) { a.ph_lo = ph; a.ph_hi = ph + 1; hipLaunchKernelGGL(mk_fwd, dim3(grid), dim3(NTHREADS), LDS_BYTES, stream, a); }
#endif
}
```

```cpp
#include <hip/hip_runtime.h>
#include <cstdio>
#include <cstdint>
#define LAS __attribute__((address_space(3)))
#define MK_LAUNCHES 1
namespace pg8 {
#define PG8_LAS __attribute__((address_space(3)))
typedef unsigned short bf16_t;
typedef short bf16x8 __attribute__((ext_vector_type(8)));
typedef float f32x4 __attribute__((ext_vector_type(4)));
typedef unsigned u32x4 __attribute__((ext_vector_type(4)));
constexpr int BM = 256, BK = 64, HALF = 128, HTB = HALF * BK * 2  , STAGE_BYTES = 8 * HTB, NXCD = 8, WGM = 8;

__host__ __device__ __forceinline__ int lds_byte(int r, int c) { const int st = (r >> 4) * 2 + (c >> 5), rr = r & 15, cc = c & 31, ob = rr * 64 + cc * 2; return st * 1024 + (ob ^ (((ob >> 9) & 1) << 5)); }
__host__ __device__ __forceinline__ void stage_rc(int b, int& R, int& C) { const int st = b / 1024, sb = b % 1024, swz = sb ^ (((sb >> 9) & 1) << 5); R = (st >> 1) * 16 + swz / 64; C = (st & 1) * 32 + (swz % 64) / 2; }
__host__ __device__ __forceinline__ int perm32(int rho) { const int n = rho >> 4, i = rho & 15; return 8 * (i >> 2) + 4 * n + (i & 3); }

struct Unit { int pm, pn; };
struct Gemm { const bf16_t* A; const bf16_t* Bt; int M, N, K; };

struct StaticOrder {
    int nM, nN, nwg, G, c;
    __host__ __device__ void init(int M, int N, int G_, int c_) { nM = M / BM; nN = N / BM; nwg = nM * nN; G = G_; c = c_; }
    __host__ __device__ bool next(int i, Unit& u) const {
        const long L = (long)i * G + c; if (L >= nwg) return false;
        int wgid = (int)L; { const int q = nwg / NXCD, r = nwg % NXCD, xcd = wgid % NXCD, off = wgid / NXCD; wgid = (xcd < r ? xcd * (q + 1) : r * (q + 1) + (xcd - r) * q) + off; }
        const int nig = WGM * nN, gid = wgid / nig, fm = gid * WGM, gsz = (nM - fm) < WGM ? (nM - fm) : WGM;
        u.pm = fm + ((wgid % nig) % gsz); u.pn = (wgid % nig) / gsz; return true;
    }
    __device__ __forceinline__ void a_ready(const Unit&) const {}
    __device__ __forceinline__ void done(const Unit&) const {}
};


template <class Epi, class Sched, bool ALIGN_EPI = false, bool SP2 = false>
__device__ __forceinline__ void gemm_phase(PG8_LAS unsigned char* lds, const Gemm g, const Sched& S, const Epi& E) {
    const int tid = threadIdx.x, wid = __builtin_amdgcn_readfirstlane(tid >> 6), lane = tid & 63, wr = wid >> 2, wc = wid & 3, fr = lane & 15, fq = lane >> 4;
    const int K = g.K, nt = K / BK;
    unsigned voffA[2], voffB[2];
#pragma unroll
    for (int i = 0; i < 2; ++i) { int R, C; stage_rc(tid * 16 + i * 8192, R, C); const int Rb = Epi::PERM ? ((R & ~31) + perm32(R & 31)) : R;
        voffA[i] = (unsigned)(R * K + C) * 2u; voffB[i] = (unsigned)(Rb * K + C) * 2u; }
    const size_t kstep = (size_t)(BK * 2);
    const size_t hstep = (size_t)HALF * K * 2;
    const size_t tstep = 2 * hstep;
    const unsigned ldsw = (unsigned)wid * 1024u;
    const int aoff = lds_byte(wr * 64 + fr, fq * 8), boff = lds_byte(wc * 32 + fr, fq * 8);
#define PG8_SA(b, h) (((b) * 2 + (h)) * HTB)
#define PG8_SB(b, h) ((4 + (b) * 2 + (h)) * HTB)
#define PG8_STAGE(bufoff, gbase, voff) do { _Pragma("unroll") for (int _i = 0; _i < 2; ++_i) \
        __builtin_amdgcn_global_load_lds((const unsigned*)((const char*)(gbase) + (voff)[_i]), (PG8_LAS unsigned*)(lds + (bufoff) + ldsw + _i * 8192), 16, 0, 0); } while (0)
#define PG8_LDA(dst, b, h) do { _Pragma("unroll") for (int m = 0; m < 4; ++m) _Pragma("unroll") for (int k = 0; k < 2; ++k) dst[m][k] = *(const PG8_LAS bf16x8*)(lds + PG8_SA(b, h) + aoff + m * 2048 + k * 1024); } while (0)
#define PG8_LDB(dst, b, h) do { _Pragma("unroll") for (int n = 0; n < 2; ++n) _Pragma("unroll") for (int k = 0; k < 2; ++k) dst[n][k] = *(const PG8_LAS bf16x8*)(lds + PG8_SB(b, h) + boff + n * 2048 + k * 1024); } while (0)
#define PG8_MMA(ai, bj, At, Bt) do { __builtin_amdgcn_s_setprio(1); _Pragma("unroll") for (int m = 0; m < 4; ++m) _Pragma("unroll") for (int n = 0; n < 2; ++n) _Pragma("unroll") for (int k = 0; k < 2; ++k) \
        acc[ai][bj][m][n] = __builtin_amdgcn_mfma_f32_16x16x32_bf16(Bt[n][k], At[m][k], acc[ai][bj][m][n], 0, 0, 0); __builtin_amdgcn_s_setprio(0); } while (0)
#define PG8_WAIT_V(n) asm volatile("s_waitcnt vmcnt(" #n ")" ::: "memory")
#define PG8_WAIT_L(n) asm volatile("s_waitcnt lgkmcnt(" #n ")" ::: "memory")
#define PG8_BAR __builtin_amdgcn_s_barrier()
#define PG8_SCHED __builtin_amdgcn_sched_barrier(0)
    Unit cur, nxt; int ui = 0;
    if (!S.next(0, cur)) return;
    f32x4 acc[2][2][4][2];
#pragma unroll
    for (int a = 0; a < 2; ++a)
#pragma unroll
        for (int b = 0; b < 2; ++b)
#pragma unroll
            for (int m = 0; m < 4; ++m)
#pragma unroll
                for (int n = 0; n < 2; ++n) acc[a][b][m][n] = (f32x4){0.f, 0.f, 0.f, 0.f};
    bf16x8 At[4][2], B0[2][2], B1[2][2];
    const char* cA = (const char*)g.A + (size_t)cur.pm * tstep; const char* cB = (const char*)g.Bt + (size_t)cur.pn * tstep;
    S.a_ready(cur);
    if constexpr (SP2) {
        PG8_STAGE(PG8_SB(0, 0), cB, voffB); PG8_STAGE(PG8_SB(0, 1), cB + hstep, voffB); PG8_STAGE(PG8_SA(0, 0), cA, voffA); PG8_STAGE(PG8_SA(0, 1), cA + hstep, voffA);
        if (wr == 1) PG8_BAR;
        PG8_WAIT_V(2); PG8_BAR;
        PG8_STAGE(PG8_SB(1, 0), cB + kstep, voffB); PG8_STAGE(PG8_SA(1, 0), cA + kstep, voffA); PG8_STAGE(PG8_SB(1, 1), cB + hstep + kstep, voffB);
        PG8_WAIT_V(6); PG8_BAR;
    } else {
        PG8_STAGE(PG8_SB(0, 0), cB, voffB); PG8_STAGE(PG8_SA(0, 0), cA, voffA); PG8_STAGE(PG8_SB(0, 1), cB + hstep, voffB); PG8_STAGE(PG8_SA(0, 1), cA + hstep, voffA);
        if (wr == 1) PG8_BAR;
        PG8_WAIT_V(4); PG8_BAR;
        PG8_STAGE(PG8_SB(1, 0), cB + kstep, voffB); PG8_STAGE(PG8_SA(1, 0), cA + kstep, voffA); PG8_STAGE(PG8_SB(1, 1), cB + hstep + kstep, voffB);
        PG8_WAIT_V(6); PG8_BAR;
    }
    for (;;) {
        const bool has_next = S.next(ui + 1, nxt);
        const char* nA = has_next ? (const char*)g.A + (size_t)nxt.pm * tstep : cA; const char* nB = has_next ? (const char*)g.Bt + (size_t)nxt.pn * tstep : cB;
_Pragma("nounroll")
        for (int t = 0; t < nt; t += 2) {
            const bool last = (t == nt - 2);
            const char* a1 = cA + (size_t)(t + 1) * kstep;
            const char* a2 = last ? nA : cA + (size_t)(t + 2) * kstep; const char* b2 = last ? nB : cB + (size_t)(t + 2) * kstep;
            const char* a3 = a2 + kstep; const char* b3 = b2 + kstep;
            if (last && has_next) S.a_ready(nxt);
            if constexpr (SP2) {
            PG8_LDB(B0, 0, 0); PG8_LDB(B1, 0, 1); PG8_SCHED; PG8_LDA(At, 0, 0); PG8_STAGE(PG8_SA(1, 1), a1 + hstep, voffA);
            PG8_WAIT_V(8); PG8_WAIT_L(0); PG8_BAR; PG8_MMA(0, 0, At, B0); PG8_MMA(0, 1, At, B1); PG8_BAR; PG8_SCHED;
            PG8_LDA(At, 0, 1); PG8_STAGE(PG8_SB(0, 0), b2, voffB); PG8_STAGE(PG8_SB(0, 1), b2 + hstep, voffB); PG8_STAGE(PG8_SA(0, 0), a2, voffA);
            PG8_WAIT_V(8); PG8_WAIT_L(0); PG8_BAR; PG8_MMA(1, 0, At, B0); PG8_MMA(1, 1, At, B1); PG8_BAR; PG8_SCHED;
            PG8_LDB(B0, 1, 0); PG8_LDB(B1, 1, 1); PG8_SCHED; PG8_LDA(At, 1, 0); PG8_STAGE(PG8_SA(0, 1), a2 + hstep, voffA);
            PG8_WAIT_V(8); PG8_WAIT_L(0); PG8_BAR; PG8_MMA(0, 0, At, B0); PG8_MMA(0, 1, At, B1); PG8_BAR; PG8_SCHED;
            PG8_LDA(At, 1, 1); PG8_STAGE(PG8_SB(1, 0), b3, voffB); PG8_STAGE(PG8_SB(1, 1), b3 + hstep, voffB); PG8_STAGE(PG8_SA(1, 0), a3, voffA);
            PG8_WAIT_V(8); PG8_WAIT_L(0); PG8_BAR; PG8_MMA(1, 0, At, B0); PG8_MMA(1, 1, At, B1); PG8_BAR; PG8_SCHED;
            } else {
            PG8_LDB(B0, 0, 0); PG8_SCHED; PG8_LDA(At, 0, 0); PG8_STAGE(PG8_SA(1, 1), a1 + hstep, voffA);
            PG8_WAIT_L(8); PG8_BAR; PG8_WAIT_L(0); PG8_MMA(0, 0, At, B0); PG8_BAR; PG8_SCHED;
            PG8_LDB(B1, 0, 1); PG8_STAGE(PG8_SB(0, 0), b2, voffB);
            PG8_BAR; PG8_WAIT_L(0); PG8_MMA(0, 1, At, B1); PG8_BAR;
            PG8_LDA(At, 0, 1); PG8_STAGE(PG8_SA(0, 0), a2, voffA);
            PG8_BAR; PG8_WAIT_L(0); PG8_MMA(1, 0, At, B0); PG8_BAR; PG8_SCHED;
            PG8_STAGE(PG8_SB(0, 1), b2 + hstep, voffB);
            PG8_WAIT_V(6); PG8_BAR; PG8_MMA(1, 1, At, B1); PG8_BAR;
            PG8_LDB(B0, 1, 0); PG8_SCHED; PG8_LDA(At, 1, 0); PG8_STAGE(PG8_SA(0, 1), a2 + hstep, voffA);
            PG8_WAIT_L(8); PG8_BAR; PG8_WAIT_L(0); PG8_MMA(0, 0, At, B0); PG8_BAR; PG8_SCHED;
            PG8_LDB(B1, 1, 1); PG8_STAGE(PG8_SB(1, 0), b3, voffB);
            PG8_BAR; PG8_WAIT_L(0); PG8_MMA(0, 1, At, B1); PG8_BAR;
            PG8_LDA(At, 1, 1); PG8_STAGE(PG8_SA(1, 0), a3, voffA);
            PG8_BAR; PG8_WAIT_L(0); PG8_MMA(1, 0, At, B0); PG8_BAR; PG8_SCHED;
            PG8_STAGE(PG8_SB(1, 1), b3 + hstep, voffB);
            PG8_WAIT_V(6); PG8_BAR; PG8_MMA(1, 1, At, B1); PG8_BAR;
            }
        }
        if constexpr (ALIGN_EPI) { if (wr == 0) PG8_BAR; }
        if constexpr (!Epi::AFTER_DRAIN) { E(acc, cur, wr, wc, fr, fq); S.done(cur); }
        if (!has_next) break;
#pragma unroll
        for (int a = 0; a < 2; ++a)
#pragma unroll
            for (int b = 0; b < 2; ++b)
#pragma unroll
                for (int m = 0; m < 4; ++m)
#pragma unroll
                    for (int n = 0; n < 2; ++n) acc[a][b][m][n] = (f32x4){0.f, 0.f, 0.f, 0.f};
        cur = nxt; cA = nA; cB = nB; ++ui;
        if constexpr (ALIGN_EPI) { if (wr == 1) PG8_BAR; }
    }
    PG8_WAIT_V(0);
    if constexpr (!ALIGN_EPI) { if (wr == 0) PG8_BAR; }
    PG8_BAR;
    if constexpr (Epi::AFTER_DRAIN) { E.fused(acc, cur, wr, wc, fr, fq, lds, wid, lane); S.done(cur); }
#undef PG8_SA
#undef PG8_SB
#undef PG8_STAGE
#undef PG8_LDA
#undef PG8_LDB
#undef PG8_MMA
#undef PG8_WAIT_V
#undef PG8_WAIT_L
#undef PG8_BAR
#undef PG8_SCHED
}
}
#define GAS __attribute__((address_space(1)))
#define XB_TMO      128
#define XB_XCNT(j)  (256  + 64 * (j))
#define XB_XSUB(j)  (1280 + 64 * (j))
#define XB_XGEN(j)  (2304 + 64 * (j))
#define XB_TOP      3328
#define XB_TOPGEN   3392
#define XCD_BAR_WORDS 3456
#define XB_SPIN_CAP (1u << 18)

__device__ __forceinline__ unsigned xb_ld(unsigned* p)              { return __hip_atomic_load(p, __ATOMIC_RELAXED, __HIP_MEMORY_SCOPE_AGENT); }
__device__ __forceinline__ unsigned xb_add(unsigned* p, unsigned v) { return __hip_atomic_fetch_add(p, v, __ATOMIC_RELAXED, __HIP_MEMORY_SCOPE_AGENT); }
__device__ __forceinline__ unsigned xb_xcc_id() { return (unsigned)__builtin_amdgcn_s_getreg((3 << 11) | 20) & 0xFu; }
#define XB_SPIN(cond, bar) do { unsigned _sp = 0; while (cond) { __builtin_amdgcn_s_sleep(1); \
    if ((++_sp & 255u) == 0u) { if (xb_ld(&(bar)[XB_TMO])) break; if (_sp > XB_SPIN_CAP) { atomicAdd(&(bar)[XB_TMO], 1u); break; } } } } while (0)

struct XcdBarrier {
    unsigned* bar; unsigned x;
    volatile LAS unsigned* st;
};

__device__ __forceinline__ XcdBarrier xcd_barrier_post(unsigned* bar, volatile LAS unsigned* st) {
    XcdBarrier b; b.bar = bar; b.x = xb_xcc_id(); b.st = st;
    if (threadIdx.x == 0) (void)xb_add(&bar[XB_XCNT(b.x)], 1u);
    return b;
}
__device__ __forceinline__ void xcd_barrier_complete(unsigned* bar, unsigned x, unsigned& nloc, unsigned& nx) {
    const unsigned G = gridDim.x * gridDim.y * gridDim.z;
    unsigned sum, cnt, mine, sp = 0u;
    for (;;) {
        sum = 0u; cnt = 0u; mine = 0u;
#pragma unroll
        for (unsigned j = 0; j < 16; ++j) { const unsigned c = xb_ld(&bar[XB_XCNT(j)]); sum += c; cnt += (c > 0u) ? 1u : 0u; mine = (j == x) ? c : mine; }
        if (sum == G) break;
        __builtin_amdgcn_s_sleep(1);
        if ((++sp & 255u) == 0u) { if (xb_ld(&bar[XB_TMO])) break; if (sp > XB_SPIN_CAP) { atomicAdd(&bar[XB_TMO], 1u); break; } }
    }
    nloc = mine > 0u ? mine : 1u; nx = cnt > 0u ? cnt : 1u;
}

__device__ __forceinline__ void xcd_barrier(const XcdBarrier& b) {
    asm volatile("s_waitcnt vmcnt(0)" ::: "memory");
    __syncthreads();
    if (threadIdx.x == 0) {
        unsigned* bar = b.bar;
        __builtin_amdgcn_s_waitcnt(0);
        unsigned nloc = b.st[0], nx = b.st[1];
        if (nloc == 0u) { xcd_barrier_complete(bar, b.x, nloc, nx); b.st[0] = nloc; b.st[1] = nx; }
        const unsigned old = xb_add(&bar[XB_XSUB(b.x)], 1u);
        const unsigned gen = old / nloc;
        if (old + 1u == (gen + 1u) * nloc) {
            __builtin_amdgcn_fence(__ATOMIC_RELEASE, "agent");
            asm volatile("s_waitcnt vmcnt(0)" ::: "memory");
            const unsigned og = xb_add(&bar[XB_TOP], 1u);
            const unsigned tg = og / nx;
            if (og + 1u == (tg + 1u) * nx) xb_add(&bar[XB_TOPGEN], 1u);
            else XB_SPIN(xb_ld(&bar[XB_TOPGEN]) == tg, bar);
            __builtin_amdgcn_fence(__ATOMIC_ACQUIRE, "agent");
            xb_add(&bar[XB_XGEN(b.x)], 1u);
            asm volatile("s_waitcnt vmcnt(0)" ::: "memory");
        } else {
            XB_SPIN(xb_ld(&bar[XB_XGEN(b.x)]) == gen, bar);
            __builtin_amdgcn_fence(__ATOMIC_ACQUIRE, "agent");
            asm volatile("s_waitcnt vmcnt(0)" ::: "memory");
        }
    }
    __syncthreads();
}

using pg8::bf16_t; using pg8::bf16x8; using pg8::f32x4; using pg8::Unit;
typedef float f32x16 __attribute__((ext_vector_type(16)));
typedef float f32x2_t __attribute__((ext_vector_type(2)));
typedef __bf16 bf16x2_t __attribute__((ext_vector_type(2)));
typedef unsigned u32x2 __attribute__((ext_vector_type(2)));
typedef unsigned u32x4 __attribute__((ext_vector_type(4)));

constexpr int DM = 1024, NBATCH = 8, SEQ = 2048, NMETA = 16, TPOS = 2064, DECB = 128, PASTLEN = 8192, PAGESZ = 128, NPAGES = 64;
constexpr int NHEAD = 8, QLORA = 384, KVLORA = 256, KVW = 288;
constexpr int RWW = 512, RWCOLS = 1792, INCOLS = 4512, INPAD = 4608, DFF = 4096;
constexpr int MMAIN = 16384, ROW_META = 16384, ROW_SAMP = 16400, ROW_PAD = 16528, MROWS = 16640;
constexpr int KPITCH = 2112;
constexpr int ROPE_SAMP = 2064;
constexpr float NORM_EPS = 1e-6f, GN_EPS = 64e-5f;
constexpr float QSCALE = 0.10206207261596577f * 1.4426950408889634f;
constexpr int NTHREADS = 512, NWAVES = 8;
constexpr int LDS_RING = 131072, LDS_DECQ = 0  , LDS_DECT = 41472  , LDS_MISC = 162048, LDS_BYTES = LDS_MISC + 1024;

constexpr size_t al256(size_t x) { return (x + 255) & ~(size_t)255; }
constexpr size_t WS_CTL   = 0;
constexpr size_t WS_SSQ1  = 65536;
constexpr size_t WS_SSQ2  = WS_SSQ1 + al256((size_t)MROWS * 4);
constexpr size_t WS_ZERO_END = WS_SSQ2 + al256((size_t)MROWS * 4);
constexpr size_t WS_WIN   = al256(WS_ZERO_END);
constexpr size_t WS_WUQ   = WS_WIN   + (size_t)INPAD * DM * 2;
constexpr size_t WS_WQABS = WS_WUQ   + (size_t)768 * 384 * 2;
constexpr size_t WS_WKV   = WS_WQABS + (size_t)2048 * 384 * 2;
constexpr size_t WS_WLORA = WS_WKV   + (size_t)1024 * 256 * 2;
constexpr size_t WS_WOM   = WS_WLORA + (size_t)1536 * 256 * 2;
constexpr size_t WS_WOR   = WS_WOM   + (size_t)1024 * 512 * 2;
constexpr size_t WS_WOUT  = WS_WOR   + (size_t)1024 * 512 * 2;
constexpr size_t WS_WUP   = WS_WOUT  + (size_t)1024 * 1024 * 2;
constexpr size_t WS_WDN   = WS_WUP   + (size_t)4096 * 1024 * 2;
constexpr size_t WS_ROPE  = WS_WDN   + (size_t)1024 * 4096 * 2;
constexpr size_t WS_XB    = al256(WS_ROPE + (size_t)2065 * 32 * 4);
constexpr size_t WS_ZS    = WS_XB    + (size_t)MROWS * 1024 * 2;
constexpr size_t WS_RW    = WS_ZS    + (size_t)MROWS * 768 * 4;
constexpr size_t WS_GATE  = WS_RW    + (size_t)MROWS * 1792 * 4;
constexpr size_t WS_QN    = WS_GATE  + (size_t)MROWS * 2048 * 2;
constexpr size_t WS_CKV   = WS_QN    + (size_t)MROWS * 384 * 2;
constexpr size_t WS_LIN   = WS_CKV   + (size_t)MROWS * 256 * 2;
constexpr size_t WS_ZK    = WS_LIN   + (size_t)MROWS * 256 * 2;
constexpr size_t SCN_TOTAL = (size_t)64 * TPOS * 384;
constexpr size_t SCN_BSTRIDE = (size_t)8 * TPOS * 384;
constexpr size_t WS_SCN   = WS_ZK    + (size_t)MROWS * 512 * 4;
constexpr size_t WS_B2    = WS_SCN   + (SCN_TOTAL + (size_t)1024 * 384) * 4;
constexpr size_t WS_Y     = WS_B2;
constexpr size_t WS_GB    = WS_Y     + (size_t)MROWS * 512 * 4;
constexpr size_t WS_KN    = WS_GB    + (size_t)MROWS * 512 * 2;
constexpr size_t WS_KR    = WS_KN    + (size_t)NBATCH * KPITCH * 512 * 2;
constexpr size_t WS_VT    = WS_KR    + (size_t)NBATCH * KPITCH * 32 * 2;
constexpr size_t WS_Q     = WS_VT    + (size_t)NBATCH * 512 * KPITCH * 2;
constexpr size_t WS_QF    = WS_Q     + (size_t)MROWS * 768 * 2;
constexpr size_t WS_PART  = al256(WS_QF + (size_t)DECB * 8 * 288 * 2);
constexpr size_t WS_O     = al256(WS_PART + (size_t)2048 * 8 * 260 * 4);
constexpr size_t WS_ORW   = WS_O     + (size_t)MROWS * 512 * 2;
constexpr size_t WS_MRG   = WS_ORW   + (size_t)MROWS * 512 * 2;
constexpr size_t WS_X1    = WS_MRG   + (size_t)MROWS * 1024 * 2;
constexpr size_t WS_X1B   = WS_X1    + (size_t)MROWS * 1024 * 4;
constexpr size_t WS_ACT   = WS_X1B   + (size_t)MROWS * 1024 * 2;
constexpr size_t WS_X2    = WS_ACT   + (size_t)MROWS * 4096 * 2;
constexpr size_t WS_CH    = WS_X2    + (size_t)MROWS * 1024 * 4;
constexpr int    CH_BYTES = 14336, CH_AR = 0, CH_MAK = 4096, CH_TT = 5120, CH_MBR = 6144, CH_BK = 7168, CH_GAM = 11264, CH_V = 11520;
constexpr size_t WS_WUVO  = WS_CH    + (size_t)64 * 129 * CH_BYTES;
constexpr size_t WS_OLAT  = WS_WUVO  + (size_t)1024 * 2048 * 2;
constexpr size_t WS_END   = WS_OLAT  + (size_t)128 * 2048 * 2;

constexpr size_t OUT_YP  = 0;
constexpr size_t OUT_YS  = OUT_YP  + (size_t)NBATCH * SEQ * DM;
constexpr size_t OUT_KVP = OUT_YS  + (size_t)DECB * DM;
constexpr size_t OUT_WKVP= OUT_KVP + (size_t)NBATCH * TPOS * KVW;
constexpr size_t OUT_SHP = OUT_WKVP+ (size_t)NBATCH * 8 * 64 * 64;
constexpr size_t OUT_KVS = OUT_SHP + (size_t)NBATCH * RWCOLS;
constexpr size_t OUT_WKVS= OUT_KVS + (size_t)DECB * KVW;
constexpr size_t OUT_SHS = OUT_WKVS+ (size_t)DECB * 8 * 64 * 64;
constexpr size_t OUT_END = OUT_SHS + (size_t)DECB * RWCOLS;

enum { I_XP = 0, I_XS, I_CACHE, I_PT, I_SWKV, I_SSHIFT, I_META, I_GFINAL, I_GMIX, I_WIN, I_GQ, I_WUQ, I_GKV, I_WUK, I_WUV, I_WOM, I_MU, I_W0, I_W2, I_A0, I_A2, I_G2,
       I_KK, I_KA, I_RK, I_LNW, I_LNB, I_WOR, I_WOUT, I_GFFN, I_WUP, I_WDN, N_IN };

struct Args { const void* in[N_IN]; float* out; unsigned char* ws; int ph_lo, ph_hi; };
#define INF(i) ((const float*)A.in[i])
#define WSP(T, off) ((T*)(A.ws + (off)))

__device__ __forceinline__ unsigned pk_bf16(float lo, float hi) { f32x2_t v = {lo, hi}; bf16x2_t b = __builtin_convertvector(v, bf16x2_t); return __builtin_bit_cast(unsigned, b); }
__device__ __forceinline__ bf16_t f2bf(float f) { return (bf16_t)(pk_bf16(f, 0.f) & 0xffffu); }
__device__ __forceinline__ float bf2f(bf16_t b) { return __uint_as_float((unsigned)b << 16); }
__device__ __forceinline__ u32x2 pk4(f32x4 v) { u32x2 r; r.x = pk_bf16(v[0], v[1]); r.y = pk_bf16(v[2], v[3]); return r; }
__device__ __forceinline__ float sigmoidf_(float x) { return __builtin_amdgcn_rcpf(1.0f + __expf(-x)); }
__device__ __forceinline__ float wave_sum(float v) {
#pragma unroll
    for (int o = 1; o < 64; o <<= 1) v += __shfl_xor(v, o);
    return v;
}
__device__ __forceinline__ float dpp_f(float x, const int ctrl_sel) {
    int xi = __builtin_bit_cast(int, x), r;
    if (ctrl_sel == 0) r = __builtin_amdgcn_update_dpp(0, xi, 0xB1, 0xF, 0xF, true);
    else if (ctrl_sel == 1) r = __builtin_amdgcn_update_dpp(0, xi, 0x4E, 0xF, 0xF, true);
    else if (ctrl_sel == 2) r = __builtin_amdgcn_update_dpp(0, xi, 0x141, 0xF, 0xF, true);
    else r = __builtin_amdgcn_update_dpp(0, xi, 0x140, 0xF, 0xF, true);
    return __builtin_bit_cast(float, r);
}
__device__ __forceinline__ float row16_sum(float x) { x += dpp_f(x, 0); x += dpp_f(x, 1); x += dpp_f(x, 2); x += dpp_f(x, 3); return x; }

struct XSrc { const float* xp; const float* meta; const float* xs; };
__device__ __forceinline__ const float* xrow_ptr(const XSrc& X, int row) {
    if (row < MMAIN) return X.xp + (size_t)row * DM;
    if (row < ROW_SAMP) return X.meta + (size_t)(row - ROW_META) * DM;
    if (row < ROW_PAD) return X.xs + (size_t)(row - ROW_SAMP) * DM;
    return nullptr;
}
__device__ __forceinline__ int rope_idx(int row) {
    if (row < MMAIN) return NMETA + (row & (SEQ - 1));
    if (row < ROW_SAMP) return row - ROW_META;
    if (row < ROW_PAD) return ROPE_SAMP;
    return 0;
}

__device__ __forceinline__ size_t scn_base(int row, int h, int& ncopies) {
    if (row < MMAIN) { ncopies = 1; return ((size_t)((row >> 11) * 8 + h) * TPOS + NMETA + (row & (SEQ - 1))) * 384; }
    if (row < ROW_SAMP) { ncopies = 1; return ((size_t)h * TPOS + (row - ROW_META)) * 384; }
    if (row < ROW_PAD) { ncopies = 1; return SCN_TOTAL + (size_t)((row - ROW_SAMP) * 8 + h) * 384; }
    ncopies = 0; return 0;
}

__device__ __forceinline__ int win_cmap(int n) {
    if (n < 256) return 384 + n;
    if (n < 640) return n - 256;
    if (n < 672) return n;
    if (n < 768) return -1;
    return n - 96;
}
struct TJob { const float* src; int ldsrc; const float* kscale; bf16_t* dst; int ldd; int N, K; int mode; };
__device__ __forceinline__ void transpose_tile(const TJob& J, int tile, LAS float* scr) {
    const int ntk = J.K >> 6, tn = tile / ntk, tk = tile - tn * ntk, tid = threadIdx.x;
    {
        const int n_l = tid & 63, k0 = tid >> 6, n = tn * 64 + n_l, c = J.mode ? win_cmap(n) : n;
#pragma unroll
        for (int i = 0; i < 8; ++i) {
            const int k_l = k0 + 8 * i, k = tk * 64 + k_l;
            float v = 0.f;
            if (c >= 0) { v = J.src[(size_t)k * J.ldsrc + c]; if (J.kscale) v *= J.kscale[k]; }
            scr[k_l * 65 + n_l] = v;
        }
    }
    __syncthreads();
    {
        const int k_l = tid & 63, n0 = tid >> 6;
#pragma unroll
        for (int i = 0; i < 8; ++i) {
            const int n_l = n0 + 8 * i;
            J.dst[(size_t)(tn * 64 + n_l) * J.ldd + tk * 64 + k_l] = f2bf(scr[k_l * 65 + n_l]);
        }
    }
    __syncthreads();
}
constexpr int NJOBS = 12;
__device__ __forceinline__ TJob get_job(const Args& A, int j) {
    TJob J; J.kscale = nullptr; J.mode = 0;
    switch (j) {
    case 0:  J.src = INF(I_WIN);  J.ldsrc = INCOLS; J.kscale = INF(I_GMIX); J.dst = WSP(bf16_t, WS_WIN); J.ldd = 1024; J.N = INPAD; J.K = 1024; J.mode = 1; break;
    case 1:  J.src = INF(I_WUQ);  J.ldsrc = 768;  J.kscale = INF(I_GQ); J.dst = WSP(bf16_t, WS_WUQ); J.ldd = 384; J.N = 768; J.K = 384; break;
    case 2:  J.src = INF(I_WUK);  J.ldsrc = 512;  J.dst = WSP(bf16_t, WS_WKV); J.ldd = 256; J.N = 512; J.K = 256; break;
    case 3:  J.src = INF(I_WUV);  J.ldsrc = 512;  J.dst = WSP(bf16_t, WS_WKV) + (size_t)512 * 256; J.ldd = 256; J.N = 512; J.K = 256; break;
    case 4:  J.src = INF(I_W2);   J.ldsrc = 512;  J.dst = WSP(bf16_t, WS_WLORA); J.ldd = 256; J.N = 512; J.K = 64; break;
    case 5:  J.src = INF(I_A2);   J.ldsrc = 512;  J.dst = WSP(bf16_t, WS_WLORA) + (size_t)512 * 256 + 64; J.ldd = 256; J.N = 512; J.K = 64; break;
    case 6:  J.src = INF(I_G2);   J.ldsrc = 512;  J.dst = WSP(bf16_t, WS_WLORA) + (size_t)1024 * 256 + 128; J.ldd = 256; J.N = 512; J.K = 128; break;
    case 7:  J.src = INF(I_WOM);  J.ldsrc = 1024; J.dst = WSP(bf16_t, WS_WOM); J.ldd = 512; J.N = 1024; J.K = 512; break;
    case 8:  J.src = INF(I_WOR);  J.ldsrc = 1024; J.dst = WSP(bf16_t, WS_WOR); J.ldd = 512; J.N = 1024; J.K = 512; break;
    case 9:  J.src = INF(I_WOUT); J.ldsrc = 1024; J.dst = WSP(bf16_t, WS_WOUT); J.ldd = 1024; J.N = 1024; J.K = 1024; break;
    case 10: J.src = INF(I_WUP);  J.ldsrc = 4096; J.kscale = INF(I_GFFN); J.dst = WSP(bf16_t, WS_WUP); J.ldd = 1024; J.N = 4096; J.K = 1024; break;
    default: J.src = INF(I_WDN);  J.ldsrc = 1024; J.dst = WSP(bf16_t, WS_WDN); J.ldd = 4096; J.N = 1024; J.K = 4096; break;
    }
    return J;
}
__device__ __forceinline__ void p0_weights(const Args& A, int gtid, int gthreads, int j_lo, int j_hi, bool rest) {
#pragma unroll 1
    for (int j = j_lo; j < j_hi; ++j) {
        const TJob J = get_job(A, j);
        const int items = J.N * (J.K >> 3);
#pragma unroll 2
        for (int i = gtid; i < items; i += gthreads) {
            const int kb = i / J.N, n = i - kb * J.N, k0 = kb * 8, c = J.mode ? win_cmap(n) : n;
            float v[8];
#pragma unroll
            for (int e = 0; e < 8; ++e) v[e] = (c >= 0) ? J.src[(size_t)(k0 + e) * J.ldsrc + c] : 0.f;
            if (J.kscale) {
#pragma unroll
                for (int e = 0; e < 8; ++e) v[e] *= J.kscale[k0 + e];
            }
            *(u32x4*)(J.dst + (size_t)n * J.ldd + k0) = (u32x4){pk_bf16(v[0], v[1]), pk_bf16(v[2], v[3]), pk_bf16(v[4], v[5]), pk_bf16(v[6], v[7])};
        }
    }
    if (!rest) return;
    for (int i = gtid; i < 1536 * 256; i += gthreads) {
        const int n = i >> 8, k = i & 255, blk = n >> 9;
        const bool nz = (blk == 0) ? (k < 64) : (blk == 1) ? (k >= 64 && k < 128) : (k >= 128);
        if (!nz) WSP(bf16_t, WS_WLORA)[i] = 0;
    }
    for (int i = gtid; i < 2048 * 384; i += gthreads) {
        const int k = i % 384, n = i / 384, h = n >> 8, c = n & 255;
        const float* a = INF(I_WUQ) + (size_t)k * 768 + h * 96;
        const float* b = INF(I_WUK) + (size_t)c * 512 + h * 64;
        float s = 0.f;
#pragma unroll
        for (int q = 0; q < 16; ++q) { const f32x4 av = *(const f32x4*)(a + 4 * q), bv = *(const f32x4*)(b + 4 * q); s += av[0] * bv[0] + av[1] * bv[1] + av[2] * bv[2] + av[3] * bv[3]; }
        WSP(bf16_t, WS_WQABS)[i] = f2bf(s * INF(I_GQ)[k]);
    }
}
constexpr int P1_TAIL_CU0 = 146;
__device__ __forceinline__ void p0_prologue(const Args& A, LAS unsigned char* lds) {
    const int tid = threadIdx.x, lane = tid & 63, wid = tid >> 6, G = gridDim.x;
    const int gtid = blockIdx.x * NTHREADS + tid, gthreads = G * NTHREADS;
    p0_weights(A, gtid, gthreads, 0, 10, true);
    for (int i = gtid; i < 2065 * 16; i += gthreads) {
        const int idx = i >> 4, f = i & 15;
        const double pos = (idx == ROPE_SAMP) ? (double)PASTLEN : (double)idx;
        const double ang = pos * pow(10000.0, -(double)f / 16.0);
        WSP(float, WS_ROPE)[idx * 32 + f] = (float)cos(ang);
        WSP(float, WS_ROPE)[idx * 32 + 16 + f] = (float)sin(ang);
    }
    for (int row = blockIdx.x * NWAVES + wid; row < MROWS; row += G * NWAVES) {
        const XSrc XS{INF(I_XP), INF(I_META), INF(I_XS)};
        const float* xr = xrow_ptr(XS, row);
        bf16_t* o = WSP(bf16_t, WS_XB) + (size_t)row * DM;
        f32x4 v[4]; float ss = 0.f;
#pragma unroll
        for (int i = 0; i < 4; ++i) { v[i] = xr ? *(const f32x4*)(xr + i * 256 + lane * 4) : (f32x4){0.f, 0.f, 0.f, 0.f}; ss += v[i][0] * v[i][0] + v[i][1] * v[i][1] + v[i][2] * v[i][2] + v[i][3] * v[i][3]; }
        ss = wave_sum(ss);
        const float rs = rsqrtf(ss * (1.0f / DM) + NORM_EPS);
#pragma unroll
        for (int i = 0; i < 4; ++i) *(u32x2*)(o + i * 256 + lane * 4) = pk4(v[i] * rs);
    }
}

#define EPI_ROWS_BEGIN _Pragma("unroll") for (int ai = 0; ai < 2; ++ai) _Pragma("unroll") for (int m = 0; m < 4; ++m) { const int row = u.pm * 256 + ai * 128 + wr * 64 + m * 16 + fr;
#define EPI_COLS_BEGIN _Pragma("unroll") for (int bj = 0; bj < 2; ++bj) _Pragma("unroll") for (int n = 0; n < 2; ++n) { const int col = u.pn * 256 + bj * 128 + wc * 32 + n * 16 + fq * 4; const f32x4 v = acc[ai][bj][m][n];
#define EPI_END }

struct EpiG1 {
    static constexpr bool PERM = false, AFTER_DRAIN = false;
    float* zs; float* rw; bf16_t* gate;
    __device__ __forceinline__ void operator()(const f32x4 (&acc)[2][2][4][2], const Unit& u, int wr, int wc, int fr, int fq) const {
        EPI_ROWS_BEGIN
            EPI_COLS_BEGIN
                if (u.pn < 3) *(f32x4*)(zs + (size_t)row * 768 + col) = v;
                else if (u.pn < 10) *(f32x4*)(rw + (size_t)row * RWCOLS + (col - 768)) = v;
                else { f32x4 s; s[0] = sigmoidf_(v[0]); s[1] = sigmoidf_(v[1]); s[2] = sigmoidf_(v[2]); s[3] = sigmoidf_(v[3]); *(u32x2*)(gate + (size_t)row * 2048 + (col - 2560)) = pk4(s); }
            EPI_END
        EPI_END
    }
};
struct EpiKV {
    static constexpr bool PERM = false, AFTER_DRAIN = false;
    bf16_t* kn; bf16_t* vt;
    __device__ __forceinline__ void operator()(const f32x4 (&acc)[2][2][4][2], const Unit& u, int wr, int wc, int fr, int fq) const {
        EPI_ROWS_BEGIN
            const bool live = row < ROW_SAMP;
            const int b = (row < MMAIN) ? (row >> 11) : 0, pos = (row < MMAIN) ? NMETA + (row & (SEQ - 1)) : (row - ROW_META) & 15;
            const int pp = (pos & ~12) | ((pos & 4) << 1) | ((pos & 8) >> 1);
            EPI_COLS_BEGIN
                if (live) {
                    if (u.pn < 2) *(u32x2*)(kn + ((size_t)b * KPITCH + pos) * 512 + col) = pk4(v);
                    else { bf16_t* p = vt + ((size_t)b * 512 + (col - 512)) * KPITCH + pp; p[0] = f2bf(v[0]); p[KPITCH] = f2bf(v[1]); p[2 * KPITCH] = f2bf(v[2]); p[3 * KPITCH] = f2bf(v[3]); }
                }
            EPI_END
        EPI_END
    }
};
struct EpiLora {
    static constexpr bool PERM = false, AFTER_DRAIN = false;
    const float* w0; const float* a0; float* scn; bf16_t* gb;
    __device__ __forceinline__ void operator()(const f32x4 (&acc)[2][2][4][2], const Unit& u, int wr, int wc, int fr, int fq) const {
        EPI_ROWS_BEGIN
            EPI_COLS_BEGIN
                if (u.pn < 4) {
                    const int c = col & 511;
                    int nc; const size_t sb = scn_base(row, c >> 6, nc) + (u.pn < 2 ? 64 : 256) + (c & 63);
                    if (nc) *(f32x4*)(scn + sb) = v + *(const f32x4*)((u.pn < 2 ? w0 : a0) + c);
                } else {
                    *(u32x2*)(gb + (size_t)row * 512 + (col - 1024)) = pk4(v);
                }
            EPI_END
        EPI_END
    }
};
struct EpiQ {
    static constexpr bool PERM = false, AFTER_DRAIN = false;
    bf16_t* q; bf16_t* qf; const float* rope;
    __device__ __forceinline__ void operator()(const f32x4 (&acc)[2][2][4][2], const Unit& u, int wr, int wc, int fr, int fq) const {
        EPI_ROWS_BEGIN
            const int ri = rope_idx(row);
#pragma unroll
            for (int bj = 0; bj < 2; ++bj) {
                const int cb = u.pn * 256 + bj * 128 + wc * 32;
                const int g32 = cb >> 5, h = g32 / 3, part = g32 - 3 * h;
                f32x4 v0 = acc[ai][bj][m][0] * QSCALE, v1 = acc[ai][bj][m][1] * QSCALE;
                if (part == 2) {
                    const f32x4 cs = *(const f32x4*)(rope + ri * 32 + fq * 4), sn = *(const f32x4*)(rope + ri * 32 + 16 + fq * 4);
                    const f32x4 o0 = v0 * cs - v1 * sn, o1 = v0 * sn + v1 * cs; v0 = o0; v1 = o1;
                    if (row >= ROW_SAMP && row < ROW_PAD) { bf16_t* p = qf + ((size_t)(row - ROW_SAMP) * 8 + h) * 288 + 256 + fq * 4; *(u32x2*)p = pk4(v0); *(u32x2*)(p + 16) = pk4(v1); }
                }
                bf16_t* p = q + (size_t)row * 768 + cb + fq * 4;
                *(u32x2*)p = pk4(v0); *(u32x2*)(p + 16) = pk4(v1);
            }
        EPI_END
    }
};
struct EpiQabs {
    static constexpr bool PERM = false, AFTER_DRAIN = false;
    bf16_t* qf;
    __device__ __forceinline__ void operator()(const f32x4 (&acc)[2][2][4][2], const Unit& u, int wr, int wc, int fr, int fq) const {
        EPI_ROWS_BEGIN
            const int sb = row - (ROW_SAMP - ROW_META);
            EPI_COLS_BEGIN
                if (sb >= 0 && sb < DECB) { const int h = col >> 8, c = col & 255; *(u32x2*)(qf + ((size_t)sb * 8 + h) * 288 + c) = pk4(v * QSCALE); }
            EPI_END
        EPI_END
    }
};
struct EpiG4 {
    static constexpr bool PERM = false, AFTER_DRAIN = false;
    const bf16_t* gate; bf16_t* mrg;
    __device__ __forceinline__ void operator()(const f32x4 (&acc)[2][2][4][2], const Unit& u, int wr, int wc, int fr, int fq) const {
        EPI_ROWS_BEGIN
            EPI_COLS_BEGIN
                const u32x2 g = *(const u32x2*)(gate + (size_t)row * 2048 + col);
                f32x4 o; o[0] = v[0] * __uint_as_float(g.x << 16); o[1] = v[1] * __uint_as_float(g.x & 0xffff0000u); o[2] = v[2] * __uint_as_float(g.y << 16); o[3] = v[3] * __uint_as_float(g.y & 0xffff0000u);
                *(u32x2*)(mrg + (size_t)row * 1024 + col) = pk4(o);
            EPI_END
        EPI_END
    }
};
struct EpiG5 {
    static constexpr bool PERM = false, AFTER_DRAIN = false;
    const bf16_t* gate; bf16_t* mrg;
    __device__ __forceinline__ void operator()(const f32x4 (&acc)[2][2][4][2], const Unit& u, int wr, int wc, int fr, int fq) const {
        EPI_ROWS_BEGIN
            EPI_COLS_BEGIN
                const u32x2 g = *(const u32x2*)(gate + (size_t)row * 2048 + 1024 + col);
                const u32x2 t = *(const u32x2*)(mrg + (size_t)row * 1024 + col);
                f32x4 o; o[0] = __uint_as_float(t.x << 16) + v[0] * __uint_as_float(g.x << 16); o[1] = __uint_as_float(t.x & 0xffff0000u) + v[1] * __uint_as_float(g.x & 0xffff0000u);
                o[2] = __uint_as_float(t.y << 16) + v[2] * __uint_as_float(g.y << 16); o[3] = __uint_as_float(t.y & 0xffff0000u) + v[3] * __uint_as_float(g.y & 0xffff0000u);
                *(u32x2*)(mrg + (size_t)row * 1024 + col) = pk4(o);
            EPI_END
        EPI_END
    }
};
struct EpiG6 {
    static constexpr bool PERM = false, AFTER_DRAIN = false;
    XSrc X; float* x1; bf16_t* x1b; float* ssq;
    __device__ __forceinline__ void operator()(const f32x4 (&acc)[2][2][4][2], const Unit& u, int wr, int wc, int fr, int fq) const {
        EPI_ROWS_BEGIN
            const float* xr = xrow_ptr(X, row); float ss = 0.f;
            EPI_COLS_BEGIN
                const f32x4 xv = xr ? *(const f32x4*)(xr + col) : (f32x4){0.f, 0.f, 0.f, 0.f};
                const f32x4 o = xv + v;
                ss += o[0] * o[0] + o[1] * o[1] + o[2] * o[2] + o[3] * o[3];
                *(f32x4*)(x1 + (size_t)row * 1024 + col) = o; *(u32x2*)(x1b + (size_t)row * 1024 + col) = pk4(o);
            EPI_END
            ss += __shfl_xor(ss, 16); ss += __shfl_xor(ss, 32);
            if (fq == 0) atomicAdd(ssq + row, ss);
        EPI_END
    }
};
struct EpiG7 {
    static constexpr bool PERM = false, AFTER_DRAIN = false;
    const float* ssq; bf16_t* act;
    __device__ __forceinline__ void operator()(const f32x4 (&acc)[2][2][4][2], const Unit& u, int wr, int wc, int fr, int fq) const {
        EPI_ROWS_BEGIN
            const float rs = rsqrtf(ssq[row] * (1.0f / DM) + NORM_EPS);
            EPI_COLS_BEGIN
                f32x4 o;
#pragma unroll
                for (int e = 0; e < 4; ++e) { const float t = fmaxf(v[e] * rs, 0.f); o[e] = t * t; }
                *(u32x2*)(act + (size_t)row * DFF + col) = pk4(o);
            EPI_END
        EPI_END
    }
};
struct EpiG8 {
    static constexpr bool PERM = false, AFTER_DRAIN = false;
    const float* x1; float* x2; float* ssq;
    __device__ __forceinline__ void operator()(const f32x4 (&acc)[2][2][4][2], const Unit& u, int wr, int wc, int fr, int fq) const {
        EPI_ROWS_BEGIN
            float ss = 0.f;
            EPI_COLS_BEGIN
                const f32x4 o = *(const f32x4*)(x1 + (size_t)row * 1024 + col) + v;
                ss += o[0] * o[0] + o[1] * o[1] + o[2] * o[2] + o[3] * o[3];
                *(f32x4*)(x2 + (size_t)row * 1024 + col) = o;
            EPI_END
            ss += __shfl_xor(ss, 16); ss += __shfl_xor(ss, 32);
            if (fq == 0) atomicAdd(ssq + row, ss);
        EPI_END
    }
};

__device__ __forceinline__ void p2a_rows(const Args& A) {
    const int tid = threadIdx.x, lane = tid & 63, wid = tid >> 6, G = gridDim.x;
    const float* zs = WSP(float, WS_ZS); const float* rw = WSP(float, WS_RW); const float* rope = WSP(float, WS_ROPE);
    for (int row = blockIdx.x * NWAVES + wid; row < MROWS; row += G * NWAVES) {
        bf16_t* qn = WSP(bf16_t, WS_QN) + (size_t)row * 384; bf16_t* ckv = WSP(bf16_t, WS_CKV) + (size_t)row * 256; bf16_t* lin = WSP(bf16_t, WS_LIN) + (size_t)row * 256;
        if (row >= ROW_PAD) {
            *(u32x2*)(qn + lane * 4) = (u32x2){0u, 0u}; *(unsigned*)(qn + 256 + lane * 2) = 0u; *(u32x2*)(ckv + lane * 4) = (u32x2){0u, 0u}; *(u32x2*)(lin + lane * 4) = (u32x2){0u, 0u};
            continue;
        }
        int kind, b = 0, pos, ri; const float* prev;
        if (row < MMAIN) { kind = 0; b = row >> 11; const int t = row & (SEQ - 1); pos = NMETA + t; ri = pos; prev = rw + (size_t)(t == 0 ? ROW_META + NMETA - 1 : row - 1) * RWCOLS; }
        else if (row < ROW_SAMP) { kind = 1; pos = row - ROW_META; ri = pos; prev = (pos == 0) ? nullptr : rw + (size_t)(row - 1) * RWCOLS; }
        else { kind = 2; b = row - ROW_SAMP; pos = 0; ri = ROPE_SAMP; prev = INF(I_SSHIFT) + (size_t)b * RWCOLS; }
        const float* z = zs + (size_t)row * 768;
        const float* c = rw + (size_t)row * RWCOLS; const float* mu = INF(I_MU);
        const f32x4 kv = *(const f32x4*)(z + lane * 4), q0 = *(const f32x4*)(z + 256 + lane * 4); const f32x2_t q1 = *(const f32x2_t*)(z + 512 + lane * 2);
        const float rx1 = z[640 + (lane & 15)], rx2 = z[656 + (lane & 15)];
        f32x4 cc[7], pp[7];
#pragma unroll
        for (int j = 0; j < 7; ++j) { const int col = 4 * (lane + 64 * j); cc[j] = *(const f32x4*)(c + col); pp[j] = prev ? *(const f32x4*)(prev + col) : (f32x4){0.f, 0.f, 0.f, 0.f}; }
        asm volatile("" ::: "memory");
        {
            const float ss = wave_sum(kv[0] * kv[0] + kv[1] * kv[1] + kv[2] * kv[2] + kv[3] * kv[3]);
            const float rs = rsqrtf(ss * (1.0f / KVLORA) + NORM_EPS);
            const f32x4 cv = kv * rs * *(const f32x4*)(INF(I_GKV) + lane * 4);
            *(u32x2*)(ckv + lane * 4) = pk4(cv);
            if (kind == 0) *(f32x4*)(A.out + OUT_KVP + ((size_t)b * TPOS + pos) * KVW + lane * 4) = cv;
            else if (kind == 1) { for (int bb = 0; bb < NBATCH; ++bb) *(f32x4*)(A.out + OUT_KVP + ((size_t)bb * TPOS + pos) * KVW + lane * 4) = cv; }
            else *(f32x4*)(A.out + OUT_KVS + (size_t)b * KVW + lane * 4) = cv;
        }
        {
            const float ss = wave_sum(q0[0] * q0[0] + q0[1] * q0[1] + q0[2] * q0[2] + q0[3] * q0[3] + q1[0] * q1[0] + q1[1] * q1[1]);
            const float rs = rsqrtf(ss * (1.0f / QLORA) + NORM_EPS);
            *(u32x2*)(qn + lane * 4) = pk4(q0 * rs); *(unsigned*)(qn + 256 + lane * 2) = pk_bf16(q1[0] * rs, q1[1] * rs);
        }
        if (lane < 16) {
            const float cs = rope[ri * 32 + lane], sn = rope[ri * 32 + 16 + lane];
            const float o1 = rx1 * cs - rx2 * sn, o2 = rx1 * sn + rx2 * cs;
            if (kind == 2) { float* o = A.out + OUT_KVS + (size_t)b * KVW + 256; o[lane] = o1; o[16 + lane] = o2; }
            else {
                const int b0 = (kind == 0) ? b : 0, b1 = (kind == 0) ? b + 1 : NBATCH;
                for (int bb = b0; bb < b1; ++bb) {
                    float* o = A.out + OUT_KVP + ((size_t)bb * TPOS + pos) * KVW + 256; o[lane] = o1; o[16 + lane] = o2;
                    bf16_t* kr = WSP(bf16_t, WS_KR) + ((size_t)bb * KPITCH + pos) * 32; kr[lane] = f2bf(o1); kr[16 + lane] = f2bf(o2);
                }
            }
        }
        {
            float* shout = (kind == 0 && (row & (SEQ - 1)) == SEQ - 1) ? A.out + OUT_SHP + (size_t)b * RWCOLS : (kind == 2) ? A.out + OUT_SHS + (size_t)b * RWCOLS : nullptr;
#pragma unroll
            for (int j = 0; j < 7; ++j) {
                const int col = 4 * (lane + 64 * j);
                const f32x4 mm = *(const f32x4*)(mu + col);
                const f32x4 zz = cc[j] + (pp[j] - cc[j]) * mm;
                if (shout) *(f32x4*)(shout + col) = cc[j];
                if (j < 6) {
                    const int cw = col & 511, hd = cw >> 6, wi = cw & 63;
                    int nc; const size_t sbase = scn_base(row, hd, nc) + wi; float* scn = WSP(float, WS_SCN);
                    if (j < 2) *(f32x4*)(scn + sbase) = zz;
                    else if (j < 4) {
                        *(f32x4*)(scn + sbase + 2 * 64) = zz;
                        const f32x4 kk = zz * *(const f32x4*)(INF(I_KK) + cw);
                        const float ss = row16_sum(kk[0] * kk[0] + kk[1] * kk[1] + kk[2] * kk[2] + kk[3] * kk[3]);
                        const float inv = -1.0f / fmaxf(sqrtf(ss), 1e-12f);
                        const f32x4 nk = kk * inv;
                        *(f32x4*)(scn + sbase + 3 * 64) = nk;
                    } else *(f32x4*)(scn + sbase + 5 * 64) = zz;
                }
                else {
                    f32x4 o;
                    if (lane < 16) { for (int e = 0; e < 4; ++e) o[e] = tanhf(zz[e]); }
                    else if (lane < 32) o = zz;
                    else { for (int e = 0; e < 4; ++e) o[e] = sigmoidf_(zz[e]); }
                    *(u32x2*)(lin + lane * 4) = pk4(o);
                }
            }
        }
    }
}

constexpr int AT_KP = 208, AT_VP = 144, AT_KBYTES = 64 * AT_KP, AT_STAGE = AT_KBYTES + 64 * AT_VP;
__device__ __forceinline__ void attn_unit(const Args& A, int b, int h, int qblk, int wid, int lane, LAS unsigned char* lds) {
    const int tid = threadIdx.x, c = lane & 31, hh = lane >> 5;
    const int qrow = b * SEQ + qblk * 256 + wid * 32 + c, qpos = NMETA + qblk * 256 + wid * 32 + c;
    const bf16_t* qp = WSP(bf16_t, WS_Q) + (size_t)qrow * 768 + h * 96 + 8 * hh;
    bf16x8 qf[6];
#pragma unroll
    for (int s = 0; s < 6; ++s) qf[s] = *(const bf16x8*)(qp + 16 * s);
    f32x16 o0, o1;
#pragma unroll
    for (int i = 0; i < 16; ++i) { o0[i] = 0.f; o1[i] = 0.f; }
    float mrun = -1e30f, lrun = 0.f;
    const int nkt = 8 * qblk + wid + 2;
    const int nst = 4 * qblk + 5;
    const int qmin = NMETA + qblk * 256 + wid * 32;
    const bf16_t* gkn = WSP(bf16_t, WS_KN) + ((size_t)b * KPITCH + (tid >> 3)) * 512 + h * 64 + (tid & 7) * 8;
    const bf16_t* gvt = WSP(bf16_t, WS_VT) + ((size_t)(b * 8 + h) * 64 + (tid >> 3)) * KPITCH + (tid & 7) * 8;
    const bf16_t* gkr = WSP(bf16_t, WS_KR) + ((size_t)b * KPITCH + ((tid & 255) >> 2)) * 32 + (tid & 3) * 8;
    const int lkn = (tid >> 3) * AT_KP + (tid & 7) * 16, lvt = AT_KBYTES + (tid >> 3) * AT_VP + (tid & 7) * 16, lkr = ((tid & 255) >> 2) * AT_KP + 128 + (tid & 3) * 16;
    u32x4 rk, rv, rr;
#define AT_GLOAD(st) do { rk = *(const u32x4*)(gkn + (size_t)(st) * (64 * 512)); rv = *(const u32x4*)(gvt + (st) * 64); if (tid < 256) rr = *(const u32x4*)(gkr + (size_t)(st) * (64 * 32)); } while (0)
#define AT_LSTORE(buf) do { LAS unsigned char* _b = lds + (buf) * AT_STAGE; *(LAS u32x4*)(_b + lkn) = rk; *(LAS u32x4*)(_b + lvt) = rv; if (tid < 256) *(LAS u32x4*)(_b + lkr) = rr; } while (0)
    __syncthreads();
    AT_GLOAD(0); AT_LSTORE(0);
    __syncthreads();
    for (int st = 0; st < nst; ++st) {
        const LAS unsigned char* kb = lds + (st & 1) * AT_STAGE;
        if (st + 1 < nst) AT_GLOAD(st + 1);
#pragma unroll
        for (int half = 0; half < 2; ++half) {
            const int kt = 2 * st + half;
            if (kt < nkt) {
                const LAS unsigned char* kp = kb + (32 * half + c) * AT_KP + 16 * hh;
                const LAS unsigned char* vp = kb + AT_KBYTES + c * AT_VP + (32 * half) * 2 + 16 * hh;
                f32x16 sa;
#pragma unroll
                for (int i = 0; i < 16; ++i) sa[i] = 0.f;
#pragma unroll
                for (int s = 0; s < 6; ++s) sa = __builtin_amdgcn_mfma_f32_32x32x16_bf16(*(const LAS bf16x8*)(kp + 32 * s), qf[s], sa, 0, 0, 0);
                if (32 * kt + 31 > qmin) {
#pragma unroll
                    for (int i = 0; i < 16; ++i) { const int key = 32 * kt + (i & 3) + 8 * (i >> 2) + 4 * hh; if (key > qpos) sa[i] = -1e30f; }
                }
                float mx = sa[0];
#pragma unroll
                for (int i = 1; i < 16; ++i) mx = fmaxf(mx, sa[i]);
                mx = fmaxf(mx, __shfl_xor(mx, 32));
                const float mnew = fmaxf(mrun, mx), alpha = __builtin_amdgcn_exp2f(mrun - mnew);
                float ps = 0.f;
#pragma unroll
                for (int i = 0; i < 16; ++i) { sa[i] = __builtin_amdgcn_exp2f(sa[i] - mnew); ps += sa[i]; }
                ps += __shfl_xor(ps, 32);
                lrun = lrun * alpha + ps; mrun = mnew;
                if (__any(alpha != 1.0f)) { o0 *= alpha; o1 *= alpha; }
#pragma unroll
                for (int s = 0; s < 2; ++s) {
                    u32x4 pw; pw[0] = pk_bf16(sa[8 * s], sa[8 * s + 1]); pw[1] = pk_bf16(sa[8 * s + 2], sa[8 * s + 3]); pw[2] = pk_bf16(sa[8 * s + 4], sa[8 * s + 5]); pw[3] = pk_bf16(sa[8 * s + 6], sa[8 * s + 7]);
                    const bf16x8 pf = __builtin_bit_cast(bf16x8, pw);
                    o0 = __builtin_amdgcn_mfma_f32_32x32x16_bf16(*(const LAS bf16x8*)(vp + 32 * s), pf, o0, 0, 0, 0);
                    o1 = __builtin_amdgcn_mfma_f32_32x32x16_bf16(*(const LAS bf16x8*)(vp + 32 * AT_VP + 32 * s), pf, o1, 0, 0, 0);
                }
            }
        }
        if (st + 1 < nst) AT_LSTORE((st + 1) & 1);
        __syncthreads();
    }
#undef AT_GLOAD
#undef AT_LSTORE
    const float inv = 1.0f / lrun;
    bf16_t* op = WSP(bf16_t, WS_O) + (size_t)qrow * 512 + h * 64 + 4 * hh;
#pragma unroll
    for (int g = 0; g < 4; ++g) {
        *(u32x2*)(op + 8 * g) = pk4((f32x4){o0[4 * g] * inv, o0[4 * g + 1] * inv, o0[4 * g + 2] * inv, o0[4 * g + 3] * inv});
        *(u32x2*)(op + 32 + 8 * g) = pk4((f32x4){o1[4 * g] * inv, o1[4 * g + 1] * inv, o1[4 * g + 2] * inv, o1[4 * g + 3] * inv});
    }
}
__device__ __forceinline__ void p3_attention(const Args& A, LAS unsigned char* lds) {
    const int tid = threadIdx.x, lane = tid & 63, wid = tid >> 6;
    for (int p = blockIdx.x; p < 256; p += gridDim.x) {
        const int b = p >> 5, h = (p >> 2) & 7, qq = p & 3;
        attn_unit(A, b, h, 7 - qq, wid, lane, lds);
        attn_unit(A, b, h, qq, wid, lane, lds);
    }
}

__device__ __forceinline__ void bar4(volatile LAS unsigned* cnt, unsigned& epoch, int lane) {
    epoch += 4u;
    asm volatile("s_waitcnt lgkmcnt(0)" ::: "memory");
    if (lane == 0) (void)__hip_atomic_fetch_add((LAS unsigned*)cnt, 1u, __ATOMIC_RELAXED, __HIP_MEMORY_SCOPE_WORKGROUP);
    for (unsigned sp = 0;; ++sp) { const unsigned v = (unsigned)__builtin_amdgcn_readfirstlane((int)*cnt); if ((int)(v - epoch) >= 0 || sp > (1u << 24)) break; __builtin_amdgcn_s_sleep(1); }
    asm volatile("" ::: "memory");
}
__device__ __forceinline__ void attn_unit4(const Args& A, int b, int h, int qblk, int hf, int wid, int lane, LAS unsigned char* lds, volatile LAS unsigned* bcnt, unsigned& epoch) {
    const int tid = wid * 64 + lane, c = lane & 31, hh = lane >> 5;
    const int r0 = qblk * 256 + hf * 128 + wid * 32;
    const int qrow = b * SEQ + r0 + c, qpos = NMETA + r0 + c;
    const bf16_t* qp = WSP(bf16_t, WS_Q) + (size_t)qrow * 768 + h * 96 + 8 * hh;
    bf16x8 qf[6];
#pragma unroll
    for (int s = 0; s < 6; ++s) qf[s] = *(const bf16x8*)(qp + 16 * s);
    f32x16 o0, o1;
#pragma unroll
    for (int i = 0; i < 16; ++i) { o0[i] = 0.f; o1[i] = 0.f; }
    float mrun = -1e30f, lrun = 0.f;
    const int nkt = 8 * qblk + 4 * hf + wid + 2;
    const int nst = 4 * qblk + 2 * hf + 3;
    const int qmin = NMETA + r0;
    const bf16_t* gkn = WSP(bf16_t, WS_KN) + ((size_t)b * KPITCH + (tid >> 3)) * 512 + h * 64 + (tid & 7) * 8;
    const bf16_t* gvt = WSP(bf16_t, WS_VT) + ((size_t)(b * 8 + h) * 64 + (tid >> 3)) * KPITCH + (tid & 7) * 8;
    const bf16_t* gkr = WSP(bf16_t, WS_KR) + ((size_t)b * KPITCH + (tid >> 2)) * 32 + (tid & 3) * 8;
    const int lkn = (tid >> 3) * AT_KP + (tid & 7) * 16, lvt = AT_KBYTES + (tid >> 3) * AT_VP + (tid & 7) * 16, lkr = (tid >> 2) * AT_KP + 128 + (tid & 3) * 16;
    u32x4 rk0, rk1, rv0, rv1, rr;
#define AT_GLOAD(st) do { rk0 = *(const u32x4*)(gkn + (size_t)(st) * (64 * 512)); rk1 = *(const u32x4*)(gkn + (size_t)(st) * (64 * 512) + 32 * 512); \
        rv0 = *(const u32x4*)(gvt + (st) * 64); rv1 = *(const u32x4*)(gvt + (st) * 64 + (size_t)32 * KPITCH); rr = *(const u32x4*)(gkr + (size_t)(st) * (64 * 32)); } while (0)
#define AT_LSTORE(buf) do { LAS unsigned char* _b = lds + (buf) * AT_STAGE; *(LAS u32x4*)(_b + lkn) = rk0; *(LAS u32x4*)(_b + lkn + 32 * AT_KP) = rk1; \
        *(LAS u32x4*)(_b + lvt) = rv0; *(LAS u32x4*)(_b + lvt + 32 * AT_VP) = rv1; *(LAS u32x4*)(_b + lkr) = rr; } while (0)
    bar4(bcnt, epoch, lane);
    AT_GLOAD(0); AT_LSTORE(0);
    bar4(bcnt, epoch, lane);
    for (int st = 0; st < nst; ++st) {
        const LAS unsigned char* kb = lds + (st & 1) * AT_STAGE;
        if (st + 1 < nst) AT_GLOAD(st + 1);
#pragma unroll
        for (int half = 0; half < 2; ++half) {
            const int kt = 2 * st + half;
            if (kt < nkt) {
                const LAS unsigned char* kp = kb + (32 * half + c) * AT_KP + 16 * hh;
                const LAS unsigned char* vp = kb + AT_KBYTES + c * AT_VP + (32 * half) * 2 + 16 * hh;
                f32x16 sa;
#pragma unroll
                for (int i = 0; i < 16; ++i) sa[i] = 0.f;
#pragma unroll
                for (int s = 0; s < 6; ++s) sa = __builtin_amdgcn_mfma_f32_32x32x16_bf16(*(const LAS bf16x8*)(kp + 32 * s), qf[s], sa, 0, 0, 0);
                if (32 * kt + 31 > qmin) {
#pragma unroll
                    for (int i = 0; i < 16; ++i) { const int key = 32 * kt + (i & 3) + 8 * (i >> 2) + 4 * hh; if (key > qpos) sa[i] = -1e30f; }
                }
                float mx = sa[0];
#pragma unroll
                for (int i = 1; i < 16; ++i) mx = fmaxf(mx, sa[i]);
                mx = fmaxf(mx, __shfl_xor(mx, 32));
                const float mnew = fmaxf(mrun, mx), alpha = __builtin_amdgcn_exp2f(mrun - mnew);
                float ps = 0.f;
#pragma unroll
                for (int i = 0; i < 16; ++i) { sa[i] = __builtin_amdgcn_exp2f(sa[i] - mnew); ps += sa[i]; }
                ps += __shfl_xor(ps, 32);
                lrun = lrun * alpha + ps; mrun = mnew;
                if (__any(alpha != 1.0f)) { o0 *= alpha; o1 *= alpha; }
#pragma unroll
                for (int s = 0; s < 2; ++s) {
                    u32x4 pw; pw[0] = pk_bf16(sa[8 * s], sa[8 * s + 1]); pw[1] = pk_bf16(sa[8 * s + 2], sa[8 * s + 3]); pw[2] = pk_bf16(sa[8 * s + 4], sa[8 * s + 5]); pw[3] = pk_bf16(sa[8 * s + 6], sa[8 * s + 7]);
                    const bf16x8 pf = __builtin_bit_cast(bf16x8, pw);
                    o0 = __builtin_amdgcn_mfma_f32_32x32x16_bf16(*(const LAS bf16x8*)(vp + 32 * s), pf, o0, 0, 0, 0);
                    o1 = __builtin_amdgcn_mfma_f32_32x32x16_bf16(*(const LAS bf16x8*)(vp + 32 * AT_VP + 32 * s), pf, o1, 0, 0, 0);
                }
            }
        }
        if (st + 1 < nst) AT_LSTORE((st + 1) & 1);
        bar4(bcnt, epoch, lane);
    }
#undef AT_GLOAD
#undef AT_LSTORE
    const float inv = 1.0f / lrun;
    bf16_t* op = WSP(bf16_t, WS_O) + (size_t)qrow * 512 + h * 64 + 4 * hh;
#pragma unroll
    for (int g = 0; g < 4; ++g) {
        *(u32x2*)(op + 8 * g) = pk4((f32x4){o0[4 * g] * inv, o0[4 * g + 1] * inv, o0[4 * g + 2] * inv, o0[4 * g + 3] * inv});
        *(u32x2*)(op + 32 + 8 * g) = pk4((f32x4){o1[4 * g] * inv, o1[4 * g + 1] * inv, o1[4 * g + 2] * inv, o1[4 * g + 3] * inv});
    }
}

__device__ __forceinline__ void scan_sample_step(const Args& A, int slot, int lane) {
    const int sb = slot >> 3, h = slot & 7, rho = lane >> 4, kq = lane & 15, row = ROW_SAMP + sb;
    const float* rec = WSP(float, WS_SCN) + SCN_TOTAL + (size_t)slot * 384;
    const f32x4 rr = *(const f32x4*)(rec + 4 * kq), wpre = *(const f32x4*)(rec + 64 + 4 * kq), zk = *(const f32x4*)(rec + 128 + 4 * kq),
                aa = *(const f32x4*)(rec + 192 + 4 * kq), apre = *(const f32x4*)(rec + 256 + 4 * kq), ka4 = *(const f32x4*)(INF(I_KA) + h * 64 + 4 * kq);
    f32x4 ww, kk, bb;
#pragma unroll
    for (int e = 0; e < 4; ++e) { const float asg = sigmoidf_(apre[e]); ww[e] = __expf(-0.6065306597126334f * sigmoidf_(wpre[e])); kk[e] = zk[e] * (1.0f + (asg - 1.0f) * ka4[e]); bb[e] = -aa[e] * asg; }
    const float* s0 = INF(I_SWKV) + (size_t)slot * 4096; float* s1 = A.out + OUT_WKVS + (size_t)slot * 4096;
#pragma unroll 4
    for (int i = 0; i < 16; ++i) {
        const int v = 4 * i + rho;
        f32x4 S = *(const f32x4*)(s0 + v * 64 + 4 * kq);
        const float vv = rec[320 + v];
        const float sa = row16_sum(S[0] * aa[0] + S[1] * aa[1] + S[2] * aa[2] + S[3] * aa[3]);
        S = S * ww + sa * bb + vv * kk;
        const float y = row16_sum(S[0] * rr[0] + S[1] * rr[1] + S[2] * rr[2] + S[3] * rr[3]);
        *(f32x4*)(s1 + v * 64 + 4 * kq) = S;
        if (kq == 0) WSP(float, WS_Y)[(size_t)row * 512 + h * 64 + v] = y;
    }
}
__device__ __forceinline__ void x1_task(const Args& A, int bh, int ch, int lane, LAS unsigned char* scr) {
    const int c = lane & 15, q = lane >> 4;
    const float* src = WSP(float, WS_SCN) + ((size_t)(ch == 0 ? (bh & 7) : bh) * TPOS + 16 * ch) * 384;
    const float kach = INF(I_KA)[(bh & 7) * 64 + lane];
    unsigned char* dst = A.ws + WS_CH + ((size_t)bh * 129 + ch) * CH_BYTES;
    constexpr int PIT = 144;
    constexpr int L_BH = 0, L_KH = 2304, L_AT = 4608, L_RT = 6912, L_BT = 9216, L_KT = 11264, L_VV = 13312, L_MAB = 15360;
    {
        float g = 1.f; float bt[16], kt[16], vv[16];
#pragma unroll
        for (int t = 0; t < 16; ++t) {
            const float* p = src + t * 384 + lane;
            const float r = p[0], a = p[192]; vv[t] = p[320];
            const float asg = sigmoidf_(p[256]), w = __expf(-0.6065306597126334f * sigmoidf_(p[64])), k = p[128] * (1.0f + (asg - 1.0f) * kach), b = -a * asg;
            const float gp = g; g *= w; const float ig = 1.0f / g;
            bt[t] = b * ig; kt[t] = k * ig;
            *(LAS bf16_t*)(scr + L_BH + t * PIT + lane * 2) = f2bf(bt[t]); *(LAS bf16_t*)(scr + L_KH + t * PIT + lane * 2) = f2bf(kt[t]);
            *(LAS bf16_t*)(scr + L_AT + t * PIT + lane * 2) = f2bf(a * gp); *(LAS bf16_t*)(scr + L_RT + t * PIT + lane * 2) = f2bf(r * g);
        }
        *(float*)(dst + CH_GAM + lane * 4) = g;
        u32x4 w0, w1;
#pragma unroll
        for (int i = 0; i < 4; ++i) { w0[i] = pk_bf16(bt[2 * i] * g, bt[2 * i + 1] * g); w1[i] = pk_bf16(bt[8 + 2 * i] * g, bt[9 + 2 * i] * g); }
        *(LAS u32x4*)(scr + L_BT + lane * 32) = w0; *(LAS u32x4*)(scr + L_BT + lane * 32 + 16) = w1;
#pragma unroll
        for (int i = 0; i < 4; ++i) { w0[i] = pk_bf16(kt[2 * i] * g, kt[2 * i + 1] * g); w1[i] = pk_bf16(kt[8 + 2 * i] * g, kt[9 + 2 * i] * g); }
        *(LAS u32x4*)(scr + L_KT + lane * 32) = w0; *(LAS u32x4*)(scr + L_KT + lane * 32 + 16) = w1;
#pragma unroll
        for (int i = 0; i < 4; ++i) { w0[i] = pk_bf16(vv[2 * i], vv[2 * i + 1]); w1[i] = pk_bf16(vv[8 + 2 * i], vv[9 + 2 * i]); }
        *(LAS u32x4*)(scr + L_VV + lane * 32) = w0; *(LAS u32x4*)(scr + L_VV + lane * 32 + 16) = w1;
    }
    f32x4 mab = {0.f, 0.f, 0.f, 0.f}, mak = mab, mbr = mab, mkr = mab;
#pragma unroll
    for (int kb = 0; kb < 2; ++kb) {
        const int o = c * PIT + (32 * kb + 8 * q) * 2;
        const bf16x8 fb = *(const LAS bf16x8*)(scr + L_BH + o), fk = *(const LAS bf16x8*)(scr + L_KH + o), fa = *(const LAS bf16x8*)(scr + L_AT + o), fr = *(const LAS bf16x8*)(scr + L_RT + o);
        mab = __builtin_amdgcn_mfma_f32_16x16x32_bf16(fb, fa, mab, 0, 0, 0); mbr = __builtin_amdgcn_mfma_f32_16x16x32_bf16(fb, fr, mbr, 0, 0, 0);
        mak = __builtin_amdgcn_mfma_f32_16x16x32_bf16(fk, fa, mak, 0, 0, 0); mkr = __builtin_amdgcn_mfma_f32_16x16x32_bf16(fk, fr, mkr, 0, 0, 0);
    }
#pragma unroll
    for (int r = 0; r < 4; ++r) { const int s = 4 * q + r;
        if (!(s < c)) { mab[r] = 0.f; mak[r] = 0.f; } if (!(s <= c)) { mbr[r] = 0.f; mkr[r] = 0.f; }
        *(LAS float*)(scr + L_MAB + (s * 16 + c) * 4) = mab[r]; }
    float T[16];
#pragma unroll
    for (int s = 15; s >= 0; --s) {
        f32x4 n[4];
#pragma unroll
        for (int i = 0; i < 4; ++i) n[i] = *(const LAS f32x4*)(scr + L_MAB + s * 64 + i * 16);
        float acc = (s == c) ? 1.f : 0.f;
#pragma unroll
        for (int t = s + 1; t < 16; ++t) acc += n[t >> 2][t & 3] * T[t];
        T[s] = acc;
    }
    {
        f32x4 ts;
#pragma unroll
        for (int j = 0; j < 4; ++j) ts[j] = (q == 0) ? T[j] : (q == 1) ? T[4 + j] : (q == 2) ? T[8 + j] : T[12 + j];
        *(u32x4*)(dst + CH_TT + lane * 16) = (u32x4){pk_bf16(ts[0], ts[1]), pk_bf16(ts[2], ts[3]), 0u, 0u};
        *(u32x4*)(dst + CH_MAK + lane * 16) = (u32x4){0u, 0u, pk_bf16(mak[0], mak[1]), pk_bf16(mak[2], mak[3])};
        *(u32x4*)(dst + CH_MBR + lane * 16) = (u32x4){pk_bf16(mbr[0], mbr[1]), pk_bf16(mbr[2], mbr[3]), pk_bf16(mkr[0], mkr[1]), pk_bf16(mkr[2], mkr[3])};
#pragma unroll
        for (int tile = 0; tile < 2; ++tile)
#pragma unroll
            for (int kb = 0; kb < 2; ++kb) {
                const LAS unsigned char* p = scr + (tile ? L_RT : L_AT) + c * PIT + (32 * kb + 4 * q) * 2;
                const u32x2 lo = *(const LAS u32x2*)p, hi = *(const LAS u32x2*)(p + 32);
                *(u32x4*)(dst + CH_AR + (tile * 2 + kb) * 1024 + lane * 16) = (u32x4){lo.x, lo.y, hi.x, hi.y};
            }
#pragma unroll
        for (int mt = 0; mt < 4; ++mt) {
            const u32x2 lo = *(const LAS u32x2*)(scr + L_BT + (16 * mt + c) * 32 + 8 * q), hi = *(const LAS u32x2*)(scr + L_KT + (16 * mt + c) * 32 + 8 * q);
            *(u32x4*)(dst + CH_BK + mt * 1024 + lane * 16) = (u32x4){lo.x, lo.y, hi.x, hi.y};
            *(u32x2*)(dst + CH_V + mt * 512 + lane * 8) = *(const LAS u32x2*)(scr + L_VV + (16 * mt + c) * 32 + 8 * q);
        }
    }
}
__device__ __forceinline__ void p4_x1(const Args& A, LAS unsigned char* lds) {
    const int tid = threadIdx.x, lane = tid & 63, wid = __builtin_amdgcn_readfirstlane(tid >> 6);
    {
        const int gtid = blockIdx.x * NTHREADS + tid, gthreads = gridDim.x * NTHREADS;
        for (int i = gtid; i < 7 * 16 * 64; i += gthreads) { const int b = 1 + i / 1024, r = i % 1024;
            *(u32x4*)(WSP(bf16_t, WS_KN) + ((size_t)b * KPITCH + (r >> 6)) * 512 + (r & 63) * 8) = *(const u32x4*)(WSP(bf16_t, WS_KN) + ((size_t)(r >> 6)) * 512 + (r & 63) * 8); }
        for (int i = gtid; i < 7 * 512 * 2; i += gthreads) { const int b = 1 + i / 1024, r = i % 1024;
            *(u32x4*)(WSP(bf16_t, WS_VT) + ((size_t)b * 512 + (r >> 1)) * KPITCH + (r & 1) * 8) = *(const u32x4*)(WSP(bf16_t, WS_VT) + ((size_t)(r >> 1)) * KPITCH + (r & 1) * 8); }
    }
    for (int task = blockIdx.x * NWAVES + wid; task < 64 * 129; task += gridDim.x * NWAVES) x1_task(A, task / 129, task % 129, lane, lds + wid * 16384);
}
struct X2Early { u32x4 ar0, ar1, mak, tt; u32x2 v; };
struct X2Late { u32x4 ar2, ar3, mbr, bk[4]; f32x4 gam[4]; };
__device__ __forceinline__ void x2_scan(const Args& A, int bh, int g, int lane) {
    const int c = lane & 15, q = lane >> 4, b = bh >> 3, h = bh & 7, vcol = 16 * g + c;
    const unsigned char* base = A.ws + WS_CH + (size_t)bh * 129 * CH_BYTES;
#define X2_LOADE(O, ch) do { const unsigned char* _p = base + (size_t)(ch) * CH_BYTES; \
        O.ar0 = *(const u32x4*)(_p + CH_AR + lane * 16); O.ar1 = *(const u32x4*)(_p + CH_AR + 1024 + lane * 16); \
        O.mak = *(const u32x4*)(_p + CH_MAK + lane * 16); O.tt = *(const u32x4*)(_p + CH_TT + lane * 16); O.v = *(const u32x2*)(_p + CH_V + g * 512 + lane * 8); } while (0)
#define X2_LOADL(O, ch) do { const unsigned char* _p = base + (size_t)(ch) * CH_BYTES; \
        O.ar2 = *(const u32x4*)(_p + CH_AR + 2048 + lane * 16); O.ar3 = *(const u32x4*)(_p + CH_AR + 3072 + lane * 16); O.mbr = *(const u32x4*)(_p + CH_MBR + lane * 16); \
        _Pragma("unroll") for (int _i = 0; _i < 4; ++_i) { O.bk[_i] = *(const u32x4*)(_p + CH_BK + _i * 1024 + lane * 16); O.gam[_i] = *(const f32x4*)(_p + CH_GAM + (16 * _i + 4 * q) * 4); } } while (0)
#define BF8(x) __builtin_bit_cast(bf16x8, x)
    f32x4 zt[4];
#pragma unroll
    for (int i = 0; i < 4; ++i) zt[i] = (f32x4){0.f, 0.f, 0.f, 0.f};
    float* py = WSP(float, WS_Y) + h * 64 + vcol;
    const f32x4 z4 = {0.f, 0.f, 0.f, 0.f};
    X2Early e0, e1, e2; X2Late l0, l1;
    X2_LOADE(e0, 0); X2_LOADL(l0, 0); X2_LOADE(e1, 1);
#pragma unroll 1
    for (int ch = 0; ch < 129; ++ch) {
        asm volatile("" ::: "memory");
        { const int c2 = (ch + 2 < 129) ? ch + 2 : 128, c1 = (ch + 1 < 129) ? ch + 1 : 128; X2_LOADE(e2, c2); X2_LOADL(l1, c1); }
        asm volatile("" ::: "memory");
        const u32x4 zb0 = {pk_bf16(zt[0][0], zt[0][1]), pk_bf16(zt[0][2], zt[0][3]), pk_bf16(zt[1][0], zt[1][1]), pk_bf16(zt[1][2], zt[1][3])};
        const u32x4 zb1 = {pk_bf16(zt[2][0], zt[2][1]), pk_bf16(zt[2][2], zt[2][3]), pk_bf16(zt[3][0], zt[3][1]), pk_bf16(zt[3][2], zt[3][3])};
        f32x4 x1a = __builtin_amdgcn_mfma_f32_16x16x32_bf16(BF8(e0.ar0), BF8(zb0), z4, 0, 0, 0);
        x1a = __builtin_amdgcn_mfma_f32_16x16x32_bf16(BF8(e0.ar1), BF8(zb1), x1a, 0, 0, 0);
        const u32x4 bp2 = {0u, 0u, e0.v.x, e0.v.y};
        const f32x4 p2 = __builtin_amdgcn_mfma_f32_16x16x32_bf16(BF8(e0.mak), BF8(bp2), x1a, 0, 0, 0);
        const u32x4 bu = {pk_bf16(p2[0], p2[1]), pk_bf16(p2[2], p2[3]), 0u, 0u};
        const f32x4 u = __builtin_amdgcn_mfma_f32_16x16x32_bf16(BF8(e0.tt), BF8(bu), z4, 0, 0, 0);
        const u32x4 buv = {pk_bf16(u[0], u[1]), pk_bf16(u[2], u[3]), e0.v.x, e0.v.y};
        f32x4 x1r = __builtin_amdgcn_mfma_f32_16x16x32_bf16(BF8(l0.ar2), BF8(zb0), z4, 0, 0, 0);
        x1r = __builtin_amdgcn_mfma_f32_16x16x32_bf16(BF8(l0.ar3), BF8(zb1), x1r, 0, 0, 0);
        const f32x4 y = __builtin_amdgcn_mfma_f32_16x16x32_bf16(BF8(l0.mbr), BF8(buv), x1r, 0, 0, 0);
#pragma unroll
        for (int i = 0; i < 4; ++i) zt[i] = __builtin_amdgcn_mfma_f32_16x16x32_bf16(BF8(l0.bk[i]), BF8(buv), zt[i] * l0.gam[i], 0, 0, 0);
#pragma unroll
        for (int r = 0; r < 4; ++r) { const int t = 16 * ch + 4 * q + r; py[(size_t)(t < NMETA ? ROW_META + t : b * SEQ + (t - NMETA)) * 512] = y[r]; }
        e0 = e1; e1 = e2; l0 = l1;
    }
#undef X2_LOADE
#undef X2_LOADL
#undef BF8
#pragma unroll
    for (int i = 0; i < 4; ++i) *(f32x4*)(A.out + OUT_WKVP + ((size_t)bh * 64 + vcol) * 64 + 16 * i + 4 * q) = zt[i];
}

__device__ __forceinline__ void decode_run(const Args& A, int cu, int wid, int lane, const LAS unsigned char* qlds, LAS unsigned char* tl, volatile LAS unsigned* qctr) {
    const int sb = cu >> 1, c = lane & 15, q = lane >> 4;
    const LAS unsigned char* qrd = qlds + (c < 8 ? c : 8) * 576 + q * 16;
    bf16x8 sel0, sel1;
#pragma unroll
    for (int e = 0; e < 8; ++e) { sel0[e] = (q == (c >> 3) && e == (c & 7)) ? (short)0x3F80 : (short)0; sel1[e] = (q == 2 + (c >> 3) && e == (c & 7)) ? (short)0x3F80 : (short)0; }
    f32x4 acc[16];
#pragma unroll
    for (int i = 0; i < 16; ++i) acc[i] = (f32x4){0.f, 0.f, 0.f, 0.f};
    float mrun = -1e30f, lpart = 0.f;
    const int* ptb = (const int*)A.in[I_PT] + sb * NPAGES + (cu & 1) * 32;
    f32x4 X[18];
    const size_t lane_off = (size_t)lane * 4;
    const LAS unsigned char* trd = tl + c * 576 + 16 * q; LAS unsigned char* twr = tl + lane * 8;
#define DEC_LOAD(ptr) do { _Pragma("unroll") for (int _n = 0; _n < 18; ++_n) X[_n] = *(const f32x4*)((ptr) + 256 * _n); } while (0)
    for (;;) {
    unsigned kk = 0;
    if (lane == 0) kk = __hip_atomic_fetch_add((LAS unsigned*)qctr, 1u, __ATOMIC_RELAXED, __HIP_MEMORY_SCOPE_WORKGROUP);
    kk = __builtin_amdgcn_readfirstlane(kk);
    if (kk >= 16u) break;
    const int* pt = ptb + 2 * (int)kk;
    const float* page = INF(I_CACHE) + (size_t)pt[0] * (PAGESZ * KVW);
    DEC_LOAD(page + lane_off);
    asm volatile("" ::: "memory");
#pragma unroll 1
    for (int tile = 0; tile < 16; ++tile) {
        bf16x8 C[9];
#pragma unroll
        for (int n = 0; n < 18; ++n) *(LAS u32x2*)(twr + 512 * n) = (u32x2){pk_bf16(X[n][0], X[n][1]), pk_bf16(X[n][2], X[n][3])};
#pragma unroll
        for (int s = 0; s < 9; ++s) C[s] = *(const LAS bf16x8*)(trd + 64 * s);
        asm volatile("" ::: "memory");
        {
            const int tn = (tile + 1 < 16) ? tile + 1 : tile;
            const float* pg = INF(I_CACHE) + (size_t)pt[tn >> 3] * (PAGESZ * KVW) + (size_t)((tn & 7) * 16) * KVW;
            DEC_LOAD(pg + lane_off);
        }
        asm volatile("" ::: "memory");
        f32x4 st = {0.f, 0.f, 0.f, 0.f};
#pragma unroll
        for (int s = 0; s < 9; ++s) st = __builtin_amdgcn_mfma_f32_16x16x32_bf16(C[s], *(const LAS bf16x8*)(qrd + 64 * s), st, 0, 0, 0);
        float mx = fmaxf(fmaxf(st[0], st[1]), fmaxf(st[2], st[3]));
        mx = fmaxf(mx, __shfl_xor(mx, 16)); mx = fmaxf(mx, __shfl_xor(mx, 32));
        const float mnew = fmaxf(mrun, mx), alpha = exp2f(mrun - mnew);
        mrun = mnew;
        f32x4 p; float ps = 0.f;
#pragma unroll
        for (int r = 0; r < 4; ++r) { p[r] = exp2f(st[r] - mnew); ps += p[r]; }
        lpart = lpart * alpha + ps;
        u32x4 pw; pw[0] = pk_bf16(p[0], p[1]); pw[1] = pk_bf16(p[2], p[3]); pw[2] = 0u; pw[3] = 0u;
        const bf16x8 pa = __builtin_bit_cast(bf16x8, pw);
        if (__any(alpha != 1.0f)) {
            f32x4 al;
#pragma unroll
            for (int r = 0; r < 4; ++r) al[r] = __shfl(alpha, (4 * q + r) & 7);
#pragma unroll
            for (int g = 0; g < 16; ++g) acc[g] *= al;
        }
#pragma unroll
        for (int s = 0; s < 8; ++s) {
            const f32x4 z4 = {0.f, 0.f, 0.f, 0.f};
            const f32x4 t0 = __builtin_amdgcn_mfma_f32_16x16x32_bf16(C[s], sel0, z4, 0, 0, 0);
            const f32x4 t1 = __builtin_amdgcn_mfma_f32_16x16x32_bf16(C[s], sel1, z4, 0, 0, 0);
            u32x4 b0; b0[0] = pk_bf16(t0[0], t0[1]); b0[1] = pk_bf16(t0[2], t0[3]); b0[2] = 0u; b0[3] = 0u;
            u32x4 b1; b1[0] = pk_bf16(t1[0], t1[1]); b1[1] = pk_bf16(t1[2], t1[3]); b1[2] = 0u; b1[3] = 0u;
            acc[2 * s] = __builtin_amdgcn_mfma_f32_16x16x32_bf16(pa, __builtin_bit_cast(bf16x8, b0), acc[2 * s], 0, 0, 0);
            acc[2 * s + 1] = __builtin_amdgcn_mfma_f32_16x16x32_bf16(pa, __builtin_bit_cast(bf16x8, b1), acc[2 * s + 1], 0, 0, 0);
        }
    }
    }
#undef DEC_LOAD
    float lsum = lpart; lsum += __shfl_xor(lsum, 16); lsum += __shfl_xor(lsum, 32);
    float* part = WSP(float, WS_PART) + (size_t)(cu * 8 + wid) * (8 * 260);
    if (q < 2) {
#pragma unroll
        for (int g = 0; g < 16; ++g)
#pragma unroll
            for (int r = 0; r < 4; ++r) part[(4 * q + r) * 260 + 16 * g + c] = acc[g][r];
    }
    if (q == 0 && c < 8) { part[c * 260 + 256] = mrun; part[c * 260 + 257] = lsum; }
}
#define EVT(e) do { if (lane == 0) ((volatile LAS unsigned*)(lds + LDS_MISC))[32 + (e)] = (unsigned)__builtin_amdgcn_s_memrealtime(); } while (0)
constexpr int LDS5_DECQ = 2 * AT_STAGE, LDS5_DECT = LDS5_DECQ + 5184;
__device__ __forceinline__ void p5_mixed(const Args& A, LAS unsigned char* lds) {
    const int tid = threadIdx.x, lane = tid & 63, wid = __builtin_amdgcn_readfirstlane(tid >> 6), G = gridDim.x, cu = blockIdx.x;
    volatile LAS unsigned* misc = (volatile LAS unsigned*)(lds + LDS_MISC);
    {
        LAS unsigned char* qlds = lds + LDS5_DECQ; const bf16_t* qg = WSP(bf16_t, WS_QF) + (size_t)(cu >> 1) * 8 * 288;
        if (tid < 288) *(LAS u32x4*)(qlds + tid * 16) = *(const u32x4*)((const char*)qg + tid * 16);
        else if (tid < 324) *(LAS u32x4*)(qlds + tid * 16) = (u32x4){0u, 0u, 0u, 0u};
    }
    __syncthreads();
    if (wid < 4) {
        unsigned epoch = 0u;
        const int b = cu >> 5, h = (cu >> 2) & 7, qq = cu & 3;
        attn_unit4(A, b, h, 7 - qq, 1, wid, lane, lds, misc + 48, epoch);
        attn_unit4(A, b, h, 7 - qq, 0, wid, lane, lds, misc + 48, epoch);
        attn_unit4(A, b, h, qq, 1, wid, lane, lds, misc + 48, epoch);
        attn_unit4(A, b, h, qq, 0, wid, lane, lds, misc + 48, epoch);
    } else {
        const int dw = wid - 4;
        for (int s = cu * 4 + dw; s < 1024; s += G * 4) scan_sample_step(A, s, lane);
        if (dw == 0) x2_scan(A, cu >> 2, cu & 3, lane);
    }
    decode_run(A, cu, wid, lane, lds + LDS5_DECQ, lds + LDS5_DECT + wid * 9216, misc + 40);
}

__device__ __forceinline__ void p5a_post(const Args& A, LAS unsigned char* lds) {
    const int tid = threadIdx.x, lane = tid & 63, wid = tid >> 6, G = gridDim.x;
    for (int row = blockIdx.x * NWAVES + wid; row < MROWS; row += G * NWAVES) {
        bf16_t* o = WSP(bf16_t, WS_ORW) + (size_t)row * 512 + lane * 8;
        if (row >= ROW_PAD || (row >= ROW_META && row < ROW_SAMP)) { *(u32x4*)o = (u32x4){0u, 0u, 0u, 0u}; continue; }
        const size_t ro = (size_t)row * 512 + lane * 8;
        int ncop; const float* rec = WSP(float, WS_SCN) + scn_base(row, lane >> 3, ncop) + (lane & 7) * 8;
        f32x4 y[2], r[2], k[2], v[2];
#pragma unroll
        for (int i = 0; i < 2; ++i) { y[i] = *(const f32x4*)(WSP(float, WS_Y) + ro + 4 * i); r[i] = *(const f32x4*)(rec + 4 * i); { const f32x4 zk = *(const f32x4*)(rec + 128 + 4 * i), ap = *(const f32x4*)(rec + 256 + 4 * i), ka4 = *(const f32x4*)(INF(I_KA) + lane * 8 + 4 * i);
              for (int e = 0; e < 4; ++e) k[i][e] = zk[e] * (1.0f + (sigmoidf_(ap[e]) - 1.0f) * ka4[e]); } v[i] = *(const f32x4*)(rec + 320 + 4 * i); }
        float s1 = 0.f, rk = 0.f;
#pragma unroll
        for (int i = 0; i < 2; ++i) { const f32x4 rkw = *(const f32x4*)(INF(I_RK) + lane * 8 + 4 * i);
            for (int e = 0; e < 4; ++e) { s1 += y[i][e]; rk += r[i][e] * k[i][e] * rkw[e]; } }
        s1 += __shfl_xor(s1, 1); s1 += __shfl_xor(s1, 2); s1 += __shfl_xor(s1, 4);
        rk += __shfl_xor(rk, 1); rk += __shfl_xor(rk, 2); rk += __shfl_xor(rk, 4);
        const float mean = s1 * (1.0f / 64.0f);
        float s2 = 0.f;
#pragma unroll
        for (int i = 0; i < 2; ++i) for (int e = 0; e < 4; ++e) { const float d = y[i][e] - mean; s2 += d * d; }
        s2 += __shfl_xor(s2, 1); s2 += __shfl_xor(s2, 2); s2 += __shfl_xor(s2, 4);
        const float rstd = rsqrtf(s2 * (1.0f / 64.0f) + GN_EPS);
        const u32x4 gw = *(const u32x4*)(WSP(bf16_t, WS_GB) + ro);
        f32x4 out[2];
#pragma unroll
        for (int i = 0; i < 2; ++i) { const f32x4 lw = *(const f32x4*)(INF(I_LNW) + lane * 8 + 4 * i), lb = *(const f32x4*)(INF(I_LNB) + lane * 8 + 4 * i);
            for (int e = 0; e < 4; ++e) { const unsigned g2 = gw[2 * i + (e >> 1)]; const float g = __uint_as_float((e & 1) ? (g2 & 0xffff0000u) : (g2 << 16));
                out[i][e] = ((y[i][e] - mean) * rstd * lw[e] + lb[e] + rk * v[i][e]) * g; } }
        const u32x2 a = pk4(out[0]), b2 = pk4(out[1]);
        *(u32x4*)o = (u32x4){a.x, a.y, b2.x, b2.y};
    }
    LAS float* ol = (LAS float*)lds;
    for (int sb = blockIdx.x; sb < DECB; sb += G) {
        const int h = tid >> 6, c4 = (tid & 63) * 4;
        const float* kvs = A.out + OUT_KVS + (size_t)sb * KVW;
        const bf16_t* qf = WSP(bf16_t, WS_QF) + ((size_t)sb * 8 + h) * 288;
        float sp = 0.f;
        { const u32x2 qw = *(const u32x2*)(qf + c4); const f32x4 kv = *(const f32x4*)(kvs + c4);
          sp = __uint_as_float(qw.x << 16) * kv[0] + __uint_as_float(qw.x & 0xffff0000u) * kv[1] + __uint_as_float(qw.y << 16) * kv[2] + __uint_as_float(qw.y & 0xffff0000u) * kv[3];
          if (lane < 32) sp += bf2f(qf[256 + lane]) * kvs[256 + lane]; }
        const float sself = wave_sum(sp);
        const float* part = WSP(float, WS_PART) + (size_t)(sb * 16) * (8 * 260) + h * 260;
        float M = sself;
#pragma unroll
        for (int i = 0; i < 16; ++i) M = fmaxf(M, part[(size_t)i * (8 * 260) + 256]);
        const float wself = exp2f(sself - M);
        float L = wself; f32x4 o = *(const f32x4*)(kvs + c4) * wself;
#pragma unroll
        for (int i = 0; i < 16; ++i) { const float* pi = part + (size_t)i * (8 * 260); const float w = exp2f(pi[256] - M); L += pi[257] * w; o += *(const f32x4*)(pi + c4) * w; }
        const float invL = 1.0f / L;
        __syncthreads();
        ol[h * 256 + c4] = o[0] * invL; ol[h * 256 + c4 + 1] = o[1] * invL; ol[h * 256 + c4 + 2] = o[2] * invL; ol[h * 256 + c4 + 3] = o[3] * invL;
        __syncthreads();
        { const int hv = tid, hh = hv >> 6; const float* wv = INF(I_WUV) + hv; float s = 0.f;
#pragma unroll 8
          for (int cc = 0; cc < 256; ++cc) s += ol[hh * 256 + cc] * wv[(size_t)cc * 512];
          WSP(bf16_t, WS_O)[(size_t)(ROW_SAMP + sb) * 512 + hv] = f2bf(s); }
    }
    for (int i = blockIdx.x * NTHREADS + tid; i < (MROWS - MMAIN) * 512; i += G * NTHREADS) {
        const int row = MMAIN + i / 512; if (row < ROW_SAMP || row >= ROW_PAD) WSP(bf16_t, WS_O)[(size_t)MMAIN * 512 + i] = 0;
    }
}

template <int KS, class Epi>
__device__ __forceinline__ void skinny_gemm(const bf16_t* A_, const bf16_t* Bt, int N, int K, const Epi& E, LAS unsigned char* lds) {
    constexpr int MT = 8 / KS, MG = 8 / MT;
    const int tid = threadIdx.x, lane = tid & 63, wid = __builtin_amdgcn_readfirstlane(tid >> 6), c = lane & 15, q = lane >> 4;
    const int n_items = (N >> 4) * MG, kw = K / KS;
    for (int it = blockIdx.x; it < n_items; it += gridDim.x) {
        const int nt = it / MG, mg = it - nt * MG, mtl = wid % MT, ks = wid / MT, mt = mg * MT + mtl;
        const bf16_t* ap = A_ + (size_t)(mt * 16 + c) * K + ks * kw + 8 * q;
        const bf16_t* bp = Bt + (size_t)(nt * 16 + c) * K + ks * kw + 8 * q;
        f32x4 acc = {0.f, 0.f, 0.f, 0.f};
#pragma unroll 8
        for (int k = 0; k < kw; k += 32) acc = __builtin_amdgcn_mfma_f32_16x16x32_bf16(*(const bf16x8*)(ap + k), *(const bf16x8*)(bp + k), acc, 0, 0, 0);
        if (KS > 1) {
            *(LAS f32x4*)(lds + wid * 1024 + lane * 16) = acc;
            __syncthreads();
            if (ks == 0) {
#pragma unroll
                for (int s = 1; s < KS; ++s) acc += *(const LAS f32x4*)(lds + (s * MT + mtl) * 1024 + lane * 16);
            }
            __syncthreads();
        }
        if (ks == 0) E(acc, mt * 16 + 4 * q, nt * 16 + c, c);
    }
}
struct SkG4 { const bf16_t* gate; bf16_t* mrg;
    __device__ __forceinline__ void operator()(const f32x4& acc, int sr0, int col, int) const {
#pragma unroll
        for (int r = 0; r < 4; ++r) { const size_t row = ROW_SAMP + sr0 + r; mrg[row * 1024 + col] = f2bf(acc[r] * bf2f(gate[row * 2048 + col])); } } };
struct SkG5 { const bf16_t* gate; bf16_t* mrg;
    __device__ __forceinline__ void operator()(const f32x4& acc, int sr0, int col, int) const {
#pragma unroll
        for (int r = 0; r < 4; ++r) { const size_t row = ROW_SAMP + sr0 + r; mrg[row * 1024 + col] = f2bf(bf2f(mrg[row * 1024 + col]) + acc[r] * bf2f(gate[row * 2048 + 1024 + col])); } } };
struct SkG6 { const float* xs; float* x1; bf16_t* x1b; float* ssq;
    __device__ __forceinline__ void operator()(const f32x4& acc, int sr0, int col, int) const {
#pragma unroll
        for (int r = 0; r < 4; ++r) { const size_t row = ROW_SAMP + sr0 + r; const float o = xs[(size_t)(sr0 + r) * DM + col] + acc[r];
            x1[row * 1024 + col] = o; x1b[row * 1024 + col] = f2bf(o); const float ss = row16_sum(o * o); if ((threadIdx.x & 15) == 0) atomicAdd(ssq + row, ss); } } };
struct SkG7 { const float* ssq; bf16_t* act;
    __device__ __forceinline__ void operator()(const f32x4& acc, int sr0, int col, int) const {
#pragma unroll
        for (int r = 0; r < 4; ++r) { const size_t row = ROW_SAMP + sr0 + r; const float t = fmaxf(acc[r] * rsqrtf(ssq[row] * (1.0f / DM) + NORM_EPS), 0.f); act[row * DFF + col] = f2bf(t * t); } } };
struct SkG8 { const float* x1; float* x2; float* ssq;
    __device__ __forceinline__ void operator()(const f32x4& acc, int sr0, int col, int) const {
#pragma unroll
        for (int r = 0; r < 4; ++r) { const size_t row = ROW_SAMP + sr0 + r; const float o = x1[row * 1024 + col] + acc[r];
            x2[row * 1024 + col] = o; const float ss = row16_sum(o * o); if ((threadIdx.x & 15) == 0) atomicAdd(ssq + row, ss); } } };

__device__ __forceinline__ void p9_final(const Args& A) {
    const int tid = threadIdx.x, lane = tid & 63, wid = tid >> 6, G = gridDim.x;
    for (int row = blockIdx.x * NWAVES + wid; row < ROW_PAD; row += G * NWAVES) {
        float* o;
        if (row < MMAIN) o = A.out + OUT_YP + (size_t)row * DM;
        else if (row >= ROW_SAMP) o = A.out + OUT_YS + (size_t)(row - ROW_SAMP) * DM;
        else continue;
        const float rs = rsqrtf(WSP(float, WS_SSQ2)[row] * (1.0f / DM) + NORM_EPS);
        const float* x = WSP(float, WS_X2) + (size_t)row * DM;
#pragma unroll
        for (int i = 0; i < 4; ++i) *(f32x4*)(o + i * 256 + lane * 4) = *(const f32x4*)(x + i * 256 + lane * 4) * rs * *(const f32x4*)(INF(I_GFINAL) + i * 256 + lane * 4);
    }
}

#ifndef MK_LAUNCHES
#define MK_LAUNCHES 1
#endif
#ifndef REP_A
#define REP_A 1
#endif
#ifndef REP_B
#define REP_B 1
#endif
#ifndef REP_T
#define REP_T 1
#endif
constexpr int NPHASES = 12;
constexpr int CW_BAR = 0;

__global__ void __launch_bounds__(NTHREADS, 2) mk_fwd(Args A) {
    extern __shared__ __attribute__((aligned(16))) unsigned char lds_raw[];
    LAS unsigned char* lds = (LAS unsigned char*)lds_raw;
    volatile LAS unsigned* misc = (volatile LAS unsigned*)(lds + LDS_MISC);
    const int tid = threadIdx.x;
    if (tid < 64) misc[tid] = 0u;
    __syncthreads();
    const int lo = A.ph_lo, hi = A.ph_hi;
    XcdBarrier bar; bar.bar = WSP(unsigned, WS_CTL) + CW_BAR; bar.x = 0; bar.st = nullptr;
    if (hi - lo > 1) bar = xcd_barrier_post(WSP(unsigned, WS_CTL) + CW_BAR, misc + 8);
#ifndef PH_MASK
#define PH_MASK 0xfff
#endif
#define IN(k) (((PH_MASK >> (k)) & 1) && lo <= (k) && (k) < hi)
#define SEAM(k) do { if (IN(k) && IN((k) + 1)) xcd_barrier(bar); } while (0)
    const int G = gridDim.x, cid = blockIdx.x;
#ifdef PROBE_K
    unsigned long long pr_t0 = __builtin_amdgcn_s_memrealtime(), pr_t1 = pr_t0;
#define PROBE_AT(k) do { if ((k) == PROBE_K) pr_t1 = __builtin_amdgcn_s_memrealtime(); } while (0)
#else
#define PROBE_AT(k) do { } while (0)
#endif

    if (IN(0)) { for (int r = 0; r < REP_T; ++r) p0_prologue(A, lds); }
    SEAM(0); PROBE_AT(0);
    if (IN(1)) {
        pg8::Gemm g{WSP(bf16_t, WS_XB), WSP(bf16_t, WS_WIN), MROWS, INPAD, DM}; pg8::StaticOrder S; S.init(MROWS, INPAD, G, cid);
        EpiG1 E{WSP(float, WS_ZS), WSP(float, WS_RW), WSP(bf16_t, WS_GATE)};
#ifndef REP_G1
#define REP_G1 1
#endif
        for (int r = 0; r < REP_G1; ++r) pg8::gemm_phase<EpiG1, pg8::StaticOrder, true, true>(lds, g, S, E);
        if (cid >= P1_TAIL_CU0) p0_weights(A, (cid - P1_TAIL_CU0) * NTHREADS + tid, (G - P1_TAIL_CU0) * NTHREADS, 10, NJOBS, false);
    }
    SEAM(1); PROBE_AT(1);
    if (IN(2)) { for (int r = 0; r < REP_T; ++r) p2a_rows(A); }
    SEAM(2); PROBE_AT(2);
    if (IN(3)) {
#ifndef P3SEL
#define P3SEL 15
#endif
        if (P3SEL & 1) {
            pg8::Gemm g{WSP(bf16_t, WS_CKV), WSP(bf16_t, WS_WKV), MROWS, 1024, 256}; pg8::StaticOrder S; S.init(MROWS, 1024, G, (cid + 128) % G);
            EpiKV E{WSP(bf16_t, WS_KN), WSP(bf16_t, WS_VT)};
            pg8::gemm_phase<EpiKV, pg8::StaticOrder, false, false>(lds, g, S, E);
        }
        if (P3SEL & 2) {
            pg8::Gemm g{WSP(bf16_t, WS_LIN), WSP(bf16_t, WS_WLORA), MROWS, 1536, 256}; pg8::StaticOrder S; S.init(MROWS, 1536, G, (cid + 64) % G);
            EpiLora E{INF(I_W0), INF(I_A0), WSP(float, WS_SCN), WSP(bf16_t, WS_GB)};
            pg8::gemm_phase<EpiLora, pg8::StaticOrder, false, false>(lds, g, S, E);
        }
        if (P3SEL & 4) {
            pg8::Gemm g{WSP(bf16_t, WS_QN), WSP(bf16_t, WS_WUQ), MROWS, 768, 384}; pg8::StaticOrder S; S.init(MROWS, 768, G, cid);
            EpiQ E{WSP(bf16_t, WS_Q), WSP(bf16_t, WS_QF), WSP(float, WS_ROPE)};
            pg8::gemm_phase<EpiQ, pg8::StaticOrder, false, false>(lds, g, S, E);
        }
        if (P3SEL & 8) {
            pg8::Gemm g{WSP(bf16_t, WS_QN) + (size_t)ROW_META * 384, WSP(bf16_t, WS_WQABS), 256, 2048, 384}; pg8::StaticOrder S; S.init(256, 2048, G, (cid + 120) % G);
            EpiQabs E{WSP(bf16_t, WS_QF)};
            pg8::gemm_phase<EpiQabs, pg8::StaticOrder, false, false>(lds, g, S, E);
        }
    }
    SEAM(3); PROBE_AT(3);
    if (IN(4)) { p4_x1(A, lds); }
    SEAM(4); PROBE_AT(4);
    if (IN(5)) {
        p5_mixed(A, lds);
    }
    SEAM(5); PROBE_AT(5);
    if (IN(6)) { for (int r = 0; r < REP_T; ++r) p5a_post(A, lds); }
    SEAM(6); PROBE_AT(6);
    if (IN(7)) {
        {   pg8::Gemm g{WSP(bf16_t, WS_O), WSP(bf16_t, WS_WOM), MMAIN, 1024, 512}; pg8::StaticOrder S; S.init(MMAIN, 1024, G, cid);
            EpiG4 E{WSP(bf16_t, WS_GATE), WSP(bf16_t, WS_MRG)};
            pg8::gemm_phase<EpiG4, pg8::StaticOrder, false, false>(lds, g, S, E); }
        {   pg8::Gemm g{WSP(bf16_t, WS_ORW), WSP(bf16_t, WS_WOR), MMAIN, 1024, 512}; pg8::StaticOrder S; S.init(MMAIN, 1024, G, cid);
            EpiG5 E{WSP(bf16_t, WS_GATE), WSP(bf16_t, WS_MRG)};
            pg8::gemm_phase<EpiG5, pg8::StaticOrder, false, false>(lds, g, S, E); }
        skinny_gemm<4>(WSP(bf16_t, WS_O) + (size_t)ROW_SAMP * 512, WSP(bf16_t, WS_WOM), 1024, 512, SkG4{WSP(bf16_t, WS_GATE), WSP(bf16_t, WS_MRG)}, lds);
        skinny_gemm<4>(WSP(bf16_t, WS_ORW) + (size_t)ROW_SAMP * 512, WSP(bf16_t, WS_WOR), 1024, 512, SkG5{WSP(bf16_t, WS_GATE), WSP(bf16_t, WS_MRG)}, lds);
    }
    SEAM(7); PROBE_AT(7);
    if (IN(8)) {
        pg8::Gemm g{WSP(bf16_t, WS_MRG), WSP(bf16_t, WS_WOUT), MMAIN, 1024, 1024}; pg8::StaticOrder S; S.init(MMAIN, 1024, G, cid);
        EpiG6 E{XSrc{INF(I_XP), INF(I_META), INF(I_XS)}, WSP(float, WS_X1), WSP(bf16_t, WS_X1B), WSP(float, WS_SSQ1)};
        pg8::gemm_phase<EpiG6, pg8::StaticOrder, false, true>(lds, g, S, E);
        skinny_gemm<4>(WSP(bf16_t, WS_MRG) + (size_t)ROW_SAMP * 1024, WSP(bf16_t, WS_WOUT), 1024, 1024, SkG6{INF(I_XS), WSP(float, WS_X1), WSP(bf16_t, WS_X1B), WSP(float, WS_SSQ1)}, lds);
    }
    SEAM(8); PROBE_AT(8);
    if (IN(9)) {
        pg8::Gemm g{WSP(bf16_t, WS_X1B), WSP(bf16_t, WS_WUP), MMAIN, DFF, 1024}; pg8::StaticOrder S; S.init(MMAIN, DFF, G, cid);
        EpiG7 E{WSP(float, WS_SSQ1), WSP(bf16_t, WS_ACT)};
#ifndef REP_G7
#define REP_G7 1
#endif
        for (int r = 0; r < REP_G7; ++r) pg8::gemm_phase<EpiG7, pg8::StaticOrder, true, true>(lds, g, S, E);
        skinny_gemm<1>(WSP(bf16_t, WS_X1B) + (size_t)ROW_SAMP * 1024, WSP(bf16_t, WS_WUP), DFF, 1024, SkG7{WSP(float, WS_SSQ1), WSP(bf16_t, WS_ACT)}, lds);
    }
    SEAM(9); PROBE_AT(9);
    if (IN(10)) {
        pg8::Gemm g{WSP(bf16_t, WS_ACT), WSP(bf16_t, WS_WDN), MMAIN, 1024, DFF}; pg8::StaticOrder S; S.init(MMAIN, 1024, G, cid);
        EpiG8 E{WSP(float, WS_X1), WSP(float, WS_X2), WSP(float, WS_SSQ2)};
        pg8::gemm_phase<EpiG8, pg8::StaticOrder, false, true>(lds, g, S, E);
        skinny_gemm<4>(WSP(bf16_t, WS_ACT) + (size_t)ROW_SAMP * DFF, WSP(bf16_t, WS_WDN), 1024, DFF, SkG8{WSP(float, WS_X1), WSP(float, WS_X2), WSP(float, WS_SSQ2)}, lds);
    }
    SEAM(10); PROBE_AT(10);
    if (IN(11)) { for (int r = 0; r < REP_T; ++r) p9_final(A); }
#ifdef PROBE_K
#ifdef PROBE_E1
    if (cid == 0 && tid == 0) { pr_t0 = misc[32 + PROBE_E1]; pr_t1 = misc[32 + PROBE_E2]; }
#endif
    if (cid == 0 && tid == 0) { const unsigned long long te = __builtin_amdgcn_s_memrealtime(), want = 4ull * (unsigned)((unsigned)pr_t1 - (unsigned)pr_t0);
        while (__builtin_amdgcn_s_memrealtime() - te < want) __builtin_amdgcn_s_sleep(16); }
#endif
#undef IN
#undef SEAM
}

extern "C" void kernel_launch(void* const* d_in, const int* in_sizes, int n_in, void* d_out, int out_size, void* d_ws, size_t ws_size, hipStream_t stream) {
    static int grid = 0;
    if (grid == 0) {
        if (n_in != N_IN || (size_t)out_size != OUT_END || ws_size < WS_END) { fprintf(stderr, "kernel_launch: unexpected sizes: n_in %d out %d (want %zu) ws %zu (want %zu)\n", n_in, out_size, (size_t)OUT_END, ws_size, (size_t)WS_END); grid = -1; return; }
        int dev = 0, cus = 0, per_cu = 0;
        if (hipGetDevice(&dev) != hipSuccess || hipDeviceGetAttribute(&cus, hipDeviceAttributeMultiprocessorCount, dev) != hipSuccess) { grid = -1; return; }
        if (hipFuncSetAttribute((const void*)mk_fwd, hipFuncAttributeMaxDynamicSharedMemorySize, LDS_BYTES) != hipSuccess) { fprintf(stderr, "kernel_launch: hipFuncSetAttribute failed\n"); grid = -1; return; }
        if (hipOccupancyMaxActiveBlocksPerMultiprocessor(&per_cu, (const void*)mk_fwd, NTHREADS, LDS_BYTES) != hipSuccess || per_cu < 1) { fprintf(stderr, "kernel_launch: occupancy query says %d\n", per_cu); }
        (void)hipGetLastError();
        if (cus < 256) { fprintf(stderr, "kernel_launch: needs 256 CUs\n"); grid = -1; return; }
        grid = 256;
    }
    if (grid < 0) return;
    (void)hipMemsetAsync(d_ws, 0, WS_ZERO_END, stream);
    Args a{};
    for (int i = 0; i < N_IN; ++i) a.in[i] = d_in[i];
    a.out = (float*)d_out; a.ws = (unsigned char*)d_ws;
#if MK_LAUNCHES == 1
    a.ph_lo = 0; a.ph_hi = NPHASES;
    hipLaunchKernelGGL(mk_fwd, dim3(grid), dim3(NTHREADS), LDS_BYTES, stream, a);
#else
    for (int ph = 0; ph < NPHASES; ++ph) { a.ph_lo = ph; a.ph_hi = ph + 1; hipLaunchKernelGGL(mk_fwd, dim3(grid), dim3(NTHREADS), LDS_BYTES, stream, a); }
#endif
}
```
